# Optimizing an MI355X kernel written in HIP

```python
import math
import jax
import jax.numpy as jnp
from jax import lax
import numpy as np

D_MODEL = 1024
BATCH = 8
SEQ = 2048
DEPTH = 2
DEC_BATCH = 32
DEC_SEQ = 4
PAST_LEN = 16384
PAGE_SIZE = 128

N_MIXERS = 2
N_MLA = (DEPTH + 1) // 2
N_DN = DEPTH // 2

MLA_HEADS = 8
QK_NOPE = 128
QK_ROPE = 64
V_HEAD = 128
KV_LORA = 256
Q_LORA = 384
MLA_ROW = KV_LORA + QK_ROPE
MLA_SCALE = (QK_NOPE + QK_ROPE) ** -0.5
ROPE_THETA = 10000.0
Q_BLOCK = 128

DN_HEADS = 8
DN_DK = 128
DN_DV = 128
CONV_W = 4
DN_CHUNK = 64
DN_HK = DN_HEADS * DN_DK
DN_QKV = DN_HEADS * (2 * DN_DK + DN_DV)
DN_Z = DN_HEADS * DN_DV

D_FF = ((-(-8 * D_MODEL // 3) + 255) // 256) * 256

RMS_EPS = 1e-6
L2_EPS = 1e-6

kernel_name = "hybrid_mla_gated_deltanet_step"


def rmsnorm(x, w):
    x32 = x.astype(jnp.float32)
    y = x32 * lax.rsqrt(jnp.mean(x32 * x32, axis=-1, keepdims=True) + RMS_EPS)
    return (y * w.astype(jnp.float32)).astype(x.dtype)


def l2norm(x):
    return x * lax.rsqrt(jnp.sum(x * x, axis=-1, keepdims=True) + L2_EPS)


def rope(x, pos):
    half = x.shape[-1] // 2
    freq = ROPE_THETA ** (-jnp.arange(half, dtype=jnp.float32) / half)
    ang = pos.astype(jnp.float32)[:, None] * freq[None, :]
    bshape = (ang.shape[0],) + (1,) * (x.ndim - 3) + (half,)
    cos = jnp.cos(ang).reshape(bshape)
    sin = jnp.sin(ang).reshape(bshape)
    x32 = x.astype(jnp.float32)
    x1, x2 = x32[..., :half], x32[..., half:]
    return jnp.concatenate([x1 * cos - x2 * sin, x2 * cos + x1 * sin], axis=-1).astype(x.dtype)


def mla_project(u, pos, w_in, g_q, g_kv, w_uq, w_uk):
    b, t, _ = u.shape
    a = u @ w_in
    c_q = rmsnorm(a[..., :Q_LORA], g_q)
    c_kv = rmsnorm(a[..., Q_LORA:Q_LORA + KV_LORA], g_kv)
    k_r = rope(a[..., Q_LORA + KV_LORA:], pos)
    q = (c_q @ w_uq).reshape(b, t, MLA_HEADS, QK_NOPE + QK_ROPE)
    q_lat = jnp.einsum('bthn,hrn->bthr', q[..., :QK_NOPE], w_uk)
    q_rope = rope(q[..., QK_NOPE:], pos)
    rows = jnp.concatenate([c_kv, k_r], axis=-1)
    return q_lat, q_rope, rows


def mla_core(q_lat, q_rope, rows, q_pos, k_pos):
    c = rows[..., :KV_LORA]
    kr = rows[..., KV_LORA:]
    s = (jnp.einsum('bqhr,bkr->bhqk', q_lat, c)
         + jnp.einsum('bqhp,bkp->bhqk', q_rope, kr)).astype(jnp.float32) * MLA_SCALE
    s = jnp.where(k_pos[None, :] <= q_pos[:, None], s, -jnp.inf)
    p = jax.nn.softmax(s, axis=-1).astype(c.dtype)
    return jnp.einsum('bhqk,bkr->bqhr', p, c)


def mla_prompt_attention(q_lat, q_rope, rows, pos):
    b, t, h, r = q_lat.shape
    nb = t // Q_BLOCK

    def blk(x):
        return jnp.moveaxis(x.reshape(b, nb, Q_BLOCK, *x.shape[2:]), 1, 0)

    def one(args):
        ql, qr, qp = args
        return mla_core(ql, qr, rows, qp, pos)

    o = lax.map(one, (blk(q_lat), blk(q_rope), pos.reshape(nb, Q_BLOCK)))
    return jnp.moveaxis(o, 0, 1).reshape(b, t, h, r)


def mla_out(o_lat, w_uv, w_o):
    b, t, _, _ = o_lat.shape
    o = jnp.einsum('bthr,hrv->bthv', o_lat, w_uv).reshape(b, t, MLA_HEADS * V_HEAD)
    return o @ w_o


def gdn_chunked(q, k, v, g, beta, s0):
    b, t, h, _ = q.shape
    dv = v.shape[-1]
    n = t // DN_CHUNK
    c = DN_CHUNK

    def blk(x):
        return jnp.moveaxis(x.reshape(b, n, c, h, *x.shape[3:]), 3, 1)

    q, k, v, g, beta = blk(q), blk(k), blk(v), blk(g), blk(beta)
    gc = jnp.cumsum(g, axis=-1)
    idx = jnp.arange(c)
    causal = idx[:, None] >= idx[None, :]
    strict = idx[:, None] > idx[None, :]
    decay = jnp.exp(jnp.where(causal, gc[..., :, None] - gc[..., None, :], -jnp.inf))
    kb = k * beta[..., None]
    vb = v * beta[..., None]
    lower = jnp.where(strict, jnp.einsum('bhncd,bhnsd->bhncs', kb, k) * decay, 0.0)
    a_mat = jnp.eye(c, dtype=jnp.float32) + lower
    rhs = jnp.concatenate([vb, kb * jnp.exp(gc)[..., None]], axis=-1)
    sol = lax.linalg.triangular_solve(a_mat, rhs, left_side=True, lower=True, unit_diagonal=True)
    u_c, w_c = sol[..., :dv], sol[..., dv:]
    qk = jnp.where(causal, jnp.einsum('bhncd,bhnsd->bhncs', q, k) * decay, 0.0)
    q_dec = q * jnp.exp(gc)[..., None]
    k_dec = k * jnp.exp(gc[..., -1:] - gc)[..., None]
    g_last = jnp.exp(gc[..., -1])

    def step(s, xs):
        u_i, w_i, qk_i, qd_i, kd_i, gl_i = xs
        v_new = u_i - jnp.einsum('bhcd,bhde->bhce', w_i, s)
        o_i = jnp.einsum('bhcd,bhde->bhce', qd_i, s) + jnp.einsum('bhcs,bhse->bhce', qk_i, v_new)
        s = s * gl_i[..., None, None] + jnp.einsum('bhcd,bhce->bhde', kd_i, v_new)
        return s, o_i

    xs = tuple(jnp.moveaxis(x, 2, 0) for x in (u_c, w_c, qk, q_dec, k_dec, g_last))
    s, o = lax.scan(step, s0, xs)
    o = jnp.transpose(o, (1, 0, 3, 2, 4)).reshape(b, t, h, dv)
    return o, s


def gdn_recurrent(q, k, v, g, beta, s0):
    def step(s, xs):
        q_t, k_t, v_t, g_t, b_t = xs
        s = s * jnp.exp(g_t)[..., None, None]
        kv = jnp.einsum('bhd,bhde->bhe', k_t, s)
        delta = (v_t - kv) * b_t[..., None]
        s = s + jnp.einsum('bhd,bhe->bhde', k_t, delta)
        return s, jnp.einsum('bhd,bhde->bhe', q_t, s)

    xs = tuple(jnp.moveaxis(x, 1, 0) for x in (q, k, v, g, beta))
    s, o = lax.scan(step, s0, xs)
    return jnp.moveaxis(o, 0, 1), s


def dn_mixer(u, s0, conv0, w_in, conv_w, a_log, dt_bias, g_out, w_o, chunked):
    b, t, _ = u.shape
    proj = u @ w_in
    qkv_raw = proj[..., :DN_QKV]
    z = proj[..., DN_QKV:DN_QKV + DN_Z].reshape(b, t, DN_HEADS, DN_DV)
    b_raw = proj[..., DN_QKV + DN_Z:DN_QKV + DN_Z + DN_HEADS]
    a_raw = proj[..., DN_QKV + DN_Z + DN_HEADS:]
    xc = jnp.concatenate([conv0.astype(qkv_raw.dtype), qkv_raw], axis=1)
    new_conv = xc[:, xc.shape[1] - (CONV_W - 1):]
    qkv = lax.conv_general_dilated(xc, conv_w.astype(xc.dtype)[:, None, :], (1,), 'VALID',
                                   dimension_numbers=('NWC', 'WIO', 'NWC'),
                                   feature_group_count=DN_QKV)
    qkv = jax.nn.silu(qkv).astype(jnp.float32)
    q = l2norm(qkv[..., :DN_HK].reshape(b, t, DN_HEADS, DN_DK)) * (DN_DK ** -0.5)
    k = l2norm(qkv[..., DN_HK:2 * DN_HK].reshape(b, t, DN_HEADS, DN_DK))
    v = qkv[..., 2 * DN_HK:].reshape(b, t, DN_HEADS, DN_DV)
    beta = jax.nn.sigmoid(b_raw.astype(jnp.float32))
    g = -jnp.exp(a_log.astype(jnp.float32)) * jax.nn.softplus(
        a_raw.astype(jnp.float32) + dt_bias.astype(jnp.float32))
    core = gdn_chunked if chunked else gdn_recurrent
    o, s = core(q, k, v, g, beta, s0.astype(jnp.float32))
    o = rmsnorm(o, g_out).astype(u.dtype) * jax.nn.silu(z)
    return o.reshape(b, t, DN_HEADS * DN_DV) @ w_o, s, new_conv


def swiglu(u, w_in, w_out):
    gu = u @ w_in
    return (jax.nn.silu(gu[..., :D_FF]) * gu[..., D_FF:]) @ w_out


def setup_inputs(seed: int = 0) -> dict:
    key = jax.random.key(seed)
    ks = jax.random.split(key, 24)
    f32 = jnp.float32

    def nrm(i, shape, scale=1.0):
        return jax.random.normal(ks[i], shape, f32) * scale

    n_pages = PAST_LEN // PAGE_SIZE
    n_used = DEC_BATCH * n_pages
    n_pool = n_used + n_used // 4
    page_table = jax.random.permutation(ks[0], n_pool)[:n_used].reshape(DEC_BATCH, n_pages).astype(jnp.int32)
    dt = jnp.exp(jax.random.uniform(ks[1], (N_DN, DN_HEADS), f32, math.log(1e-3), math.log(1e-1)))
    return {
        "x_prompt": nrm(2, (BATCH, SEQ, D_MODEL)),
        "x_sample": nrm(3, (DEC_BATCH, DEC_SEQ, D_MODEL)),
        "cache_mla": nrm(4, (N_MLA, n_pool, PAGE_SIZE, MLA_ROW)),
        "state_dn": nrm(5, (N_DN, DEC_BATCH, DN_HEADS, DN_DK, DN_DV), 0.1),
        "state_dn_conv": nrm(6, (N_DN, DEC_BATCH, CONV_W - 1, DN_QKV)),
        "page_table": page_table,
        "norm_w": 1.0 + nrm(7, (DEPTH, 4, D_MODEL), 0.02),
        "mla_w_in": nrm(8, (N_MLA, D_MODEL, Q_LORA + MLA_ROW), D_MODEL ** -0.5),
        "mla_g_q": 1.0 + nrm(9, (N_MLA, Q_LORA), 0.02),
        "mla_g_kv": 1.0 + nrm(10, (N_MLA, KV_LORA), 0.02),
        "mla_w_uq": nrm(11, (N_MLA, Q_LORA, MLA_HEADS * (QK_NOPE + QK_ROPE)), Q_LORA ** -0.5),
        "mla_w_uk": nrm(12, (N_MLA, MLA_HEADS, KV_LORA, QK_NOPE), KV_LORA ** -0.5),
        "mla_w_uv": nrm(13, (N_MLA, MLA_HEADS, KV_LORA, V_HEAD), KV_LORA ** -0.5),
        "mla_w_o": nrm(14, (N_MLA, MLA_HEADS * V_HEAD, D_MODEL), (MLA_HEADS * V_HEAD) ** -0.5),
        "dn_w_in": nrm(15, (N_DN, D_MODEL, DN_QKV + DN_Z + 2 * DN_HEADS), D_MODEL ** -0.5),
        "dn_conv_w": nrm(16, (N_DN, CONV_W, DN_QKV), CONV_W ** -0.5),
        "dn_a_log": jnp.log(jax.random.uniform(ks[17], (N_DN, DN_HEADS), f32, 1.0, 16.0)),
        "dn_dt_bias": dt + jnp.log(-jnp.expm1(-dt)),
        "dn_g_out": 1.0 + nrm(18, (N_DN, DN_DV), 0.02),
        "dn_w_o": nrm(19, (N_DN, DN_HEADS * DN_DV, D_MODEL), (DN_HEADS * DN_DV) ** -0.5),
        "ffn_w_in": nrm(20, (DEPTH, D_MODEL, 2 * D_FF), D_MODEL ** -0.5),
        "ffn_w_out": nrm(21, (DEPTH, D_FF, D_MODEL), D_FF ** -0.5),
    }


def reference(x_prompt, x_sample, cache_mla, state_dn, state_dn_conv, page_table, norm_w,
              mla_w_in, mla_g_q, mla_g_kv, mla_w_uq, mla_w_uk, mla_w_uv, mla_w_o,
              dn_w_in, dn_conv_w, dn_a_log, dn_dt_bias, dn_g_out, dn_w_o,
              ffn_w_in, ffn_w_out):
    bp, tp, _ = x_prompt.shape
    bs, ts, _ = x_sample.shape
    past = page_table.shape[1] * PAGE_SIZE
    pos_p = jnp.arange(tp)
    pos_s = past + jnp.arange(ts)
    pos_all = jnp.arange(past + ts)
    hp, hs = x_prompt, x_sample
    rows_p_l, rows_s_l, sp_l, ss_l, cp_l, cs_l = [], [], [], [], [], []
    for layer in range(DEPTH):
        j = layer // N_MIXERS
        nw = norm_w[layer]
        up = rmsnorm(hp, nw[0])
        us = rmsnorm(hs, nw[0])
        if layer % N_MIXERS == 0:
            ql, qr, rows_p = mla_project(up, pos_p, mla_w_in[j], mla_g_q[j], mla_g_kv[j], mla_w_uq[j], mla_w_uk[j])
            o_p = mla_prompt_attention(ql, qr, rows_p, pos_p)
            ql, qr, rows_s = mla_project(us, pos_s, mla_w_in[j], mla_g_q[j], mla_g_kv[j], mla_w_uq[j], mla_w_uk[j])
            past_rows = cache_mla[j, page_table].reshape(bs, past, MLA_ROW)
            all_rows = jnp.concatenate([past_rows.astype(rows_s.dtype), rows_s], axis=1)
            o_s = mla_core(ql, qr, all_rows, pos_s, pos_all)
            mix_p = mla_out(o_p, mla_w_uv[j], mla_w_o[j])
            mix_s = mla_out(o_s, mla_w_uv[j], mla_w_o[j])
            rows_p_l.append(rows_p)
            rows_s_l.append(rows_s)
        else:
            s0_p = jnp.zeros((bp, DN_HEADS, DN_DK, DN_DV), jnp.float32)
            c0_p = jnp.zeros((bp, CONV_W - 1, DN_QKV), up.dtype)
            mix_p, s_p, c_p = dn_mixer(up, s0_p, c0_p, dn_w_in[j], dn_conv_w[j], dn_a_log[j],
                                       dn_dt_bias[j], dn_g_out[j], dn_w_o[j], True)
            mix_s, s_s, c_s = dn_mixer(us, state_dn[j], state_dn_conv[j], dn_w_in[j], dn_conv_w[j],
                                       dn_a_log[j], dn_dt_bias[j], dn_g_out[j], dn_w_o[j], False)
            sp_l.append(s_p.astype(state_dn.dtype))
            ss_l.append(s_s.astype(state_dn.dtype))
            cp_l.append(c_p.astype(state_dn_conv.dtype))
            cs_l.append(c_s.astype(state_dn_conv.dtype))
        hp = hp + rmsnorm(mix_p, nw[1])
        hs = hs + rmsnorm(mix_s, nw[1])
        hp = hp + rmsnorm(swiglu(rmsnorm(hp, nw[2]), ffn_w_in[layer], ffn_w_out[layer]), nw[3])
        hs = hs + rmsnorm(swiglu(rmsnorm(hs, nw[2]), ffn_w_in[layer], ffn_w_out[layer]), nw[3])
    mla_rows_prompt = jnp.stack(rows_p_l)
    mla_rows_sample = jnp.stack(rows_s_l)
    dn_state_prompt = jnp.stack(sp_l)
    dn_state_sample = jnp.stack(ss_l)
    dn_conv_prompt = jnp.stack(cp_l)
    dn_conv_sample = jnp.stack(cs_l)
    return (hp, hs, mla_rows_prompt, mla_rows_sample, dn_state_prompt, dn_state_sample, dn_conv_prompt, dn_conv_sample)
```

```cpp
#include <hip/hip_runtime.h>
#include <hip/hip_cooperative_groups.h>
#include <cstdio>
#include <cstdint>
namespace cg = cooperative_groups;

#define LAS __attribute__((address_space(3)))
#define GAS __attribute__((address_space(1)))
typedef unsigned short bf16_t;
typedef short bf16x8 __attribute__((ext_vector_type(8)));
typedef short s16x4 __attribute__((ext_vector_type(4)));
typedef float f32x4 __attribute__((ext_vector_type(4)));
typedef float f32x2 __attribute__((ext_vector_type(2)));
typedef unsigned u32x4 __attribute__((ext_vector_type(4)));
typedef unsigned u32x2 __attribute__((ext_vector_type(2)));

constexpr int DM = 1024, BATCH = 8, SEQ = 2048, DECB = 32, DECS = 4, PAST = 16384, PAGE = 128;
constexpr int MP = BATCH * SEQ;
constexpr int MS = DECB * DECS;
constexpr int MV = MP + MS;
constexpr int MT = 16640;
constexpr int HEADS = 8, QK_NOPE = 128, QK_ROPE = 64, V_HEAD = 128, KV_LORA = 256, Q_LORA = 384, MLA_ROW = 320;
constexpr int NIN0 = Q_LORA + MLA_ROW;
constexpr int NIN0P = 768;
constexpr int NQ = HEADS * KV_LORA + HEADS * QK_ROPE;
constexpr int DN_HK = 1024, DN_QKV = 3072, DN_Z = 1024, DN_N = 4112, DN_NP = 4352, CONVW = 4, CHUNK = 64;
constexpr int DFF = 2816;
constexpr int NPAGES = PAST / PAGE;
constexpr float RMS_EPS = 1e-6f, L2_EPS = 1e-6f;
constexpr int NTHREADS = 512, NWAVES = 8;

constexpr size_t O_Y = 0;
constexpr size_t O_ROWS = (size_t)MV * DM;
constexpr size_t O_SP = O_ROWS + (size_t)MV * MLA_ROW;
constexpr size_t O_SS = O_SP + (size_t)BATCH * 8 * 128 * 128;
constexpr size_t O_CP = O_SS + (size_t)DECB * 8 * 128 * 128;
constexpr size_t O_CS = O_CP + (size_t)BATCH * 3 * DN_QKV;
constexpr size_t O_END = O_CS + (size_t)DECB * 3 * DN_QKV;

constexpr size_t MiB = 1u << 20;
constexpr size_t WS_CTL = 0;
constexpr size_t CTL_BYTES = 1 * MiB;
constexpr size_t WS_ROPE = 1 * MiB;
constexpr size_t WS_WT_IN0 = 2 * MiB;
constexpr size_t WS_WT_Q = 856 * MiB;
constexpr size_t WS_WT_UVO = 6 * MiB;
constexpr size_t WS_BD_UV = 10 * MiB;
constexpr size_t WS_WOT = 14 * MiB;
constexpr size_t WS_BD_UK = 16 * MiB;
constexpr size_t WS_UQN = 20 * MiB;
constexpr size_t WS_WT_F1 = 22 * MiB;
constexpr size_t WS_WT_F2 = 44 * MiB;
constexpr size_t WS_WT_DIN = 56 * MiB;
constexpr size_t WS_WT_DO = 65 * MiB;
constexpr size_t WS_U = 68 * MiB;
constexpr size_t WS_A0 = 102 * MiB;
constexpr size_t WS_CQ = 152 * MiB;
constexpr size_t WS_ROWSB = 166 * MiB;
constexpr size_t WS_Q = 178 * MiB;
constexpr size_t WS_OL = 260 * MiB;
constexpr size_t WS_MIX = 326 * MiB;
constexpr size_t WS_SLAB = 392 * MiB;
constexpr size_t WS_H = 400 * MiB;
constexpr size_t WS_PROJ = 490 * MiB;
constexpr size_t WS_PART = 632 * MiB;
constexpr size_t WS_ML = 641 * MiB;
constexpr size_t WS_DO = 642 * MiB;
constexpr size_t WS_DOG = 676 * MiB;
constexpr size_t WS_UU = 710 * MiB;
constexpr size_t WS_WW = 742 * MiB;
constexpr size_t WS_QD = 774 * MiB;
constexpr size_t WS_KDT = 806 * MiB;
constexpr size_t WS_QKM = 838 * MiB;
constexpr size_t WS_GL = 854 * MiB;
constexpr size_t WS_HB = 860 * MiB;
constexpr size_t WS_END = 894 * MiB;
constexpr int NSLAB_MAX = 16;

constexpr int CW_GEN = 64;
constexpr int CW_ATT = 8192;

__device__ __forceinline__ float bf2f(unsigned short b) { return __builtin_bit_cast(float, (unsigned)b << 16); }
typedef float f32x2_t __attribute__((ext_vector_type(2)));
typedef __bf16 bf16x2_t __attribute__((ext_vector_type(2)));
__device__ __forceinline__ unsigned cvt_pk_bf16(float lo, float hi) { f32x2_t v = {lo, hi}; bf16x2_t b = __builtin_convertvector(v, bf16x2_t); return __builtin_bit_cast(unsigned, b); }
__device__ __forceinline__ unsigned f2bf(float f) { return cvt_pk_bf16(f, 0.f) & 0xffffu; }
__device__ __forceinline__ unsigned pk2(float lo, float hi) { return cvt_pk_bf16(lo, hi); }
__device__ __forceinline__ float wave_sum(float v) {
#pragma unroll
    for (int o = 1; o < 64; o <<= 1) v += __shfl_xor(v, o);
    return v;
}
#define LDS_WAIT() asm volatile("s_waitcnt lgkmcnt(0)" ::: "memory")
#define VM_WAIT() asm volatile("s_waitcnt vmcnt(0)" ::: "memory")

typedef __attribute__((address_space(1))) unsigned char g_u8_t;
#define OPAQUE_WS(ws) do { g_u8_t* w1_ = (g_u8_t*)(ws); asm volatile("" : "+s"(w1_)); ws = (unsigned char*)w1_; } while (0)
namespace pg8 {
constexpr int BM = 256, BK = 64, HALF = 128, HTB = HALF * BK * 2, STAGE_BYTES = 8 * HTB, NXCD = 8, WGM = 8;
__host__ __device__ __forceinline__ int lds_byte(int r, int c) { const int st = (r >> 4) * 2 + (c >> 5), rr = r & 15, cc = c & 31, ob = rr * 64 + cc * 2; return st * 1024 + (ob ^ (((ob >> 9) & 1) << 5)); }
__host__ __device__ __forceinline__ void stage_rc(int b, int& R, int& C) { const int st = b / 1024, sb = b % 1024, swz = sb ^ (((sb >> 9) & 1) << 5); R = (st >> 1) * 16 + swz / 64; C = (st & 1) * 32 + (swz % 64) / 2; }
__host__ __device__ __forceinline__ int perm32(int rho) { const int n = rho >> 4, i = rho & 15; return 8 * (i >> 2) + 4 * n + (i & 3); }

struct Unit { int pm, pn, kt0, nkt, z; };
struct Gemm { const bf16_t* A; const bf16_t* Bt; int lda, ldb; };

struct MainOrder {
    int nM, nN, nwg, G, c, nkt;
    __device__ __forceinline__ void init(int nM_, int nN_, int nkt_, int G_, int c_) { nM = nM_; nN = nN_; nwg = nM * nN; G = G_; c = c_; nkt = nkt_; asm volatile("" : "+s"(c)); }
    __device__ __forceinline__ void main_map(int L, int& pm, int& pn) const {
        int wgid = L; { const int q = nwg / NXCD, r = nwg % NXCD, xcd = wgid % NXCD, off = wgid / NXCD; wgid = (xcd < r ? xcd * (q + 1) : r * (q + 1) + (xcd - r) * q) + off; }
        const int nig = WGM * nN, gid = wgid / nig, fm = gid * WGM, gsz = (nM - fm) < WGM ? (nM - fm) : WGM;
        pm = fm + ((wgid % nig) % gsz); pn = (wgid % nig) / gsz;
    }
};
struct SplitOrder : MainOrder {
    int pmx, nsplit;
    __device__ __forceinline__ bool next(int i, Unit& u) const {
        const int L = i * G + c; const bool is_main = L < nwg; const int e = L - nwg; const bool ok = is_main || e < nsplit * nN;
        int pm = 0, pn = 0; main_map(is_main ? L : 0, pm, pn);
        const int per = nkt / nsplit, z = e / nN;
        Unit r; r.pm = is_main ? pm : pmx; r.pn = is_main ? pn : e % nN; r.kt0 = is_main ? 0 : z * per; r.nkt = is_main ? nkt : per; r.z = is_main ? -1 : z;
        u = r; return ok;
    }
};
struct PlainOrder : MainOrder {
    __device__ __forceinline__ bool next(int i, Unit& u) const {
        const int L = i * G + c; const bool ok = L < nwg; int pm = 0, pn = 0; main_map(ok ? L : 0, pm, pn);
        Unit r; r.pm = pm; r.pn = pn; r.kt0 = 0; r.nkt = nkt; r.z = -1; u = r; return ok;
    }
};
struct PrepOrder {
    int nM, nN, G, c, c0, by_m;
    __device__ __forceinline__ bool next(int i, Unit& u) const {
        const int i0 = c < c0 ? (c0 - c + G - 1) / G : 0; const int L = (i + i0) * G + c - c0; const bool ok = L < nM * nN;
        const int pm = ok ? L / nN : 0, pn = ok ? L % nN : 0; const int h = by_m ? pm : pn;
        int four = 4; asm volatile("" : "+s"(four));
        Unit r; r.pm = pm; r.pn = pn; r.kt0 = 4 * (h >> 1); r.nkt = four; r.z = -1; u = r; return ok;
    }
};

struct EpiF32 {
    static constexpr bool PERM = false;
    float* C; int ldc; float* slab;
    __device__ __forceinline__ void operator()(const f32x4 (&acc)[2][2][4][2], const Unit& u, int wr, int wc, int fr, int fq) const {
        const bool split = u.z >= 0;
        float* base = (split ? slab + (size_t)u.z * 128 * ldc : C + (size_t)u.pm * BM * ldc) + (size_t)(wr * 64 + fr) * ldc + u.pn * BM + wc * 32 + 4 * fq;
#pragma unroll
        for (int ai = 0; ai < 2; ++ai) {
            if (ai == 1 && split) break;
#pragma unroll
            for (int m = 0; m < 4; ++m) { float* rowp = base + (size_t)(ai * HALF + m * 16) * ldc;
#pragma unroll
                for (int bj = 0; bj < 2; ++bj)
#pragma unroll
                    for (int n = 0; n < 2; ++n) *(f32x4*)(rowp + bj * HALF + n * 16) = acc[ai][bj][m][n]; }
        }
    }
};
struct EpiMix {
    static constexpr bool PERM = true;
    bf16_t* C; int ldc; float* slab;
    __device__ __forceinline__ void operator()(const f32x4 (&acc)[2][2][4][2], const Unit& u, int wr, int wc, int fr, int fq) const {
        const int col0 = u.pn * BM + wc * 32 + 8 * fq;
        if (u.z < 0) {
            const int row0 = u.pm * BM + wr * 64 + fr;
#pragma unroll
            for (int ai = 0; ai < 2; ++ai)
#pragma unroll
                for (int m = 0; m < 4; ++m) { bf16_t* rowp = C + (size_t)(row0 + ai * HALF + m * 16) * ldc + col0;
#pragma unroll
                    for (int bj = 0; bj < 2; ++bj) { const f32x4 v0 = acc[ai][bj][m][0], v1 = acc[ai][bj][m][1];
                        u32x4 w; w.x = cvt_pk_bf16(v0[0], v0[1]); w.y = cvt_pk_bf16(v0[2], v0[3]); w.z = cvt_pk_bf16(v1[0], v1[1]); w.w = cvt_pk_bf16(v1[2], v1[3]);
                        *(u32x4*)(rowp + bj * HALF) = w; } }
        } else {
            float* base = slab + (size_t)u.z * 128 * ldc + (size_t)(wr * 64 + fr) * ldc + col0;
#pragma unroll
            for (int m = 0; m < 4; ++m)
#pragma unroll
                for (int bj = 0; bj < 2; ++bj) { float* p = base + (size_t)(m * 16) * ldc + bj * HALF; *(f32x4*)p = acc[0][bj][m][0]; *(f32x4*)(p + 4) = acc[0][bj][m][1]; }
        }
    }
};
struct EpiBf16 {
    static constexpr bool PERM = true;
    bf16_t* C; int ldc;
    __device__ __forceinline__ void operator()(const f32x4 (&acc)[2][2][4][2], const Unit& u, int wr, int wc, int fr, int fq) const {
        const int row0 = u.pm * BM + wr * 64 + fr, col0 = u.pn * BM + wc * 32 + 8 * fq;
#pragma unroll
        for (int ai = 0; ai < 2; ++ai)
#pragma unroll
            for (int m = 0; m < 4; ++m) { bf16_t* rowp = C + (size_t)(row0 + ai * HALF + m * 16) * ldc + col0;
#pragma unroll
                for (int bj = 0; bj < 2; ++bj) { const f32x4 v0 = acc[ai][bj][m][0], v1 = acc[ai][bj][m][1];
                    u32x4 w; w.x = cvt_pk_bf16(v0[0], v0[1]); w.y = cvt_pk_bf16(v0[2], v0[3]); w.z = cvt_pk_bf16(v1[0], v1[1]); w.w = cvt_pk_bf16(v1[2], v1[3]);
                    *(u32x4*)(rowp + bj * HALF) = w; } }
    }
};
struct EpiSwiglu {
    static constexpr bool PERM = true;
    bf16_t* C; int ldc;
    __device__ __forceinline__ void operator()(const f32x4 (&acc)[2][2][4][2], const Unit& u, int wr, int wc, int fr, int fq) const {
        const int row0 = u.pm * BM + wr * 64 + fr, col0 = u.pn * HALF + wc * 32 + 8 * fq;
#pragma unroll
        for (int ai = 0; ai < 2; ++ai)
#pragma unroll
            for (int m = 0; m < 4; ++m) { float o[8];
#pragma unroll
                for (int n = 0; n < 2; ++n)
#pragma unroll
                    for (int j = 0; j < 4; ++j) { const float g = acc[ai][0][m][n][j], up = acc[ai][1][m][n][j]; o[4 * n + j] = g * __builtin_amdgcn_rcpf(1.f + __expf(-g)) * up; }
                u32x4 w; w.x = cvt_pk_bf16(o[0], o[1]); w.y = cvt_pk_bf16(o[2], o[3]); w.z = cvt_pk_bf16(o[4], o[5]); w.w = cvt_pk_bf16(o[6], o[7]);
                *(u32x4*)(C + (size_t)(row0 + ai * HALF + m * 16) * ldc + col0) = w; }
    }
};
struct EpiQ {
    static constexpr bool PERM = true;
    bf16_t* C; const f32x2* rope; float scale;
    __device__ __forceinline__ void operator()(const f32x4 (&acc)[2][2][4][2], const Unit& u, int wr, int wc, int fr, int fq) const {
        const int row0 = u.pm * BM + wr * 64 + fr, col0 = u.pn * BM + wc * 32 + 8 * fq;
        const bool rp = u.pn >= 8;
#pragma unroll
        for (int ai = 0; ai < 2; ++ai)
#pragma unroll
            for (int m = 0; m < 4; ++m) { const int row = row0 + ai * HALF + m * 16;
                int pidx = row < MP ? (row & (SEQ - 1)) : (SEQ + ((row - MP) & 3)); if (row >= MV) pidx = 0;
                bf16_t* rowp = C + (size_t)row * NQ + col0;
#pragma unroll
                for (int bj = 0; bj < 2; ++bj) { f32x4 v0 = acc[ai][bj][m][0], v1 = acc[ai][bj][m][1];
                    if (rp) { const int i0 = ((col0 + bj * HALF) & 63) >> 1; const f32x2* t = rope + pidx * 32 + i0;
                        const f32x2 c0 = t[0], c1 = t[1], c2 = t[2], c3 = t[3];
                        const f32x4 r0 = {v0[0] * c0.x - v0[1] * c0.y, v0[1] * c0.x + v0[0] * c0.y, v0[2] * c1.x - v0[3] * c1.y, v0[3] * c1.x + v0[2] * c1.y};
                        const f32x4 r1 = {v1[0] * c2.x - v1[1] * c2.y, v1[1] * c2.x + v1[0] * c2.y, v1[2] * c3.x - v1[3] * c3.y, v1[3] * c3.x + v1[2] * c3.y};
                        v0 = r0; v1 = r1; }
                    v0 = v0 * scale; v1 = v1 * scale;
                    if (rp) {
                        const int cc = col0 + bj * HALF - 2048, hh = cc >> 6, i0 = (cc & 63) >> 1; bf16_t* qp = C + (size_t)row * NQ + 2048 + hh * 64 + i0;
                        u32x2 a, b; a.x = cvt_pk_bf16(v0[0], v0[2]); a.y = cvt_pk_bf16(v1[0], v1[2]); b.x = cvt_pk_bf16(v0[1], v0[3]); b.y = cvt_pk_bf16(v1[1], v1[3]);
                        *(u32x2*)qp = a; *(u32x2*)(qp + 32) = b;
                    } else {
                    u32x4 w; w.x = cvt_pk_bf16(v0[0], v0[1]); w.y = cvt_pk_bf16(v0[2], v0[3]); w.z = cvt_pk_bf16(v1[0], v1[1]); w.w = cvt_pk_bf16(v1[2], v1[3]);
                    *(u32x4*)(rowp + bj * HALF) = w; } } }
    }
};

template <class Epi, class Sched>
__device__ __forceinline__ void gemm_phase(LAS unsigned char* lds, const Gemm g, const Sched& S, const Epi& E) {
    int tid = threadIdx.x; asm volatile("" : "+v"(tid));
    const int wid = __builtin_amdgcn_readfirstlane(tid >> 6), lane = tid & 63, wr = wid >> 2, wc = wid & 3, fr = lane & 15, fq = lane >> 4;
    unsigned voffA[2], voffB[2];
#pragma unroll
    for (int i = 0; i < 2; ++i) { int R, C; stage_rc(tid * 16 + i * 8192, R, C); const int Rb = Epi::PERM ? ((R & ~31) + perm32(R & 31)) : R;
        voffA[i] = (unsigned)(R * g.lda + C) * 2u; voffB[i] = (unsigned)(Rb * g.ldb + C) * 2u; }
    const size_t kstep = (size_t)(BK * 2);
    const size_t hstepA = (size_t)HALF * g.lda * 2, hstepB = (size_t)HALF * g.ldb * 2;
    const size_t tstepA = 2 * hstepA, tstepB = 2 * hstepB;
    const unsigned ldsw = (unsigned)wid * 1024u;
    const int aoff = lds_byte(wr * 64 + fr, fq * 8), boff = lds_byte(wc * 32 + fr, fq * 8);
#define PG8_SA(b, h) (((b) * 2 + (h)) * HTB)
#define PG8_SB(b, h) ((4 + (b) * 2 + (h)) * HTB)
#define PG8_STAGE(bufoff, gbase, voff) do { _Pragma("unroll") for (int _i = 0; _i < 2; ++_i) \
        __builtin_amdgcn_global_load_lds((const unsigned*)((const char*)(gbase) + (voff)[_i]), (LAS unsigned*)(lds + (bufoff) + ldsw + _i * 8192), 16, 0, 0); } while (0)
#define PG8_LDA(dst, b, h) do { _Pragma("unroll") for (int m = 0; m < 4; ++m) _Pragma("unroll") for (int k = 0; k < 2; ++k) dst[m][k] = *(const LAS bf16x8*)(lds + PG8_SA(b, h) + aoff + m * 2048 + k * 1024); } while (0)
#define PG8_LDB(dst, b, h) do { _Pragma("unroll") for (int n = 0; n < 2; ++n) _Pragma("unroll") for (int k = 0; k < 2; ++k) dst[n][k] = *(const LAS bf16x8*)(lds + PG8_SB(b, h) + boff + n * 2048 + k * 1024); } while (0)
#define PG8_MMA(ai, bj, At, Bt) do { __builtin_amdgcn_s_setprio(1); _Pragma("unroll") for (int m = 0; m < 4; ++m) _Pragma("unroll") for (int n = 0; n < 2; ++n) _Pragma("unroll") for (int k = 0; k < 2; ++k) \
        acc[ai][bj][m][n] = __builtin_amdgcn_mfma_f32_16x16x32_bf16(Bt[n][k], At[m][k], acc[ai][bj][m][n], 0, 0, 0); __builtin_amdgcn_s_setprio(0); } while (0)
#define PG8_WAIT_V(n) asm volatile("s_waitcnt vmcnt(" #n ")" ::: "memory")
#define PG8_WAIT_L(n) asm volatile("s_waitcnt lgkmcnt(" #n ")" ::: "memory")
#define PG8_BAR __builtin_amdgcn_s_barrier()
#define PG8_SCHED __builtin_amdgcn_sched_barrier(0)
    Unit cur, nxt; int ui = 0;
    if (!S.next(0, cur)) return;
    f32x4 acc[2][2][4][2];
#pragma unroll
    for (int a = 0; a < 2; ++a)
#pragma unroll
        for (int b = 0; b < 2; ++b)
#pragma unroll
            for (int m = 0; m < 4; ++m)
#pragma unroll
                for (int n = 0; n < 2; ++n) acc[a][b][m][n] = (f32x4){0.f, 0.f, 0.f, 0.f};
    bf16x8 At[4][2], B0[2][2], B1[2][2];
    const char* cA = (const char*)g.A + (size_t)cur.pm * tstepA + (size_t)cur.kt0 * kstep; const char* cB = (const char*)g.Bt + (size_t)cur.pn * tstepB + (size_t)cur.kt0 * kstep;
    PG8_STAGE(PG8_SB(0, 0), cB, voffB); PG8_STAGE(PG8_SB(0, 1), cB + hstepB, voffB); PG8_STAGE(PG8_SA(0, 0), cA, voffA); PG8_STAGE(PG8_SA(0, 1), cA + hstepA, voffA);
    if (wr == 1) PG8_BAR;
    PG8_WAIT_V(2); PG8_BAR;
    PG8_STAGE(PG8_SB(1, 0), cB + kstep, voffB); PG8_STAGE(PG8_SA(1, 0), cA + kstep, voffA); PG8_STAGE(PG8_SB(1, 1), cB + hstepB + kstep, voffB);
    PG8_WAIT_V(6); PG8_BAR;
    for (;;) {
        const bool has_next = S.next(ui + 1, nxt);
        const char* nA = has_next ? (const char*)g.A + (size_t)nxt.pm * tstepA + (size_t)nxt.kt0 * kstep : cA;
        const char* nB = has_next ? (const char*)g.Bt + (size_t)nxt.pn * tstepB + (size_t)nxt.kt0 * kstep : cB;
        const int nt = cur.nkt;
        for (int t = 0; t < nt; t += 2) {
            const bool last = (t == nt - 2);
            const char* a1 = cA + (size_t)(t + 1) * kstep;
            const char* a2 = last ? nA : cA + (size_t)(t + 2) * kstep; const char* b2 = last ? nB : cB + (size_t)(t + 2) * kstep;
            const char* a3 = a2 + kstep; const char* b3 = b2 + kstep;
            PG8_LDB(B0, 0, 0); PG8_LDB(B1, 0, 1); PG8_SCHED; PG8_LDA(At, 0, 0); PG8_STAGE(PG8_SA(1, 1), a1 + hstepA, voffA);
            PG8_WAIT_V(8); PG8_WAIT_L(0); PG8_BAR; PG8_MMA(0, 0, At, B0); PG8_MMA(0, 1, At, B1); PG8_BAR; PG8_SCHED;
            PG8_LDA(At, 0, 1); PG8_STAGE(PG8_SB(0, 0), b2, voffB); PG8_STAGE(PG8_SB(0, 1), b2 + hstepB, voffB); PG8_STAGE(PG8_SA(0, 0), a2, voffA);
            PG8_WAIT_V(8); PG8_WAIT_L(0); PG8_BAR; PG8_MMA(1, 0, At, B0); PG8_MMA(1, 1, At, B1); PG8_BAR; PG8_SCHED;
            PG8_LDB(B0, 1, 0); PG8_LDB(B1, 1, 1); PG8_SCHED; PG8_LDA(At, 1, 0); PG8_STAGE(PG8_SA(0, 1), a2 + hstepA, voffA);
            PG8_WAIT_V(8); PG8_WAIT_L(0); PG8_BAR; PG8_MMA(0, 0, At, B0); PG8_MMA(0, 1, At, B1); PG8_BAR; PG8_SCHED;
            PG8_LDA(At, 1, 1); PG8_STAGE(PG8_SB(1, 0), b3, voffB); PG8_STAGE(PG8_SB(1, 1), b3 + hstepB, voffB); PG8_STAGE(PG8_SA(1, 0), a3, voffA);
            PG8_WAIT_V(8); PG8_WAIT_L(0); PG8_BAR; PG8_MMA(1, 0, At, B0); PG8_MMA(1, 1, At, B1); PG8_BAR; PG8_SCHED;
        }
        if (wr == 0) PG8_BAR;
        E(acc, cur, wr, wc, fr, fq);
        if (!has_next) break;
#pragma unroll
        for (int a = 0; a < 2; ++a)
#pragma unroll
            for (int b = 0; b < 2; ++b)
#pragma unroll
                for (int m = 0; m < 4; ++m)
#pragma unroll
                    for (int n = 0; n < 2; ++n) acc[a][b][m][n] = (f32x4){0.f, 0.f, 0.f, 0.f};
        cur = nxt; cA = nA; cB = nB; ++ui;
        if (wr == 1) PG8_BAR;
    }
    PG8_WAIT_V(0);
    PG8_BAR;
#undef PG8_SA
#undef PG8_SB
#undef PG8_STAGE
#undef PG8_LDA
#undef PG8_LDB
#undef PG8_MMA
#undef PG8_WAIT_V
#undef PG8_WAIT_L
#undef PG8_BAR
#undef PG8_SCHED
}
}


#define XB_TMO      128
#define XB_XCNT(j)  (256  + 64 * (j))
#define XB_XSUB(j)  (1280 + 64 * (j))
#define XB_XGEN(j)  (2304 + 64 * (j))
#define XB_TOP      3328
#define XB_TOPGEN   3392
#define XCD_BAR_WORDS 3456
#define XB_SPIN_CAP (1u << 22)
__device__ __forceinline__ unsigned xb_ld(unsigned* p)              { return __hip_atomic_load(p, __ATOMIC_RELAXED, __HIP_MEMORY_SCOPE_AGENT); }
__device__ __forceinline__ unsigned xb_add(unsigned* p, unsigned v) { return __hip_atomic_fetch_add(p, v, __ATOMIC_RELAXED, __HIP_MEMORY_SCOPE_AGENT); }
__device__ __forceinline__ unsigned xb_xcc_id() { return (unsigned)__builtin_amdgcn_s_getreg((3 << 11) | 20) & 0xFu; }
#define XB_SPIN(cond, bar) do { unsigned _sp = 0; while (cond) { __builtin_amdgcn_s_sleep(1); \
    if ((++_sp & 255u) == 0u) { if (xb_ld(&(bar)[XB_TMO])) break; if (_sp > XB_SPIN_CAP) { atomicAdd(&(bar)[XB_TMO], 1u); break; } } } } while (0)
struct XcdBarrier { unsigned* bar; unsigned x; volatile LAS unsigned* st; };
__device__ __forceinline__ XcdBarrier xcd_barrier_post(unsigned* bar, volatile LAS unsigned* st) {
    XcdBarrier b; b.bar = bar; b.x = xb_xcc_id(); b.st = st;
    if (threadIdx.x == 0) (void)xb_add(&bar[XB_XCNT(b.x)], 1u);
    return b;
}
__device__ __forceinline__ void xcd_barrier_complete(unsigned* bar, unsigned x, unsigned& nloc, unsigned& nx) {
    const unsigned G = gridDim.x * gridDim.y * gridDim.z;
    unsigned sum, cnt, mine, sp = 0u;
    for (;;) {
        sum = 0u; cnt = 0u; mine = 0u;
#pragma unroll
        for (unsigned j = 0; j < 16; ++j) { const unsigned c = xb_ld(&bar[XB_XCNT(j)]); sum += c; cnt += (c > 0u) ? 1u : 0u; mine = (j == x) ? c : mine; }
        if (sum == G) break;
        __builtin_amdgcn_s_sleep(1);
        if ((++sp & 255u) == 0u) { if (xb_ld(&bar[XB_TMO])) break; if (sp > XB_SPIN_CAP) { atomicAdd(&bar[XB_TMO], 1u); break; } }
    }
    nloc = mine > 0u ? mine : 1u; nx = cnt > 0u ? cnt : 1u;
}
__device__ __forceinline__ void xcd_barrier(const XcdBarrier& b0) {
    XcdBarrier b; b.bar = b0.bar; b.st = b0.st; b.x = (unsigned)__builtin_amdgcn_readfirstlane((int)xb_xcc_id());
    asm volatile("s_waitcnt vmcnt(0)" ::: "memory");
    __syncthreads();
    if (threadIdx.x == 0) {
        unsigned* bar = b.bar;
        __builtin_amdgcn_s_waitcnt(0);
        unsigned nloc = b.st[0], nx = b.st[1];
        if (nloc == 0u) { xcd_barrier_complete(bar, b.x, nloc, nx); b.st[0] = nloc; b.st[1] = nx; }
        const unsigned old = xb_add(&bar[XB_XSUB(b.x)], 1u);
        const unsigned gen = old / nloc;
        if (old + 1u == (gen + 1u) * nloc) {
            __builtin_amdgcn_fence(__ATOMIC_RELEASE, "agent");
            asm volatile("s_waitcnt vmcnt(0)" ::: "memory");
            const unsigned og = xb_add(&bar[XB_TOP], 1u);
            const unsigned tg = og / nx;
            if (og + 1u == (tg + 1u) * nx) xb_add(&bar[XB_TOPGEN], 1u);
            else XB_SPIN(xb_ld(&bar[XB_TOPGEN]) == tg, bar);
            __builtin_amdgcn_fence(__ATOMIC_ACQUIRE, "agent");
            xb_add(&bar[XB_XGEN(b.x)], 1u);
            asm volatile("s_waitcnt vmcnt(0)" ::: "memory");
        } else {
            XB_SPIN(xb_ld(&bar[XB_XGEN(b.x)]) == gen, bar);
            __builtin_amdgcn_fence(__ATOMIC_ACQUIRE, "agent");
            asm volatile("s_waitcnt vmcnt(0)" ::: "memory");
        }
    }
    __syncthreads();
}

constexpr int CW_HAND = 32768;
__device__ __forceinline__ void hand_signal(unsigned* cnt) {
    asm volatile("s_waitcnt vmcnt(0)" ::: "memory");
    __syncthreads();
    if (threadIdx.x == 0) { __builtin_amdgcn_fence(__ATOMIC_RELEASE, "agent"); asm volatile("s_waitcnt vmcnt(0)" ::: "memory");
        __hip_atomic_fetch_add(cnt, 1u, __ATOMIC_RELAXED, __HIP_MEMORY_SCOPE_AGENT); }
}
__device__ __forceinline__ void hand_wait(unsigned* cnt, unsigned need) {
    if (threadIdx.x == 0) { unsigned sp = 0;
        while (__hip_atomic_load(cnt, __ATOMIC_RELAXED, __HIP_MEMORY_SCOPE_AGENT) < need) { __builtin_amdgcn_s_sleep(2); if (++sp > (1u << 24)) break; }
        __builtin_amdgcn_fence(__ATOMIC_ACQUIRE, "agent"); asm volatile("s_waitcnt vmcnt(0)" ::: "memory"); }
    __syncthreads();
}

constexpr int LDS_BYTES = 147456;
struct Params {
    const float* in[22]; const int* page_table; float* out; unsigned char* ws; int pad0, pad1;
};
struct Frame {
    LAS unsigned char* lds;
    int tid, lane, wave, G, c;
    const Params* p;
};

__device__ __forceinline__ void transpose_item(const float* W, int ldw, int k0, int n_src0, int n_valid, bf16_t* WT, int ldd, int row_base, int row_stride, LAS float* scr, int lane) {
    const int n4 = (lane & 7) * 4;
    f32x4 v[8];
#pragma unroll
    for (int i = 0; i < 8; ++i) { const int kk = 8 * i + (lane >> 3); v[i] = (n_src0 + n4 < n_valid) ? __builtin_nontemporal_load((const f32x4*)(W + (size_t)(k0 + kk) * ldw + n_src0 + n4)) : (f32x4){0.f, 0.f, 0.f, 0.f}; }
#pragma unroll
    for (int i = 0; i < 8; ++i) { LAS float* d = scr + (8 * i + (lane >> 3)) * 33 + n4; d[0] = v[i].x; d[1] = v[i].y; d[2] = v[i].z; d[3] = v[i].w; }
    LDS_WAIT(); asm volatile("" ::: "memory");
    const int c = lane & 7;
#pragma unroll
    for (int j = 0; j < 4; ++j) { const int n = (lane >> 3) + 8 * j; const LAS float* s = scr + (8 * c) * 33 + n;
        u32x4 o; o.x = pk2(s[0 * 33], s[1 * 33]); o.y = pk2(s[2 * 33], s[3 * 33]); o.z = pk2(s[4 * 33], s[5 * 33]); o.w = pk2(s[6 * 33], s[7 * 33]);
        if (n_src0 + n < n_valid) *(u32x4*)(WT + (size_t)(row_base + n * row_stride) * ldd + k0 + 8 * c) = o; }
    LDS_WAIT(); asm volatile("" ::: "memory");
}
__device__ __forceinline__ void rms_row_to_bf16(const float* xrow, const float* w, bf16_t* orow, int lane) {
    const f32x4* xr = (const f32x4*)xrow + lane; const f32x4* wr = (const f32x4*)w + lane;
    f32x4 v[4]; float s = 0.f;
#pragma unroll
    for (int j = 0; j < 4; ++j) { v[j] = xr[64 * j]; s += (v[j].x * v[j].x + v[j].y * v[j].y) + (v[j].z * v[j].z + v[j].w * v[j].w); }
    const float rs = rsqrtf(wave_sum(s) * (1.f / DM) + RMS_EPS);
    u32x2* o8 = (u32x2*)orow + lane;
#pragma unroll
    for (int j = 0; j < 4; ++j) { const f32x4 g = wr[64 * j]; u32x2 o; o.x = pk2(v[j].x * rs * g.x, v[j].y * rs * g.y); o.y = pk2(v[j].z * rs * g.z, v[j].w * rs * g.w); o8[64 * j] = o; }
}

__device__ __forceinline__ void p0_prologue(Frame& F) {
    const Params& P = *F.p;
    unsigned char* ws = P.ws;
    LAS float* scr = (LAS float*)(F.lds + F.wave * 16384);
    const int gw = F.c * NWAVES + F.wave, NGW = F.G * NWAVES;
    const int gt = F.c * NTHREADS + F.tid, NGT = F.G * NTHREADS;
    constexpr int I_IN0 = 16 * 22, I_ROPE = 6 * 16, I_WO = 16 * 32, I_F1 = 16 * 176, I_F2 = 44 * 32, I_DIN = 16 * 129, I_DO = 16 * 32;
    constexpr int NITEMS = I_IN0 + I_ROPE + I_WO + 2 * I_F1 + 2 * I_F2 + I_DIN + I_DO;
    for (int it = gw; it < NITEMS; it += NGW) {
        int r = it;
        if (r < I_IN0) { const int kb = r / 22, nb = r % 22; transpose_item(P.in[7], NIN0, 64 * kb, 32 * nb, NIN0, (bf16_t*)(ws + WS_WT_IN0), 1024, 32 * nb, 1, scr, F.lane); continue; } r -= I_IN0;
        if (r < I_ROPE) { const int kb = r / 16, hs = r % 16, h = hs >> 1, s = hs & 1;
            transpose_item(P.in[10], 1536, 64 * kb, h * 192 + 128 + 32 * s, 1536, (bf16_t*)(ws + WS_WT_Q), 512, 2048 + h * 64 + s, 2, scr, F.lane); continue; } r -= I_ROPE;
        if (r < I_WO) { const int kb = r / 32, nb = r % 32; transpose_item(P.in[13], 1024, 64 * kb, 32 * nb, 1024, (bf16_t*)(ws + WS_WOT), 1024, 32 * nb, 1, scr, F.lane); continue; } r -= I_WO;
        if (r < 2 * I_F1) { const int l = r / I_F1, q = r % I_F1, kb = q / 176, nb = q % 176; const int n0 = 32 * nb; const int nn = n0 < DFF ? n0 : n0 - DFF;
            const int row = 256 * (nn / 128) + (n0 < DFF ? 0 : 128) + (nn % 128);
            transpose_item(P.in[20] + (size_t)l * 1024 * 5632, 5632, 64 * kb, n0, 5632, (bf16_t*)(ws + WS_WT_F1) + (size_t)l * 5632 * 1024, 1024, row, 1, scr, F.lane); continue; } r -= 2 * I_F1;
        if (r < 2 * I_F2) { const int l = r / I_F2, q = r % I_F2, kb = q / 32, nb = q % 32;
            transpose_item(P.in[21] + (size_t)l * DFF * 1024, 1024, 64 * kb, 32 * nb, 1024, (bf16_t*)(ws + WS_WT_F2) + (size_t)l * 1024 * DFF, DFF, 32 * nb, 1, scr, F.lane); continue; } r -= 2 * I_F2;
        if (r < I_DIN) { const int kb = r / 129, nb = r % 129; transpose_item(P.in[14], DN_N, 64 * kb, 32 * nb, DN_N, (bf16_t*)(ws + WS_WT_DIN), 1024, 32 * nb, 1, scr, F.lane); continue; } r -= I_DIN;
        { const int kb = r / 32, nb = r % 32; transpose_item(P.in[19], 1024, 64 * kb, 32 * nb, 1024, (bf16_t*)(ws + WS_WT_DO), 1024, 32 * nb, 1, scr, F.lane); }
    }
    {
        constexpr int N_BD = 2048 * 128, N_UQ = 512 * 128, N_PADIN = 64 * 128, N_PADD = (DN_NP - DN_N) * 128;
        for (int it = gt; it < 2 * N_BD + N_UQ + N_PADIN + N_PADD; it += NGT) {
            int r = it; u32x4 o = {0u, 0u, 0u, 0u}; bf16_t* dst;
            if (r < 2 * N_BD) { const int which = r / N_BD, q = r % N_BD, row = q >> 7, c8 = (q & 127) * 8, h = row >> 8, rr = row & 255;
                const float* src = (which ? P.in[11] : P.in[12]) + ((size_t)h * 256 + rr) * 128;
                if ((c8 >> 7) == h) { const f32x4 a = *(const f32x4*)(src + (c8 & 127)), b = *(const f32x4*)(src + (c8 & 127) + 4); o.x = pk2(a.x, a.y); o.y = pk2(a.z, a.w); o.z = pk2(b.x, b.y); o.w = pk2(b.z, b.w); }
                dst = (bf16_t*)(ws + (which ? WS_BD_UK : WS_BD_UV)) + (size_t)row * 1024 + c8;
            } else if ((r -= 2 * N_BD) < N_UQ) { const int row = r >> 7, c8 = (r & 127) * 8, h = c8 >> 7, n = c8 & 127;
                if (row < 384) { const float* src = P.in[10] + (size_t)row * 1536 + h * 192 + n; const f32x4 a = *(const f32x4*)src, b = *(const f32x4*)(src + 4); o.x = pk2(a.x, a.y); o.y = pk2(a.z, a.w); o.z = pk2(b.x, b.y); o.w = pk2(b.z, b.w); }
                dst = (bf16_t*)(ws + WS_UQN) + (size_t)row * 1024 + c8;
            } else if ((r -= N_UQ) < N_PADIN) { dst = (bf16_t*)(ws + WS_WT_IN0) + (size_t)(NIN0 + (r >> 7)) * 1024 + (r & 127) * 8;
            } else { r -= N_PADIN; dst = (bf16_t*)(ws + WS_WT_DIN) + (size_t)(DN_N + (r >> 7)) * 1024 + (r & 127) * 8; }
            *(u32x4*)dst = o;
        }
    }
    for (int it = gt; it < 2052 * 32; it += NGT) { const int pi = it >> 5, i = it & 31; const float pos = (float)(pi < SEQ ? pi : PAST + (pi - SEQ));
        const float freq = exp2f(-(float)i * (13.287712379549449f / 32.0f)); const float ang = pos * freq;
        ((f32x2*)(ws + WS_ROPE))[it] = (f32x2){cosf(ang), sinf(ang)}; }
    for (int m = gw; m < MT; m += NGW) {
        bf16_t* orow = (bf16_t*)(ws + WS_U) + (size_t)m * DM;
        if (m < MV) { const float* xrow = m < MP ? P.in[0] + (size_t)m * DM : P.in[1] + (size_t)(m - MP) * DM; rms_row_to_bf16(xrow, P.in[6], orow, F.lane); }
        else { u32x4 z = {0u, 0u, 0u, 0u}; ((u32x4*)orow)[F.lane] = z; ((u32x4*)orow)[F.lane + 64] = z; }
    }
}

__device__ __forceinline__ void m2_rows(Frame& F) {
    const Params& P = *F.p; unsigned char* ws = P.ws; OPAQUE_WS(ws);
    const int gw = F.c * NWAVES + F.wave, NGW = F.G * NWAVES, lane = F.lane;
    const float* gq = P.in[8]; const float* gkv = P.in[9];
    const f32x2* rope = (const f32x2*)(ws + WS_ROPE);
    for (int m = gw; m < MV; m += NGW) {
        const float* a = (const float*)(ws + WS_A0) + (size_t)m * NIN0P;
        float v[11];
#pragma unroll
        for (int j = 0; j < 11; ++j) v[j] = __builtin_nontemporal_load(a + lane + 64 * j);
        float sq = 0.f, sk = 0.f;
#pragma unroll
        for (int j = 0; j < 6; ++j) sq += v[j] * v[j];
#pragma unroll
        for (int j = 6; j < 10; ++j) sk += v[j] * v[j];
        const float rq = rsqrtf(wave_sum(sq) * (1.f / Q_LORA) + RMS_EPS), rk = rsqrtf(wave_sum(sk) * (1.f / KV_LORA) + RMS_EPS);
        bf16_t* cq = (bf16_t*)(ws + WS_CQ) + (size_t)m * Q_LORA;
#pragma unroll
        for (int j = 0; j < 6; ++j) cq[lane + 64 * j] = (bf16_t)f2bf(v[j] * rq * gq[lane + 64 * j]);
        float* orow = P.out + O_ROWS + (size_t)m * MLA_ROW; bf16_t* rb = (bf16_t*)(ws + WS_ROWSB) + (size_t)m * MLA_ROW;
#pragma unroll
        for (int j = 0; j < 4; ++j) { const float y = v[6 + j] * rk * gkv[lane + 64 * j]; __builtin_nontemporal_store(y, orow + lane + 64 * j); rb[lane + 64 * j] = (bf16_t)f2bf(y); }
        const int pidx = m < MP ? (m & (SEQ - 1)) : (SEQ + ((m - MP) & 3));
        const int i = lane & 31; const f32x2 cs = rope[pidx * 32 + i];
        const float other = __shfl_xor(v[10], 32);
        const float y = lane < 32 ? v[10] * cs.x - other * cs.y : v[10] * cs.x + other * cs.y;
        __builtin_nontemporal_store(y, orow + 256 + lane); rb[256 + lane] = (bf16_t)f2bf(y);
    }
}


#define LDS_BARRIER() do { asm volatile("s_waitcnt lgkmcnt(0)" ::: "memory"); __builtin_amdgcn_s_barrier(); asm volatile("" ::: "memory"); } while (0)
namespace attn {
typedef short v4i16_t __attribute__((ext_vector_type(4)));
constexpr int TILE_BYTES = 64 * 640;
__device__ __forceinline__ int koff(int row, int ch) { return 5120 * (row >> 3) + 512 * (ch >> 2) + 64 * (row & 7) + 16 * ((ch & 3) ^ ((row >> 2) & 3)); }

__device__ __forceinline__ float hmax32(float x) { const unsigned u = __builtin_bit_cast(unsigned, x); auto b = __builtin_amdgcn_permlane32_swap(u, u, false, false); return fmaxf(__builtin_bit_cast(float, b[0]), __builtin_bit_cast(float, b[1])); }
struct State { f32x4 o[16]; float m, l; };
struct Addr { int kb0, kb1, tb00, tb01, tb10, tb11; };
__device__ __forceinline__ Addr make_addr(int lane) {
    const int g = lane >> 4, rho = lane & 15, q4 = rho >> 2, p4 = lane & 3; Addr a;
    a.kb0 = 5120 * q4 + 64 * (rho & 3) + 16 * (g ^ (2 * (q4 & 1)));  a.kb1 = a.kb0 ^ 16;
    const int t0 = 5120 * g + 64 * q4 + 8 * (p4 & 1) + 32 * (g & 1) + 16 * (p4 >> 1);
    a.tb00 = t0; a.tb01 = t0 ^ 16; a.tb10 = t0 ^ 32; a.tb11 = t0 ^ 48;
    return a;
}
__device__ __forceinline__ void pv_load(bf16x8 (&vf)[8], const LAS unsigned char* buf, const Addr& A, int i) {
#pragma unroll
    for (int c = 0; c < 4; ++c) { const int cb = 4 * i + c;
        const LAS unsigned char* v0 = buf + ((cb & 1) ? A.tb10 : A.tb00) + 512 * (cb >> 1);
        const LAS unsigned char* v1 = buf + ((cb & 1) ? A.tb11 : A.tb01) + 512 * (cb >> 1) + 256;
#pragma unroll
        for (int ks = 0; ks < 2; ++ks) {
            const v4i16_t t0 = __builtin_amdgcn_ds_read_tr16_b64_v4i16((LAS v4i16_t*)(v0 + 20480 * ks));
            const v4i16_t t1 = __builtin_amdgcn_ds_read_tr16_b64_v4i16((LAS v4i16_t*)(v1 + 20480 * ks));
            vf[2 * c + ks] = __builtin_shufflevector(t0, t1, 0, 1, 2, 3, 4, 5, 6, 7); } }
}
__device__ __forceinline__ void pv_mma(State& st, const bf16x8 (&vf)[8], const bf16x8 (&pf)[2], int i) {
#pragma unroll
    for (int c = 0; c < 4; ++c)
#pragma unroll
        for (int ks = 0; ks < 2; ++ks) st.o[4 * i + c] = __builtin_amdgcn_mfma_f32_16x16x32_bf16(vf[2 * c + ks], pf[ks], st.o[4 * i + c], 0, 0, 0);
}
__device__ __forceinline__ void tile_scores(const LAS unsigned char* buf, const Addr& A, const bf16x8 (&qf)[10], State& st, int limit, bool need_mask, int lane, bf16x8 (&pf)[2], bf16x8 (&vf0)[8]) {
    const int g = lane >> 4;
    f32x4 sacc[4];
    __builtin_amdgcn_s_setprio(1);
    bf16x8 kf[2][5];
#pragma unroll
    for (int b = 0; b < 4; ++b) sacc[b] = (f32x4){0.f, 0.f, 0.f, 0.f};
#pragma unroll
    for (int j = 0; j < 5; ++j) kf[0][j] = *(const LAS bf16x8*)(buf + A.kb0 + 512 * j);
#pragma unroll
    for (int i = 0; i < 8; ++i) {
        if (i + 1 < 8) { const int b1 = (i + 1) >> 1; const LAS unsigned char* kp = buf + ((b1 & 1) ? A.kb1 : A.kb0) + 20480 * (b1 >> 1) + 256 * (b1 & 1) + 2560 * ((i + 1) & 1);
#pragma unroll
            for (int j = 0; j < 5; ++j) kf[(i + 1) & 1][j] = *(const LAS bf16x8*)(kp + 512 * j); }
        __builtin_amdgcn_sched_barrier(0);
#pragma unroll
        for (int j = 0; j < 5; ++j) sacc[i >> 1] = __builtin_amdgcn_mfma_f32_16x16x32_bf16(kf[i & 1][j], qf[5 * (i & 1) + j], sacc[i >> 1], 0, 0, 0);
        __builtin_amdgcn_sched_barrier(0);
    }
    __builtin_amdgcn_s_setprio(0);
    if (need_mask) {
#pragma unroll
        for (int b = 0; b < 4; ++b)
#pragma unroll
            for (int r = 0; r < 4; ++r) { const int key = 32 * (b >> 1) + 8 * g + 4 * (b & 1) + r; sacc[b][r] = key > limit ? -1e30f : sacc[b][r]; }
    }
    float mx = fmaxf(fmaxf(fmaxf(sacc[0][0], sacc[0][1]), fmaxf(sacc[0][2], sacc[0][3])), fmaxf(fmaxf(sacc[1][0], sacc[1][1]), fmaxf(sacc[1][2], sacc[1][3])));
    mx = fmaxf(mx, fmaxf(fmaxf(fmaxf(sacc[2][0], sacc[2][1]), fmaxf(sacc[2][2], sacc[2][3])), fmaxf(fmaxf(sacc[3][0], sacc[3][1]), fmaxf(sacc[3][2], sacc[3][3]))));
    mx = fmaxf(mx, __shfl_xor(mx, 16)); mx = hmax32(mx);
    __builtin_amdgcn_sched_barrier(0);
    pv_load(vf0, buf, A, 0);
    __builtin_amdgcn_sched_barrier(0);
    if (!__all(mx - st.m <= 6.0f)) {
        const float mnew = fmaxf(st.m, mx), alpha = __builtin_amdgcn_exp2f(st.m - mnew); st.m = mnew;
        st.l *= alpha;
#pragma unroll
        for (int cb = 0; cb < 16; ++cb) st.o[cb] = st.o[cb] * alpha;
    }
    float ps = 0.f;
#pragma unroll
    for (int b = 0; b < 4; ++b)
#pragma unroll
        for (int r = 0; r < 4; ++r) { const float p = __builtin_amdgcn_exp2f(sacc[b][r] - st.m); sacc[b][r] = p; ps += p; }
    st.l += ps;
#pragma unroll
    for (int ks = 0; ks < 2; ++ks) { u32x4 w; w.x = cvt_pk_bf16(sacc[2 * ks][0], sacc[2 * ks][1]); w.y = cvt_pk_bf16(sacc[2 * ks][2], sacc[2 * ks][3]);
        w.z = cvt_pk_bf16(sacc[2 * ks + 1][0], sacc[2 * ks + 1][1]); w.w = cvt_pk_bf16(sacc[2 * ks + 1][2], sacc[2 * ks + 1][3]); pf[ks] = __builtin_bit_cast(bf16x8, w); }
}
__device__ __forceinline__ void tile_pv(const LAS unsigned char* buf, const Addr& A, State& st, const bf16x8 (&pf)[2], bf16x8 (&vf0)[8]) {
    bf16x8 vf1[8];
    __builtin_amdgcn_s_setprio(1);
    pv_load(vf1, buf, A, 1); __builtin_amdgcn_sched_barrier(0); pv_mma(st, vf0, pf, 0); __builtin_amdgcn_sched_barrier(0);
    pv_load(vf0, buf, A, 2); __builtin_amdgcn_sched_barrier(0); pv_mma(st, vf1, pf, 1); __builtin_amdgcn_sched_barrier(0);
    pv_load(vf1, buf, A, 3); __builtin_amdgcn_sched_barrier(0); pv_mma(st, vf0, pf, 2); __builtin_amdgcn_sched_barrier(0);
    pv_mma(st, vf1, pf, 3);
    __builtin_amdgcn_s_setprio(0);
}
__device__ __forceinline__ void load_q(bf16x8 (&qf)[10], const bf16_t* Q, int row, int h, int g) {
    const bf16_t* qr = Q + (size_t)row * NQ;
#pragma unroll
    for (int s = 0; s < 8; ++s) qf[s] = __builtin_nontemporal_load((const bf16x8*)(qr + h * 256 + 32 * s + 8 * g));
#pragma unroll
    for (int s = 0; s < 2; ++s) qf[8 + s] = __builtin_nontemporal_load((const bf16x8*)(qr + 2048 + h * 64 + 32 * s + 8 * g));
}
__device__ __forceinline__ void state_init(State& st) {
#pragma unroll
    for (int cb = 0; cb < 16; ++cb) st.o[cb] = (f32x4){0.f, 0.f, 0.f, 0.f};
    st.m = -1e30f; st.l = 0.f;
}
__device__ __forceinline__ int stage_lds_off(int tid) { const int row = tid >> 3; return 5120 * (row >> 3) + 64 * (row & 7) + 512 * ((tid & 7) >> 2) + 16 * ((tid & 3) ^ ((row >> 2) & 3)); }
__device__ __forceinline__ void prompt_unit(Frame& F, int b, int qb) {
    unsigned char* ws = F.p->ws; OPAQUE_WS(ws); int tid = F.tid; asm volatile("" : "+v"(tid));
    const int lane = tid & 63, h = F.wave, g = lane >> 4, qi = lane & 15;
    const int p0 = 16 * qb, nt = (p0 + 15) / 64 + 1;
    const unsigned char* rows = (const unsigned char*)((const bf16_t*)(ws + WS_ROWSB) + (size_t)b * SEQ * MLA_ROW) + (tid >> 3) * 640 + (tid & 7) * 16;
    const int soff = stage_lds_off(tid);
    bf16x8 qf[10]; load_q(qf, (const bf16_t*)(ws + WS_Q), b * SEQ + p0 + qi, h, g);
    State st; state_init(st); const Addr AD = make_addr(lane);
    u32x4 pre[3];
#pragma unroll
    for (int j = 0; j < 5; ++j) *(LAS u32x4*)(F.lds + soff + 1024 * j) = *(const u32x4*)(rows + 128 * j);
    LDS_BARRIER();
    for (int kt = 0; kt < nt; ++kt) {
        const LAS unsigned char* buf = F.lds + (kt & 1) * TILE_BYTES; LAS unsigned char* nbuf = F.lds + ((kt + 1) & 1) * TILE_BYTES + soff;
        const bool more = kt + 1 < nt; const unsigned char* src = rows + (size_t)(more ? kt + 1 : kt) * (64 * 640);
        bf16x8 pf[2], vf0[8];
#pragma unroll
        for (int j = 0; j < 3; ++j) pre[j] = *(const u32x4*)(src + 128 * j);
        __builtin_amdgcn_sched_barrier(0);
        tile_scores(buf, AD, qf, st, p0 + qi - 64 * kt, 64 * kt + 63 > p0, lane, pf, vf0);
        if (more) {
#pragma unroll
            for (int j = 0; j < 3; ++j) *(LAS u32x4*)(nbuf + 1024 * j) = pre[j];
        }
#pragma unroll
        for (int j = 0; j < 2; ++j) pre[j] = *(const u32x4*)(src + 128 * (3 + j));
        __builtin_amdgcn_sched_barrier(0);
        tile_pv(buf, AD, st, pf, vf0);
        if (more) {
#pragma unroll
            for (int j = 0; j < 2; ++j) *(LAS u32x4*)(nbuf + 1024 * (3 + j)) = pre[j];
        }
        LDS_BARRIER();
    }
    float l = st.l; l += __shfl_xor(l, 16); l += __shfl_xor(l, 32);
    const float inv = 1.f / l;
    bf16_t* orow = (bf16_t*)(ws + WS_OL) + (size_t)(b * SEQ + p0 + qi) * 2048 + h * 256 + 4 * g;
#pragma unroll
    for (int cb = 0; cb < 16; ++cb) { u32x2 w; w.x = cvt_pk_bf16(st.o[cb][0] * inv, st.o[cb][1] * inv); w.y = cvt_pk_bf16(st.o[cb][2] * inv, st.o[cb][3] * inv); *(u32x2*)(orow + 16 * cb) = w; }
}
__device__ __forceinline__ void cache_load10(f32x4 (&pre)[10], const float* src) {
#pragma unroll
    for (int k = 0; k < 10; ++k) pre[k] = __builtin_nontemporal_load((const f32x4*)(src + 32 * k));
}
__device__ __forceinline__ void cache_store10(const f32x4 (&pre)[10], LAS unsigned char* dst) {
#pragma unroll
    for (int k = 0; k < 10; ++k) { u32x2 w; w.x = cvt_pk_bf16(pre[k][0], pre[k][1]); w.y = cvt_pk_bf16(pre[k][2], pre[k][3]); *(LAS u32x2*)(dst + 512 * k) = w; }
}
template <int J0, int J1>
__device__ __forceinline__ void load_cache_part(f32x4 (&pre)[10], const float* src) {
#pragma unroll
    for (int j = J0; j < J1; ++j) { pre[2 * (j - J0)] = *(const f32x4*)(src + 64 * j); pre[2 * (j - J0) + 1] = *(const f32x4*)(src + 64 * j + 4); }
}
template <int J0, int J1>
__device__ __forceinline__ void store_cache_part(const f32x4 (&pre)[10], LAS unsigned char* dst) {
#pragma unroll
    for (int j = J0; j < J1; ++j) { const int k = 2 * (j - J0); u32x4 w; w.x = cvt_pk_bf16(pre[k][0], pre[k][1]); w.y = cvt_pk_bf16(pre[k][2], pre[k][3]);
        w.z = cvt_pk_bf16(pre[k + 1][0], pre[k + 1][1]); w.w = cvt_pk_bf16(pre[k + 1][2], pre[k + 1][3]); *(LAS u32x4*)(dst + 1024 * j) = w; }
}
__device__ __forceinline__ const float* cache_tile_src(const float* cache, int pgv, int kt) {
    const int page = __builtin_amdgcn_readlane(pgv, kt >> 1);
    return cache + ((size_t)page * PAGE + (kt & 1) * 64) * MLA_ROW;
}
__device__ __forceinline__ void samp_tile(const LAS unsigned char* buf, const Addr& A, const bf16x8 (&qf)[10], State& st, int kb, int limit, bool need_mask, int lane) {
    const int g = lane >> 4;
    f32x4 sacc = {0.f, 0.f, 0.f, 0.f};
    const LAS unsigned char* kp = buf + ((kb & 1) ? A.kb1 : A.kb0) + 20480 * (kb >> 1) + 256 * (kb & 1);
#pragma unroll
    for (int s = 0; s < 10; ++s) { const bf16x8 kf = *(const LAS bf16x8*)(kp + 512 * s); sacc = __builtin_amdgcn_mfma_f32_16x16x32_bf16(kf, qf[s], sacc, 0, 0, 0); }
    if (need_mask) {
#pragma unroll
        for (int r = 0; r < 4; ++r) { const int key = 32 * (kb >> 1) + 8 * g + 4 * (kb & 1) + r; sacc[r] = key > limit ? -1e30f : sacc[r]; }
    }
    float mx = fmaxf(fmaxf(sacc[0], sacc[1]), fmaxf(sacc[2], sacc[3]));
    mx = fmaxf(mx, __shfl_xor(mx, 16)); mx = hmax32(mx);
    if (!__all(mx - st.m <= 6.0f)) {
        const float mnew = fmaxf(st.m, mx), alpha = __builtin_amdgcn_exp2f(st.m - mnew); st.m = mnew; st.l *= alpha;
#pragma unroll
        for (int cb = 0; cb < 16; ++cb) st.o[cb] = st.o[cb] * alpha;
    }
    float p[4];
#pragma unroll
    for (int r = 0; r < 4; ++r) p[r] = __builtin_amdgcn_exp2f(sacc[r] - st.m);
    st.l += (p[0] + p[1]) + (p[2] + p[3]);
    const unsigned w0 = cvt_pk_bf16(p[0], p[1]), w1 = cvt_pk_bf16(p[2], p[3]);
    const u32x4 pw = (kb & 1) ? (u32x4){0u, 0u, w0, w1} : (u32x4){w0, w1, 0u, 0u};
    const bf16x8 pf = __builtin_bit_cast(bf16x8, pw);
#pragma unroll
    for (int cb = 0; cb < 16; ++cb) {
        const LAS unsigned char* vp = buf + ((cb & 1) ? ((kb & 1) ? A.tb11 : A.tb10) : ((kb & 1) ? A.tb01 : A.tb00)) + 512 * (cb >> 1) + 256 * (kb & 1) + 20480 * (kb >> 1);
        const v4i16_t t0 = __builtin_amdgcn_ds_read_tr16_b64_v4i16((LAS v4i16_t*)vp);
        const bf16x8 vf = __builtin_shufflevector(t0, t0, 0, 1, 2, 3, 4, 5, 6, 7);
        st.o[cb] = __builtin_amdgcn_mfma_f32_16x16x32_bf16(vf, pf, st.o[cb], 0, 0, 0);
    }
}
__device__ __forceinline__ void sample_unit(Frame& F, int sb, int split) {
    unsigned char* ws = F.p->ws; OPAQUE_WS(ws); int tid = F.tid; asm volatile("" : "+v"(tid));
    const int lane = tid & 63, w = F.wave, g = lane >> 4, qi = lane & 15;
    const float* cache = F.p->in[2]; const int* pt = F.p->page_table;
    const int hg = w & 1, kb = w >> 1, head = 4 * hg + (qi >> 2), tq = qi & 3;
    bf16x8 qf[10]; load_q(qf, (const bf16_t*)(ws + WS_Q), MP + sb * DECS + tq, head, g);
    State st; state_init(st); const Addr AD = make_addr(lane);
    f32x4 pre[10];
    const int soff = stage_lds_off(tid);
    const int crow = tid >> 3, cq = tid & 7, goff = crow * MLA_ROW + 4 * cq, coff = 5120 * (crow >> 3) + 64 * (crow & 7) + 16 * ((cq >> 1) ^ ((crow >> 2) & 3)) + 8 * (cq & 1);
    const int pgv = pt[sb * NPAGES + 16 * split + (lane & 15)];
    { const float* src = cache_tile_src(cache, pgv, 0) + goff;
      cache_load10(pre, src); cache_store10(pre, F.lds + coff);
      cache_load10(pre, cache_tile_src(cache, pgv, 1) + goff); }
    __builtin_amdgcn_sched_barrier(0);
    LDS_BARRIER();
    constexpr int NT = 32;
    for (int kt = 0; kt < NT; ++kt) {
        const LAS unsigned char* buf = F.lds + (kt & 1) * TILE_BYTES; LAS unsigned char* nbuf = F.lds + ((kt + 1) & 1) * TILE_BYTES + coff;
        samp_tile(buf, AD, qf, st, kb, 63, false, lane);
        __builtin_amdgcn_sched_barrier(0);
        if (kt + 1 < NT) cache_store10(pre, nbuf);
        if (kt + 2 < NT) cache_load10(pre, cache_tile_src(cache, pgv, kt + 2) + goff);
        __builtin_amdgcn_sched_barrier(0);
        LDS_BARRIER();
    }
    if (split == 7) {
        const bf16_t* rows = (const bf16_t*)(ws + WS_ROWSB) + (size_t)(MP + sb * DECS) * MLA_ROW;
        unsigned zr = 0u; asm volatile("" : "+v"(zr));
#pragma unroll
        for (int j = 0; j < 5; ++j) { const int row = tid >> 3; u32x4 wv = {zr, zr, zr, zr}; if (row < 4) wv = *(const u32x4*)(rows + (size_t)row * MLA_ROW + ((tid & 7) + 8 * j) * 8); *(LAS u32x4*)(F.lds + soff + 1024 * j) = wv; }
        __syncthreads();
        if (kb == 0) samp_tile(F.lds, AD, qf, st, 0, tq, true, lane);
        __syncthreads();
    }
    float l = st.l; l += __shfl_xor(l, 16); l += __shfl_xor(l, 32);
    LAS float* OB = (LAS float*)F.lds; LAS float* MLB = (LAS float*)(F.lds + 131072);
#pragma unroll
    for (int cb = 0; cb < 16; ++cb) *(LAS f32x4*)(OB + (w * 16 + qi) * 256 + 16 * cb + 4 * g) = st.o[cb];
    if (g == 0) { MLB[(w * 16 + qi) * 2] = st.m; MLB[(w * 16 + qi) * 2 + 1] = l; }
    __syncthreads();
    {   const int hg2 = tid >> 8, q = (tid >> 4) & 15, c0 = (tid & 15) * 16;
        float ms[4], ls[4], mt = -1e30f;
#pragma unroll
        for (int k = 0; k < 4; ++k) { const int ww = 2 * k + hg2; ms[k] = MLB[(ww * 16 + q) * 2]; ls[k] = MLB[(ww * 16 + q) * 2 + 1]; mt = fmaxf(mt, ms[k]); }
        float L = 0.f; f32x4 acc[4];
#pragma unroll
        for (int j = 0; j < 4; ++j) acc[j] = (f32x4){0.f, 0.f, 0.f, 0.f};
#pragma unroll
        for (int k = 0; k < 4; ++k) { const int ww = 2 * k + hg2; const float wt = __builtin_amdgcn_exp2f(ms[k] - mt); L += wt * ls[k];
#pragma unroll
            for (int j = 0; j < 4; ++j) { const f32x4 v = *(const LAS f32x4*)(OB + (ww * 16 + q) * 256 + c0 + 4 * j); acc[j] = acc[j] + v * wt; } }
        const int hd = 4 * hg2 + (q >> 2), t = q & 3;
        float* po = (float*)(ws + WS_PART) + ((((size_t)sb * 8 + split) * 8 + hd) * 4 + t) * 256 + c0;
#pragma unroll
        for (int j = 0; j < 4; ++j) *(f32x4*)(po + 4 * j) = acc[j];
        if (c0 == 0) { float* ml = (float*)(ws + WS_ML) + ((((size_t)sb * 8 + split) * 8 + hd) * 4 + t) * 2; ml[0] = mt; ml[1] = L; }
    }
    __syncthreads();
}
__device__ __forceinline__ void sample_combine(Frame& F, int sb) {
    unsigned char* ws = F.p->ws; const int tid = F.tid;
    {
        const int row = tid >> 4, c0 = (tid & 15) * 16, hh = row >> 2, t = row & 3;
        float ms[8], ls[8], mt = -1e30f;
#pragma unroll
        for (int s = 0; s < 8; ++s) { const float* ml = (const float*)(ws + WS_ML) + ((((size_t)sb * 8 + s) * 8 + hh) * 4 + t) * 2;
            ms[s] = ml[0]; ls[s] = ml[1]; mt = fmaxf(mt, ms[s]); }
        float L = 0.f; f32x4 acc[4];
#pragma unroll
        for (int j = 0; j < 4; ++j) acc[j] = (f32x4){0.f, 0.f, 0.f, 0.f};
#pragma unroll
        for (int s = 0; s < 8; ++s) { const float w = __builtin_amdgcn_exp2f(ms[s] - mt); L += w * ls[s];
            const float* po = (const float*)(ws + WS_PART) + ((((size_t)sb * 8 + s) * 8 + hh) * 4 + t) * 256 + c0;
#pragma unroll
            for (int j = 0; j < 4; ++j) { const f32x4 v = *(const f32x4*)(po + 4 * j); acc[j] = acc[j] + v * w; } }
        const float inv = 1.f / L;
        bf16_t* orow = (bf16_t*)(ws + WS_OL) + (size_t)(MP + sb * DECS + t) * 2048 + hh * 256 + c0;
#pragma unroll
        for (int j = 0; j < 2; ++j) { u32x4 w; w.x = cvt_pk_bf16(acc[2 * j][0] * inv, acc[2 * j][1] * inv); w.y = cvt_pk_bf16(acc[2 * j][2] * inv, acc[2 * j][3] * inv);
            w.z = cvt_pk_bf16(acc[2 * j + 1][0] * inv, acc[2 * j + 1][1] * inv); w.w = cvt_pk_bf16(acc[2 * j + 1][2] * inv, acc[2 * j + 1][3] * inv); *(u32x4*)(orow + 8 * j) = w; }
    }
}
__device__ __forceinline__ void phase(Frame& F) {
    const int slot = (F.c >> 3) % 3; int done = 0;
    if (slot == 0) { for (int S = F.c; S < DECB * 8; S += F.G) sample_unit(F, S >> 3, S & 7); done = 1; }
    int np = 0;
    for (int L = F.c; L < 512; L += F.G) {
        const int b = L % 8, j = L / 8;
        prompt_unit(F, b, j); prompt_unit(F, b, 127 - j); ++np;
        if (!done && slot == 1 && np == 1) { for (int S = F.c; S < DECB * 8; S += F.G) sample_unit(F, S >> 3, S & 7); done = 1; }
    }
    if (!done) for (int S = F.c; S < DECB * 8; S += F.G) sample_unit(F, S >> 3, S & 7);
}
}


__device__ __forceinline__ void unpack8(const u32x4 v, float (&o)[8]) {
#pragma unroll
    for (int c = 0; c < 4; ++c) { o[2 * c] = __builtin_bit_cast(float, v[c] << 16); o[2 * c + 1] = __builtin_bit_cast(float, v[c] & 0xffff0000u); }
}
template <int R>
__device__ __forceinline__ void rowpass_rows(const Params& P, const int (&mrow)[R], bool first, bool last, const float* wa, const float* wb, int nslab, int lane) {
    unsigned char* ws = P.ws;
    float v[R][2][8], hv[R][2][8];
#pragma unroll
    for (int r = 0; r < R; ++r) { const int m = mrow[r];
        if (m < MP) { const u32x4* mr = (const u32x4*)((const bf16_t*)(ws + WS_MIX) + (size_t)m * DM) + lane; unpack8(__builtin_nontemporal_load(mr), v[r][0]); unpack8(__builtin_nontemporal_load(mr + 64), v[r][1]); }
        else {
#pragma unroll
            for (int j = 0; j < 2; ++j)
#pragma unroll
                for (int i = 0; i < 8; ++i) v[r][j][i] = 0.f;
            for (int z = 0; z < nslab; ++z) { const f32x4* mr = (const f32x4*)((const float*)(ws + WS_SLAB) + ((size_t)z * 128 + (m - MP)) * DM) + 2 * lane;
#pragma unroll
                for (int j = 0; j < 2; ++j) { const f32x4 a = mr[128 * j], b = mr[128 * j + 1]; v[r][j][0] += a.x; v[r][j][1] += a.y; v[r][j][2] += a.z; v[r][j][3] += a.w; v[r][j][4] += b.x; v[r][j][5] += b.y; v[r][j][6] += b.z; v[r][j][7] += b.w; } } }
        if (first) { const f32x4* hr = (const f32x4*)(m < MP ? P.in[0] + (size_t)m * DM : P.in[1] + (size_t)(m - MP) * DM) + 2 * lane;
#pragma unroll
            for (int j = 0; j < 2; ++j) { const f32x4 a = hr[128 * j], b = hr[128 * j + 1]; hv[r][j][0] = a.x; hv[r][j][1] = a.y; hv[r][j][2] = a.z; hv[r][j][3] = a.w; hv[r][j][4] = b.x; hv[r][j][5] = b.y; hv[r][j][6] = b.z; hv[r][j][7] = b.w; }
        } else { const u32x4* hr = (const u32x4*)((const bf16_t*)(ws + WS_HB) + (size_t)m * DM) + lane; unpack8(__builtin_nontemporal_load(hr), hv[r][0]); unpack8(__builtin_nontemporal_load(hr + 64), hv[r][1]); } }
    float s[R];
#pragma unroll
    for (int r = 0; r < R; ++r) { s[r] = 0.f;
#pragma unroll
        for (int j = 0; j < 2; ++j)
#pragma unroll
            for (int i = 0; i < 8; ++i) s[r] += v[r][j][i] * v[r][j][i]; }
#pragma unroll
    for (int o = 1; o < 64; o <<= 1)
#pragma unroll
        for (int r = 0; r < R; ++r) s[r] += __shfl_xor(s[r], o);
    float s2[R];
#pragma unroll
    for (int r = 0; r < R; ++r) { const float rs = rsqrtf(s[r] * (1.f / DM) + RMS_EPS); s2[r] = 0.f;
#pragma unroll
        for (int j = 0; j < 2; ++j) { const f32x4 g0 = ((const f32x4*)wa)[2 * lane + 128 * j], g1 = ((const f32x4*)wa)[2 * lane + 128 * j + 1];
            const float g[8] = {g0.x, g0.y, g0.z, g0.w, g1.x, g1.y, g1.z, g1.w};
#pragma unroll
            for (int i = 0; i < 8; ++i) { v[r][j][i] = hv[r][j][i] + v[r][j][i] * rs * g[i]; s2[r] += v[r][j][i] * v[r][j][i]; } }
        const int m = mrow[r];
        if (last) { f32x4* yr = (f32x4*)(P.out + O_Y + (size_t)m * DM) + 2 * lane;
#pragma unroll
            for (int j = 0; j < 2; ++j) { __builtin_nontemporal_store((f32x4){v[r][j][0], v[r][j][1], v[r][j][2], v[r][j][3]}, yr + 128 * j); __builtin_nontemporal_store((f32x4){v[r][j][4], v[r][j][5], v[r][j][6], v[r][j][7]}, yr + 128 * j + 1); }
        } else { u32x4* hb = (u32x4*)((bf16_t*)(ws + WS_HB) + (size_t)m * DM) + lane;
#pragma unroll
            for (int j = 0; j < 2; ++j) hb[64 * j] = (u32x4){cvt_pk_bf16(v[r][j][0], v[r][j][1]), cvt_pk_bf16(v[r][j][2], v[r][j][3]), cvt_pk_bf16(v[r][j][4], v[r][j][5]), cvt_pk_bf16(v[r][j][6], v[r][j][7])}; } }
    if (wb) {
#pragma unroll
        for (int o = 1; o < 64; o <<= 1)
#pragma unroll
            for (int r = 0; r < R; ++r) s2[r] += __shfl_xor(s2[r], o);
#pragma unroll
        for (int r = 0; r < R; ++r) { const float r2 = rsqrtf(s2[r] * (1.f / DM) + RMS_EPS);
            u32x4* ur = (u32x4*)((bf16_t*)(ws + WS_U) + (size_t)mrow[r] * DM) + lane;
#pragma unroll
            for (int j = 0; j < 2; ++j) { const f32x4 g0 = ((const f32x4*)wb)[2 * lane + 128 * j], g1 = ((const f32x4*)wb)[2 * lane + 128 * j + 1];
                ur[64 * j] = (u32x4){cvt_pk_bf16(v[r][j][0] * r2 * g0.x, v[r][j][1] * r2 * g0.y), cvt_pk_bf16(v[r][j][2] * r2 * g0.z, v[r][j][3] * r2 * g0.w), cvt_pk_bf16(v[r][j][4] * r2 * g1.x, v[r][j][5] * r2 * g1.y), cvt_pk_bf16(v[r][j][6] * r2 * g1.z, v[r][j][7] * r2 * g1.w)}; } } }
}
__device__ __forceinline__ void rowpass(Frame& F, bool first, bool last, const float* wa, const float* wb, int nslab) {
    const Params& P = *F.p; int lane = F.lane; asm volatile("" : "+v"(lane));
    const int gw = F.c * NWAVES + F.wave, NGW = F.G * NWAVES;
    for (int p = gw; p < MP / 4; p += NGW) { const int mr[4] = {4 * p, 4 * p + 1, 4 * p + 2, 4 * p + 3}; rowpass_rows<4>(P, mr, first, last, wa, wb, nslab, lane); }
    for (int m = MP + gw; m < MV; m += NGW) { const int mr[1] = {m}; rowpass_rows<1>(P, mr, first, last, wa, wb, nslab, lane); }
}


namespace dn {
constexpr int SP = 132;
constexpr int L_S = 0;
constexpr int L_KB = 3 * 64 * SP * 4;
constexpr int L_QB = L_KB + 64 * 272;
constexpr int L_G = L_QB + 64 * 272;
constexpr int LP = 68;
constexpr int L_LB = L_G + 512;
constexpr int L_ST = L_KB;
static_assert(L_LB + 32 * 80 <= 131072 + 8192 && 256 * 80 <= 2 * 64 * 272, "dn LDS map");
__device__ __forceinline__ float silu(float x) { return x * __builtin_amdgcn_rcpf(1.f + __expf(-x)); }
__device__ __forceinline__ void gated_norm_row(unsigned char* ws, const float* gout, size_t row, int h, int lane) {
    const unsigned ov = *(const unsigned*)((const bf16_t*)(ws + WS_DO) + row * 1024 + h * 128 + 2 * lane);
    const unsigned zv = *(const unsigned*)((const bf16_t*)(ws + WS_PROJ) + row * DN_NP + 3072 + h * 128 + 2 * lane);
    const float o0 = __builtin_bit_cast(float, ov << 16), o1 = __builtin_bit_cast(float, ov & 0xffff0000u);
    const float z0 = __builtin_bit_cast(float, zv << 16), z1 = __builtin_bit_cast(float, zv & 0xffff0000u);
    const float rs = rsqrtf(wave_sum(o0 * o0 + o1 * o1) * (1.f / 128.f) + RMS_EPS);
    const f32x2 g = *(const f32x2*)(gout + 2 * lane);
    *(unsigned*)((bf16_t*)(ws + WS_DOG) + row * 1024 + h * 128 + 2 * lane) = cvt_pk_bf16(o0 * rs * g.x * silu(z0), o1 * rs * g.y * silu(z1));
}

struct ConvPre { u32x4 x[11]; bf16_t gb, ga; };
template <int I0, int I1, bool GATES>
__device__ __forceinline__ void conv_load_part(ConvPre& R, const bf16_t* proj, int b, int n, int tid, int h) {
    const int cgp = tid % 48, tg = tid / 48, part = cgp >> 4, d0 = (cgp & 15) * 8, col = part * 1024 + h * 128 + d0;
#pragma unroll
    for (int i = I0; i < I1; ++i) { int tok = n * CHUNK + 8 * tg - 3 + i; u32x4 v = {0u, 0u, 0u, 0u};
        int cl = col; if (tid >= 384) { tok = n * CHUNK; cl = h * 128; }
        if (tok >= 0) v = __builtin_nontemporal_load((const u32x4*)(proj + ((size_t)b * SEQ + tok) * DN_NP + cl));
        R.x[i] = v; }
    if (GATES) { const bf16_t* pr = proj + ((size_t)b * SEQ + n * CHUNK + (tid & 63)) * DN_NP + 4096 + h; R.gb = pr[0]; R.ga = pr[8]; }
}
__device__ __forceinline__ void conv_load(ConvPre& R, const bf16_t* proj, int b, int n, int tid, int h) { conv_load_part<0, 11, true>(R, proj, b, n, tid, h); }
__device__ __forceinline__ void chunk_phase(Frame& F) {
    const Params& P = *F.p; unsigned char* ws = P.ws; OPAQUE_WS(ws); int tid = F.tid; asm volatile("" : "+v"(tid));
    const int lane = tid & 63, wave = __builtin_amdgcn_readfirstlane(tid >> 6);
    LAS float* S = (LAS float*)(F.lds + L_S); LAS float* GB = (LAS float*)(F.lds + L_G);
    const bf16_t* proj = (const bf16_t*)(ws + WS_PROJ);
    const int h = F.c & 7; const int nun = (256 - (F.c >> 3) + (F.G >> 3) - 1) / (F.G >> 3);
    if ((F.G & 7) != 0 || nun <= 0) return;
    constexpr int L_CW = 131072 + 8192 + 256;
    LAS float* CW = (LAS float*)(F.lds + L_CW);
    for (int i = tid; i < 4 * 384; i += NTHREADS) { const int j = i / 384, cc = i % 384; CW[i] = P.in[15][j * DN_QKV + (cc >> 7) * 1024 + h * 128 + (cc & 127)]; }
    __syncthreads();
    ConvPre pre;
    { const int idx = F.c >> 3; conv_load(pre, proj, idx >> 5, idx & 31, tid, h); }
    const int tid0 = tid;
    for (int k = 0; k < nun; ++k) {
        int tid = tid0; asm volatile("" : "+v"(tid));
        const int lane = tid & 63;
        const int cgp = tid % 48, tg = tid / 48, part = cgp >> 4, d0c = (cgp & 15) * 8, col = part * 1024 + h * 128 + d0c;
        const int idx = (F.c >> 3) + k * (F.G >> 3), b = idx >> 5, n = idx & 31;
        const int t0 = n * CHUNK; const size_t row0 = (size_t)b * SEQ + t0; const int unit = (b * 8 + h) * 32 + n;
        if (tid < 384) {
#pragma unroll
            for (int c2 = 0; c2 < 4; ++c2) {
                float x0[11], x1[11], w0[4], w1[4];
#pragma unroll
                for (int i = 0; i < 11; ++i) { x0[i] = __builtin_bit_cast(float, pre.x[i][c2] << 16); x1[i] = __builtin_bit_cast(float, pre.x[i][c2] & 0xffff0000u); }
#pragma unroll
                for (int j = 0; j < 4; ++j) { const f32x2 wv = *(const LAS f32x2*)(CW + j * 384 + part * 128 + d0c + 2 * c2); w0[j] = wv.x; w1[j] = wv.y; }
#pragma unroll
                for (int tt = 0; tt < 8; ++tt) { float a0 = 0.f, a1 = 0.f;
#pragma unroll
                    for (int j = 0; j < 4; ++j) { a0 += w0[j] * x0[tt + j]; a1 += w1[j] * x1[tt + j]; }
                    *(LAS f32x2*)(S + (part * 64 + 8 * tg + tt) * SP + d0c + 2 * c2) = (f32x2){silu(a0), silu(a1)}; }
                if (n == 31 && tg == 7) {
#pragma unroll
                    for (int r = 0; r < 3; ++r) *(f32x2*)(P.out + O_CP + ((size_t)b * 3 + r) * DN_QKV + col + 2 * c2) = (f32x2){x0[8 + r], x1[8 + r]}; }
            }
        }
        if (wave == 7) {
            const float braw = bf2f(pre.gb), araw = bf2f(pre.ga);
            const float beta = 1.f / (1.f + __expf(-braw));
            const float xs = araw + P.in[17][h]; const float sp = xs > 20.f ? xs : log1pf(__expf(xs));
            float g = -__expf(P.in[16][h]) * sp;
#pragma unroll
            for (int o = 1; o < 64; o <<= 1) { const float t = __shfl_up(g, o); if (lane >= o) g += t; }
            GB[lane] = beta; GB[64 + lane] = g;
        }
        LDS_BARRIER();
        const int nidx = k + 1 < nun ? idx + (F.G >> 3) : idx;
        conv_load_part<0, 4, false>(pre, proj, nidx >> 5, nidx & 31, tid, h);
        {   const int r = tid >> 2, qd = tid & 3; LAS float* rp = S + r * SP + 4 * qd;
            f32x4 a[8]; float ss = 0.f;
#pragma unroll
            for (int j = 0; j < 8; ++j) { a[j] = *(const LAS f32x4*)(rp + 16 * j); ss += (a[j].x * a[j].x + a[j].y * a[j].y) + (a[j].z * a[j].z + a[j].w * a[j].w); }
            ss += __shfl_xor(ss, 1); ss += __shfl_xor(ss, 2);
            float sc = rsqrtf(ss + L2_EPS); if (r < 64) sc *= 0.08838834764831845f;
#pragma unroll
            for (int j = 0; j < 8; ++j) *(LAS f32x4*)(rp + 16 * j) = a[j] * sc;
        }
        LDS_BARRIER();
        conv_load_part<4, 8, false>(pre, proj, nidx >> 5, nidx & 31, tid, h);
        const float gl = GB[64 + 63];
        {   const int t = tid >> 3, d0 = (tid & 7) * 16; const float eg = __expf(GB[64 + t]);
            const LAS float* qp = S + t * SP + d0; const LAS float* kp = S + (64 + t) * SP + d0;
            float q[16], kk[16];
#pragma unroll
            for (int j = 0; j < 4; ++j) { const f32x4 a = *(const LAS f32x4*)(qp + 4 * j), c = *(const LAS f32x4*)(kp + 4 * j); q[4 * j] = a.x; q[4 * j + 1] = a.y; q[4 * j + 2] = a.z; q[4 * j + 3] = a.w; kk[4 * j] = c.x; kk[4 * j + 1] = c.y; kk[4 * j + 2] = c.z; kk[4 * j + 3] = c.w; }
            u32x4 w0, w1;
            w0 = (u32x4){cvt_pk_bf16(q[0], q[1]), cvt_pk_bf16(q[2], q[3]), cvt_pk_bf16(q[4], q[5]), cvt_pk_bf16(q[6], q[7])}; w1 = (u32x4){cvt_pk_bf16(q[8], q[9]), cvt_pk_bf16(q[10], q[11]), cvt_pk_bf16(q[12], q[13]), cvt_pk_bf16(q[14], q[15])};
            *(LAS u32x4*)(F.lds + L_QB + t * 272 + d0 * 2) = w0; *(LAS u32x4*)(F.lds + L_QB + t * 272 + d0 * 2 + 16) = w1;
            w0 = (u32x4){cvt_pk_bf16(kk[0], kk[1]), cvt_pk_bf16(kk[2], kk[3]), cvt_pk_bf16(kk[4], kk[5]), cvt_pk_bf16(kk[6], kk[7])}; w1 = (u32x4){cvt_pk_bf16(kk[8], kk[9]), cvt_pk_bf16(kk[10], kk[11]), cvt_pk_bf16(kk[12], kk[13]), cvt_pk_bf16(kk[14], kk[15])};
            *(LAS u32x4*)(F.lds + L_KB + t * 272 + d0 * 2) = w0; *(LAS u32x4*)(F.lds + L_KB + t * 272 + d0 * 2 + 16) = w1;
            w0 = (u32x4){cvt_pk_bf16(q[0] * eg, q[1] * eg), cvt_pk_bf16(q[2] * eg, q[3] * eg), cvt_pk_bf16(q[4] * eg, q[5] * eg), cvt_pk_bf16(q[6] * eg, q[7] * eg)};
            w1 = (u32x4){cvt_pk_bf16(q[8] * eg, q[9] * eg), cvt_pk_bf16(q[10] * eg, q[11] * eg), cvt_pk_bf16(q[12] * eg, q[13] * eg), cvt_pk_bf16(q[14] * eg, q[15] * eg)};
            bf16_t* qd = (bf16_t*)(ws + WS_QD) + (row0 + t) * 1024 + h * 128 + d0; *(u32x4*)qd = w0; *(u32x4*)(qd + 8) = w1;
        }
        {   const int d = tid >> 2, tq = (tid & 3) * 16; float kd[16];
#pragma unroll
            for (int j = 0; j < 16; ++j) kd[j] = S[(64 + tq + j) * SP + d] * __expf(gl - GB[64 + tq + j]);
            bf16_t* o = (bf16_t*)(ws + WS_KDT) + ((size_t)unit * 128 + d) * 64 + tq;
            *(u32x4*)o = (u32x4){cvt_pk_bf16(kd[0], kd[1]), cvt_pk_bf16(kd[2], kd[3]), cvt_pk_bf16(kd[4], kd[5]), cvt_pk_bf16(kd[6], kd[7])};
            *(u32x4*)(o + 8) = (u32x4){cvt_pk_bf16(kd[8], kd[9]), cvt_pk_bf16(kd[10], kd[11]), cvt_pk_bf16(kd[12], kd[13]), cvt_pk_bf16(kd[14], kd[15])};
        }
        if (tid == 0) ((float*)(ws + WS_GL))[unit] = __expf(gl);
        LDS_BARRIER();
        conv_load_part<8, 11, true>(pre, proj, nidx >> 5, nidx & 31, tid, h);
        {   const int mat = wave >> 2, bi = wave & 3, g = lane >> 4, jl = lane & 15;
            LAS float* Lt = S;
            const LAS unsigned char* ab = F.lds + (mat ? L_QB : L_KB) + (16 * bi + jl) * 272 + 16 * g;
            bf16x8 af[4];
#pragma unroll
            for (int ks = 0; ks < 4; ++ks) af[ks] = *(const LAS bf16x8*)(ab + 64 * ks);
            float gi[4], bt[4];
#pragma unroll
            for (int r = 0; r < 4; ++r) { gi[r] = GB[64 + 16 * bi + 4 * g + r]; bt[r] = GB[16 * bi + 4 * g + r]; }
            for (int bj = 0; bj < 4; ++bj) {
                f32x4 acc = {0.f, 0.f, 0.f, 0.f};
                if (bj <= bi) {
                    const LAS unsigned char* bb = F.lds + L_KB + (16 * bj + jl) * 272 + 16 * g;
#pragma unroll
                    for (int ks = 0; ks < 4; ++ks) { const bf16x8 bf = *(const LAS bf16x8*)(bb + 64 * ks); acc = __builtin_amdgcn_mfma_f32_16x16x32_bf16(af[ks], bf, acc, 0, 0, 0); }
                }
                const int j = 16 * bj + jl; const float gj = GB[64 + j];
                if (mat == 0) { if (bj <= bi) { f32x4 lv;
#pragma unroll
                        for (int r = 0; r < 4; ++r) { const int i = 16 * bi + 4 * g + r; lv[r] = (i > j) ? bt[r] * acc[r] * __expf(gi[r] - gj) : 0.f; }
                        *(LAS f32x4*)(Lt + j * LP + 16 * bi + 4 * g) = lv;
                        if (bi >= 2 && bj < 2) {
#pragma unroll
                            for (int r = 0; r < 4; ++r) *(LAS bf16_t*)(F.lds + L_LB + (16 * (bi - 2) + 4 * g + r) * 80 + j * 2) = (bf16_t)f2bf(-lv[r]); } } }
                else {
#pragma unroll
                    for (int r = 0; r < 4; ++r) { const int i = 16 * bi + 4 * g + r; const float v = (i >= j) ? acc[r] * __expf(gi[r] - gj) : 0.f; ((bf16_t*)(ws + WS_QKM))[((size_t)unit * 64 + i) * 64 + j] = (bf16_t)f2bf(v); } }
            }
        }
        {   const int t = tid >> 3, d0 = (tid & 7) * 16; const float beta = GB[t], be = beta * __expf(GB[64 + t]);
            LAS float* kp = S + (64 + t) * SP + d0; LAS float* vp = S + (128 + t) * SP + d0;
#pragma unroll
            for (int j = 0; j < 4; ++j) { f32x4 a = *(LAS f32x4*)(kp + 4 * j); a = a * be; *(LAS f32x4*)(kp + 4 * j) = a; f32x4 c = *(LAS f32x4*)(vp + 4 * j); c = c * beta; *(LAS f32x4*)(vp + 4 * j) = c; }
        }
        LDS_BARRIER();
        const LAS float* Lt = S;
        if (wave == 0) {
            const int bi = lane >> 4, cc = lane & 15; float x[16];
#pragma unroll
            for (int i = 0; i < 16; ++i) x[i] = (i == cc) ? 1.f : 0.f;
#pragma unroll
            for (int j = 0; j < 15; ++j) { const float sj = x[j];
#pragma unroll
                for (int q4 = (j + 1) / 4; q4 < 4; ++q4) { const f32x4 l4 = *(const LAS f32x4*)(Lt + (16 * bi + j) * LP + 16 * bi + 4 * q4);
#pragma unroll
                    for (int jj = 0; jj < 4; ++jj) x[4 * q4 + jj] -= l4[jj] * sj; } }
#pragma unroll
            for (int i = 0; i < 16; ++i) *(LAS bf16_t*)(F.lds + L_ST + (16 * bi + i) * 32 + cc * 2) = (bf16_t)f2bf(x[i]);
        }
        LDS_BARRIER();
        {   const int g = lane >> 4, jl = lane & 15;
            bf16x8 At[4], Al[6];
#pragma unroll
            for (int bi = 0; bi < 4; ++bi) { const u32x2 t = *(const LAS u32x2*)(F.lds + L_ST + (16 * bi + jl) * 32 + 8 * g); At[bi] = __builtin_bit_cast(bf16x8, (u32x4){t.x, t.y, 0u, 0u}); }
#pragma unroll
            for (int bi = 1; bi < 4; ++bi)
#pragma unroll
                for (int bj = 0; bj < bi; ++bj) { const LAS float* lp = Lt + (16 * bj + 4 * g) * LP + 16 * bi + jl;
                    Al[bi * (bi - 1) / 2 + bj] = __builtin_bit_cast(bf16x8, (u32x4){cvt_pk_bf16(-lp[0], -lp[LP]), cvt_pk_bf16(-lp[2 * LP], -lp[3 * LP]), 0u, 0u}); }
#pragma unroll
            for (int q = 0; q < 2; ++q) { const int cc = 16 * (2 * wave + q) + jl;
                const LAS float* rp = S + (cc < 128 ? 128 * SP + cc : 64 * SP + (cc - 128)) + (4 * g) * SP;
                bf16_t* og = (bf16_t*)(ws + (cc < 128 ? WS_UU : WS_WW)) + (row0 + 4 * g) * 1024 + h * 128 + (cc & 127);
                f32x4 y[4]; bf16x8 sb[4];
#pragma unroll
                for (int bi = 0; bi < 4; ++bi) y[bi] = (f32x4){rp[(16 * bi) * SP], rp[(16 * bi + 1) * SP], rp[(16 * bi + 2) * SP], rp[(16 * bi + 3) * SP]};
#pragma unroll
                for (int bi = 0; bi < 4; ++bi) {
#pragma unroll
                    for (int bj = 0; bj < bi; ++bj) y[bi] = __builtin_amdgcn_mfma_f32_16x16x32_bf16(Al[bi * (bi - 1) / 2 + bj], sb[bj], y[bi], 0, 0, 0);
                    const bf16x8 yb = __builtin_bit_cast(bf16x8, (u32x4){cvt_pk_bf16(y[bi][0], y[bi][1]), cvt_pk_bf16(y[bi][2], y[bi][3]), 0u, 0u});
                    const f32x4 sv = __builtin_amdgcn_mfma_f32_16x16x32_bf16(At[bi], yb, (f32x4){0.f, 0.f, 0.f, 0.f}, 0, 0, 0);
                    const unsigned p0 = cvt_pk_bf16(sv[0], sv[1]), p1 = cvt_pk_bf16(sv[2], sv[3]);
                    sb[bi] = __builtin_bit_cast(bf16x8, (u32x4){p0, p1, 0u, 0u});
                    og[(size_t)(16 * bi) * 1024] = (bf16_t)p0; og[(size_t)(16 * bi + 1) * 1024] = (bf16_t)(p0 >> 16); og[(size_t)(16 * bi + 2) * 1024] = (bf16_t)p1; og[(size_t)(16 * bi + 3) * 1024] = (bf16_t)(p1 >> 16);
                }
            }
        }
        LDS_BARRIER();
    }
}
__device__ __forceinline__ void sample_item(Frame& F, int sb, int h) {
    const Params& P = *F.p; unsigned char* ws = P.ws; OPAQUE_WS(ws); int tid = F.tid; asm volatile("" : "+v"(tid));
    const int lane = tid & 63, wave = __builtin_amdgcn_readfirstlane(tid >> 6);
    LAS float* SQ = (LAS float*)F.lds;
    LAS float* GT = SQ + 3 * 4 * 128;
    LAS float* RED = GT + 16;
    const bf16_t* proj = (const bf16_t*)(ws + WS_PROJ) + (size_t)(MP + sb * DECS) * DN_NP;
    const int dg = tid >> 7, e = tid & 127;
    float St[32];
    const float* s0 = P.in[3] + (((size_t)sb * 8 + h) * 128 + 32 * dg) * 128 + e;
#pragma unroll
    for (int i = 0; i < 32; ++i) St[i] = __builtin_nontemporal_load(s0 + (size_t)i * 128);
    if (tid < 384) {
        const int part = tid >> 7, d = tid & 127, col = part * 1024 + h * 128 + d;
        float xs[7];
#pragma unroll
        for (int j = 0; j < 3; ++j) xs[j] = P.in[4][((size_t)sb * 3 + j) * DN_QKV + col];
#pragma unroll
        for (int t = 0; t < 4; ++t) xs[3 + t] = bf2f(proj[(size_t)t * DN_NP + col]);
        float cw[4];
#pragma unroll
        for (int j = 0; j < 4; ++j) cw[j] = P.in[15][j * DN_QKV + col];
#pragma unroll
        for (int t = 0; t < 4; ++t) { float a = 0.f;
#pragma unroll
            for (int j = 0; j < 4; ++j) a += cw[j] * xs[t + j];
            SQ[(part * 4 + t) * 128 + d] = silu(a); }
#pragma unroll
        for (int j = 0; j < 3; ++j) P.out[O_CS + ((size_t)sb * 3 + j) * DN_QKV + col] = xs[4 + j];
    }
    if (tid >= 384 && tid < 388) { const int t = tid - 384; const float braw = bf2f(proj[(size_t)t * DN_NP + 4096 + h]), araw = bf2f(proj[(size_t)t * DN_NP + 4104 + h]);
        const float xs = araw + P.in[17][h]; const float sp = xs > 20.f ? xs : log1pf(__expf(xs));
        GT[t] = -__expf(P.in[16][h]) * sp; GT[4 + t] = 1.f / (1.f + __expf(-braw)); }
    LDS_BARRIER();
    { LAS float* rp = SQ + wave * 128; const float a = rp[lane], c = rp[lane + 64];
      float sc = rsqrtf(wave_sum(a * a + c * c) + L2_EPS); if (wave < 4) sc *= 0.08838834764831845f;
      rp[lane] = a * sc; rp[lane + 64] = c * sc; }
    LDS_BARRIER();
    for (int t = 0; t < 4; ++t) {
        const float dec = __expf(GT[t]), beta = GT[4 + t];
        const LAS float* qp = SQ + t * 128 + 32 * dg; const LAS float* kp = SQ + (4 + t) * 128 + 32 * dg;
        float kv = 0.f;
#pragma unroll
        for (int i = 0; i < 32; ++i) { St[i] *= dec; kv += kp[i] * St[i]; }
        RED[dg * 128 + e] = kv;
        LDS_BARRIER();
        const float kvt = (RED[e] + RED[128 + e]) + (RED[256 + e] + RED[384 + e]);
        const float delta = (SQ[(8 + t) * 128 + e] - kvt) * beta;
        float ov = 0.f;
#pragma unroll
        for (int i = 0; i < 32; ++i) { St[i] += kp[i] * delta; ov += qp[i] * St[i]; }
        LDS_BARRIER();
        RED[dg * 128 + e] = ov;
        LDS_BARRIER();
        if (dg == 0) { const float o = (RED[e] + RED[128 + e]) + (RED[256 + e] + RED[384 + e]); ((bf16_t*)(ws + WS_DO))[(size_t)(MP + sb * DECS + t) * 1024 + h * 128 + e] = (bf16_t)f2bf(o); }
        LDS_BARRIER();
    }
    float* so = P.out + O_SS + (((size_t)sb * 8 + h) * 128 + 32 * dg) * 128 + e;
#pragma unroll
    for (int i = 0; i < 32; ++i) __builtin_nontemporal_store(St[i], so + (size_t)i * 128);
    asm volatile("s_waitcnt vmcnt(0)" ::: "memory"); __syncthreads();
    if (wave < 4) gated_norm_row(ws, P.in[18], (size_t)(MP + sb * DECS + wave), h, lane);
}

struct StepRegs { bf16x8 a1[4]; bf16x8 a3[2]; bf16x8 a4[2]; };
__device__ __forceinline__ void scan_load(StepRegs& R, const unsigned char* ws, int b, int h, int sl, int n, int w, int g, int jl) {
    const int unit = (b * 8 + h) * 32 + n; const size_t row0 = (size_t)b * SEQ + 64 * n; const int tb = w & 3;
    const bf16_t* A1 = (const bf16_t*)(ws + (w < 4 ? WS_WW : WS_QD)) + (row0 + 16 * tb + jl) * 1024 + h * 128 + 8 * g;
#pragma unroll
    for (int ks = 0; ks < 4; ++ks) R.a1[ks] = *(const bf16x8*)(A1 + 32 * ks);
    const bf16_t* A4 = (const bf16_t*)(ws + WS_KDT) + ((size_t)unit * 128 + 16 * w + jl) * 64 + 8 * g;
#pragma unroll
    for (int ks = 0; ks < 2; ++ks) R.a4[ks] = *(const bf16x8*)(A4 + 32 * ks);
    const bf16_t* X = w >= 4 ? (const bf16_t*)(ws + WS_QKM) + ((size_t)unit * 64 + 16 * tb + jl) * 64 + 8 * g
                             : (const bf16_t*)(ws + WS_UU) + (row0 + 16 * tb + jl) * 1024 + h * 128 + 32 * sl + 8 * g;
    R.a3[0] = *(const bf16x8*)X; R.a3[1] = *(const bf16x8*)(X + (w >= 4 ? 32 : 0));
}
__device__ __forceinline__ void scan_step(unsigned char* ws, LAS unsigned char* ST, LAS unsigned char* VT, const StepRegs& cur, f32x4 (&sacc)[2], int b, int h, int sl, int n, int w, int g, int jl) {
    const int tb = w & 3; const size_t row0 = (size_t)b * SEQ + 64 * n;
    f32x4 tacc[2] = {{0.f, 0.f, 0.f, 0.f}, {0.f, 0.f, 0.f, 0.f}};
#pragma unroll
    for (int cb = 0; cb < 2; ++cb)
#pragma unroll
        for (int ks = 0; ks < 4; ++ks) { const bf16x8 bf = *(const LAS bf16x8*)(ST + (16 * cb + jl) * 272 + (32 * ks + 8 * g) * 2); tacc[cb] = __builtin_amdgcn_mfma_f32_16x16x32_bf16(bf, cur.a1[ks], tacc[cb], 0, 0, 0); }
    if (w < 4) {
        float uf[8]; unpack8(__builtin_bit_cast(u32x4, cur.a3[0]), uf);
#pragma unroll
        for (int cb = 0; cb < 2; ++cb) {
            const unsigned p0 = cvt_pk_bf16(uf[4 * cb + 0] - tacc[cb][0], uf[4 * cb + 1] - tacc[cb][1]), p1 = cvt_pk_bf16(uf[4 * cb + 2] - tacc[cb][2], uf[4 * cb + 3] - tacc[cb][3]);
            LAS unsigned short* vp = (LAS unsigned short*)(VT + (16 * cb + 4 * g) * 144 + (16 * tb + jl) * 2);
            vp[0] = (unsigned short)p0; vp[72] = (unsigned short)(p0 >> 16); vp[144] = (unsigned short)p1; vp[216] = (unsigned short)(p1 >> 16); }
    }
    LDS_BARRIER();
    if (w >= 4) {
#pragma unroll
        for (int cb = 0; cb < 2; ++cb)
#pragma unroll
            for (int ks = 0; ks < 2; ++ks) { const bf16x8 bf = *(const LAS bf16x8*)(VT + (16 * cb + jl) * 144 + (32 * ks + 8 * g) * 2); tacc[cb] = __builtin_amdgcn_mfma_f32_16x16x32_bf16(bf, cur.a3[ks], tacc[cb], 0, 0, 0); }
        *(u32x4*)((bf16_t*)(ws + WS_DO) + (row0 + 16 * tb + jl) * 1024 + h * 128 + 32 * sl + 8 * g) =
            (u32x4){cvt_pk_bf16(tacc[0][0], tacc[0][1]), cvt_pk_bf16(tacc[0][2], tacc[0][3]), cvt_pk_bf16(tacc[1][0], tacc[1][1]), cvt_pk_bf16(tacc[1][2], tacc[1][3])};
    }
    const float gl = ((const LAS float*)(VT + 32 * 144))[n];
#pragma unroll
    for (int cb = 0; cb < 2; ++cb) { sacc[cb] = sacc[cb] * gl;
#pragma unroll
        for (int ks = 0; ks < 2; ++ks) { const bf16x8 bf = *(const LAS bf16x8*)(VT + (16 * cb + jl) * 144 + (32 * ks + 8 * g) * 2); sacc[cb] = __builtin_amdgcn_mfma_f32_16x16x32_bf16(cur.a4[ks], bf, sacc[cb], 0, 0, 0); }
        *(LAS u32x2*)(ST + (16 * cb + jl) * 272 + (16 * w + 4 * g) * 2) = (u32x2){cvt_pk_bf16(sacc[cb][0], sacc[cb][1]), cvt_pk_bf16(sacc[cb][2], sacc[cb][3])}; }
    LDS_BARRIER();
}
__device__ __forceinline__ void scan_item(Frame& F, int b, int h, int sl) {
    const Params& P = *F.p; unsigned char* ws = P.ws; OPAQUE_WS(ws); int tid = F.tid; asm volatile("" : "+v"(tid));
    const int lane = tid & 63, w = __builtin_amdgcn_readfirstlane(tid >> 6), g = lane >> 4, jl = lane & 15;
    LAS unsigned char* ST = F.lds;
    LAS unsigned char* VT = F.lds + 32 * 272;
    for (int i = tid; i < 32 * 272 / 4; i += NTHREADS) ((LAS unsigned*)ST)[i] = 0u;
    if (tid < 32) ((LAS float*)(VT + 32 * 144))[tid] = ((const float*)(ws + WS_GL))[(b * 8 + h) * 32 + tid];
    f32x4 sacc[2] = {{0.f, 0.f, 0.f, 0.f}, {0.f, 0.f, 0.f, 0.f}};
    StepRegs A, B, C;
    scan_load(A, ws, b, h, sl, 0, w, g, jl); scan_load(B, ws, b, h, sl, 1, w, g, jl);
    __syncthreads();
    for (int n = 0; n < 30; n += 3) {
        scan_load(C, ws, b, h, sl, n + 2, w, g, jl); __builtin_amdgcn_sched_barrier(0); scan_step(ws, ST, VT, A, sacc, b, h, sl, n, w, g, jl);
        scan_load(A, ws, b, h, sl, n + 3, w, g, jl); __builtin_amdgcn_sched_barrier(0); scan_step(ws, ST, VT, B, sacc, b, h, sl, n + 1, w, g, jl);
        scan_load(B, ws, b, h, sl, n + 4, w, g, jl); __builtin_amdgcn_sched_barrier(0); scan_step(ws, ST, VT, C, sacc, b, h, sl, n + 2, w, g, jl);
    }
    scan_step(ws, ST, VT, A, sacc, b, h, sl, 30, w, g, jl);
    scan_step(ws, ST, VT, B, sacc, b, h, sl, 31, w, g, jl);
    float* so = P.out + O_SP + (((size_t)b * 8 + h) * 128 + 16 * w + 4 * g) * 128 + 32 * sl + 8 * (jl >> 2) + (jl & 3);
#pragma unroll
    for (int cb = 0; cb < 2; ++cb)
#pragma unroll
        for (int r = 0; r < 4; ++r) __builtin_nontemporal_store(sacc[cb][r], so + (size_t)r * 128 + 4 * cb);
}
template <int NB>
__device__ __forceinline__ void gated_norm_batch(unsigned char* ws, const float* gout, size_t row0, int h, int lane) {
    const size_t rowb = row0 + (lane >> 4); const int c0 = (lane & 15) * 8;
    u32x4 ov[NB], zv[NB];
#pragma unroll
    for (int i = 0; i < NB; ++i) { ov[i] = *(const u32x4*)((const bf16_t*)(ws + WS_DO) + (rowb + 32 * i) * 1024 + h * 128 + c0);
        zv[i] = __builtin_nontemporal_load((const u32x4*)((const bf16_t*)(ws + WS_PROJ) + (rowb + 32 * i) * DN_NP + 3072 + h * 128 + c0)); }
    const f32x4 g0 = *(const f32x4*)(gout + c0), g1 = *(const f32x4*)(gout + c0 + 4);
    const float g[8] = {g0.x, g0.y, g0.z, g0.w, g1.x, g1.y, g1.z, g1.w};
    __builtin_amdgcn_sched_barrier(0);
#pragma unroll
    for (int i = 0; i < NB; ++i) {
        float o[8], z[8]; unpack8(ov[i], o); unpack8(zv[i], z);
        float ss = 0.f;
#pragma unroll
        for (int k = 0; k < 8; ++k) ss += o[k] * o[k];
        ss += __shfl_xor(ss, 1); ss += __shfl_xor(ss, 2); ss += __shfl_xor(ss, 4); ss += __shfl_xor(ss, 8);
        const float rs = rsqrtf(ss * (1.f / 128.f) + RMS_EPS);
        float y[8];
#pragma unroll
        for (int k = 0; k < 8; ++k) y[k] = o[k] * rs * g[k] * silu(z[k]);
        *(u32x4*)((bf16_t*)(ws + WS_DOG) + (rowb + 32 * i) * 1024 + h * 128 + c0) = (u32x4){cvt_pk_bf16(y[0], y[1]), cvt_pk_bf16(y[2], y[3]), cvt_pk_bf16(y[4], y[5]), cvt_pk_bf16(y[6], y[7])};
    }
}
__device__ __forceinline__ void scan_tail(Frame& F, int b, int h, int sl) {
    unsigned char* ws = F.p->ws; unsigned* cnt = (unsigned*)(ws + WS_CTL) + CW_HAND + 64 * (16 + b * 8 + h);
    hand_signal(cnt);
    hand_wait(cnt, 4u);
    const int lane = F.lane;
    for (int bt = 0; bt < 2; ++bt) gated_norm_batch<8>(ws, F.p->in[18], (size_t)b * SEQ + 512 * sl + 4 * F.wave + 256 * bt, h, lane);
}
}

__global__ void __launch_bounds__(NTHREADS, 2) fwd_kernel(Params prm) {
    extern __shared__ __attribute__((aligned(16))) unsigned char lds_raw[];
    Frame F; F.lds = (LAS unsigned char*)lds_raw; F.tid = threadIdx.x; F.lane = F.tid & 63; F.wave = __builtin_amdgcn_readfirstlane(F.tid >> 6);
    F.G = gridDim.x; F.c = blockIdx.x; F.p = &prm;
    unsigned char* ws = prm.ws;
    volatile LAS unsigned* MISC = (volatile LAS unsigned*)(F.lds + 131072 + 8192);
    if (F.tid < 16) MISC[F.tid] = 0u;
    __syncthreads();
    (void)xcd_barrier_post((unsigned*)(ws + WS_CTL) + 1024, MISC + 8);
#define GSYNC() do { XcdBarrier gb_; gb_.bar = (unsigned*)(ws + WS_CTL) + 1024; gb_.x = 0; gb_.st = MISC + 8; xcd_barrier(gb_); OPAQUE_WS(ws); } while (0)
    const float QSCALE = 0.07216878364870322f * 1.4426950408889634f;

    p0_prologue(F);
    GSYNC();
    {
        pg8::Gemm g{(const bf16_t*)(ws + WS_U), (const bf16_t*)(ws + WS_WT_IN0), 1024, 1024};
        pg8::PlainOrder S; S.init(MT / 256, NIN0P / 256, 16, F.G, F.c);
        pg8::EpiF32 E{(float*)(ws + WS_A0), NIN0P, nullptr};
        pg8::gemm_phase(F.lds, g, S, E);
    }
    {
        pg8::Gemm g1{(const bf16_t*)(ws + WS_WOT), (const bf16_t*)(ws + WS_BD_UV), 1024, 1024};
        pg8::PrepOrder S1{4, 8, F.G, F.c, 195, 0};
        pg8::EpiBf16 E1{(bf16_t*)(ws + WS_WT_UVO), 2048};
        pg8::gemm_phase(F.lds, g1, S1, E1);
        pg8::Gemm g2{(const bf16_t*)(ws + WS_BD_UK), (const bf16_t*)(ws + WS_UQN), 1024, 1024};
        pg8::PrepOrder S2{8, 2, F.G, F.c, 227, 1};
        pg8::EpiBf16 E2{(bf16_t*)(ws + WS_WT_Q), 512};
        pg8::gemm_phase(F.lds, g2, S2, E2);
    }
    GSYNC();
    m2_rows(F);
    GSYNC();
    {
        pg8::Gemm g{(const bf16_t*)(ws + WS_CQ), (const bf16_t*)(ws + WS_WT_Q), 384, 512};
        pg8::PlainOrder S; S.init(MT / 256, NQ / 256, 6, F.G, F.c);
        pg8::EpiQ E{(bf16_t*)(ws + WS_Q), (const f32x2*)(ws + WS_ROPE), QSCALE};
        pg8::gemm_phase(F.lds, g, S, E);
    }
    GSYNC();
    attn::phase(F);
    GSYNC();
    for (int sb = F.c; sb < DECB; sb += F.G) attn::sample_combine(F, sb);
    GSYNC();
    {
        pg8::Gemm g{(const bf16_t*)(ws + WS_OL), (const bf16_t*)(ws + WS_WT_UVO), 2048, 2048};
        pg8::SplitOrder S; S.init(MP / 256, 4, 32, F.G, F.c); S.pmx = MP / 256; S.nsplit = 8;
        pg8::EpiMix E{(bf16_t*)(ws + WS_MIX), DM, (float*)(ws + WS_SLAB)};
        pg8::gemm_phase(F.lds, g, S, E);
    }
    GSYNC();
    rowpass(F, true, false, F.p->in[6] + 1 * DM, F.p->in[6] + 2 * DM, 8);
    GSYNC();
#pragma unroll
    for (int l = 0; l < 2; ++l) {
        if (l == 1) {
            {
                pg8::Gemm g{(const bf16_t*)(ws + WS_U), (const bf16_t*)(ws + WS_WT_DIN), 1024, 1024};
                pg8::PlainOrder S; S.init(MT / 256, DN_NP / 256, 16, F.G, F.c);
                pg8::EpiBf16 E{(bf16_t*)(ws + WS_PROJ), DN_NP};
                pg8::gemm_phase(F.lds, g, S, E);
            }
            GSYNC();
            dn::chunk_phase(F);
            for (int L = F.c; L < DECB * 8; L += F.G) dn::sample_item(F, L >> 3, L & 7);
            GSYNC();
            for (int L = F.c; L < 256; L += F.G) { const int sl = (L >> 3) & 3, bh = (L & 7) + 8 * (L >> 5); dn::scan_item(F, bh >> 3, bh & 7, sl); }
            for (int L = F.c; L < 256; L += F.G) { const int sl = (L >> 3) & 3, bh = (L & 7) + 8 * (L >> 5); dn::scan_tail(F, bh >> 3, bh & 7, sl); }
            GSYNC();
            {
                pg8::Gemm g{(const bf16_t*)(ws + WS_DOG), (const bf16_t*)(ws + WS_WT_DO), 1024, 1024};
                pg8::SplitOrder S; S.init(MP / 256, 4, 16, F.G, F.c); S.pmx = MP / 256; S.nsplit = 4;
                pg8::EpiMix E{(bf16_t*)(ws + WS_MIX), DM, (float*)(ws + WS_SLAB)};
                pg8::gemm_phase(F.lds, g, S, E);
            }
            GSYNC();
            rowpass(F, false, false, F.p->in[6] + 5 * DM, F.p->in[6] + 6 * DM, 4);
            GSYNC();
        }
        {
            pg8::Gemm g{(const bf16_t*)(ws + WS_U), (const bf16_t*)(ws + WS_WT_F1) + (size_t)l * 5632 * 1024, 1024, 1024};
            pg8::PlainOrder S; S.init(MT / 256, 22, 16, F.G, F.c);
            pg8::EpiSwiglu E{(bf16_t*)(ws + WS_H), DFF};
            pg8::gemm_phase(F.lds, g, S, E);
        }
        GSYNC();
        {
            pg8::Gemm g{(const bf16_t*)(ws + WS_H), (const bf16_t*)(ws + WS_WT_F2) + (size_t)l * 1024 * DFF, DFF, DFF};
            pg8::SplitOrder S; S.init(MP / 256, 4, 44, F.G, F.c); S.pmx = MP / 256; S.nsplit = 11;
            pg8::EpiMix E{(bf16_t*)(ws + WS_MIX), DM, (float*)(ws + WS_SLAB)};
            pg8::gemm_phase(F.lds, g, S, E);
        }
        GSYNC();
        rowpass(F, false, l == 1, F.p->in[6] + (l * 4 + 3) * DM, l == 0 ? F.p->in[6] + 4 * DM : nullptr, 11);
        if (l == 0) GSYNC();
    }
}

extern "C" void kernel_launch(void* const* d_in, const int* in_sizes, int n_in, void* d_out, int out_size, void* d_ws, size_t ws_size, hipStream_t stream) {
    static int grid = 0;
    if (grid == 0) {
        int dev = 0, cus = 0, per_cu = 0;
        hipGetDevice(&dev);
        hipDeviceGetAttribute(&cus, hipDeviceAttributeMultiprocessorCount, dev);
        hipFuncSetAttribute((const void*)fwd_kernel, hipFuncAttributeMaxDynamicSharedMemorySize, LDS_BYTES);
        hipOccupancyMaxActiveBlocksPerMultiprocessor(&per_cu, (const void*)fwd_kernel, NTHREADS, LDS_BYTES);
        if (per_cu < 1) { fprintf(stderr, "kernel_launch: occupancy query reports %d blocks per CU\n", per_cu); per_cu = 1; }
        (void)hipGetLastError();
        grid = cus;
        if (n_in != 22 || (size_t)out_size != O_END || ws_size < WS_END) fprintf(stderr, "kernel_launch: unexpected sizes n_in %d out %d ws %zu\n", n_in, out_size, ws_size);
    }
    if (ws_size < WS_END || n_in != 22 || (size_t)out_size != O_END) return;
    hipMemsetAsync((char*)d_ws + WS_CTL, 0, CTL_BYTES, stream);
    Params p{};
    for (int i = 0; i < 22; ++i) p.in[i] = (const float*)d_in[i];
    p.page_table = (const int*)d_in[5]; p.out = (float*)d_out; p.ws = (unsigned char*)d_ws;
    void* args[] = {&p};
    hipError_t e = hipLaunchCooperativeKernel((const void*)fwd_kernel, dim3(grid), dim3(NTHREADS), args, LDS_BYTES, stream);
    if (e != hipSuccess) fprintf(stderr, "cooperative launch failed: %s (grid %d)\n", hipGetErrorString(e), grid);
}
```

```cpp
#include <hip/hip_runtime.h>
#include <hip/hip_cooperative_groups.h>
#include <cstdio>
#include <cstdint>
namespace cg = cooperative_groups;

#define LAS __attribute__((address_space(3)))
#define GAS __attribute__((address_space(1)))
typedef unsigned short bf16_t;
typedef short bf16x8 __attribute__((ext_vector_type(8)));
typedef short s16x4 __attribute__((ext_vector_type(4)));
typedef float f32x4 __attribute__((ext_vector_type(4)));
typedef float f32x2 __attribute__((ext_vector_type(2)));
typedef unsigned u32x4 __attribute__((ext_vector_type(4)));
typedef unsigned u32x2 __attribute__((ext_vector_type(2)));

constexpr int DM = 1024, BATCH = 8, SEQ = 2048, DECB = 32, DECS = 4, PAST = 16384, PAGE = 128;
constexpr int MP = BATCH * SEQ;
constexpr int MS = DECB * DECS;
constexpr int MV = MP + MS;
constexpr int MT = 16640;
constexpr int HEADS = 8, QK_NOPE = 128, QK_ROPE = 64, V_HEAD = 128, KV_LORA = 256, Q_LORA = 384, MLA_ROW = 320;
constexpr int NIN0 = Q_LORA + MLA_ROW;
constexpr int NIN0P = 768;
constexpr int NQ = HEADS * KV_LORA + HEADS * QK_ROPE;
constexpr int DN_HK = 1024, DN_QKV = 3072, DN_Z = 1024, DN_N = 4112, DN_NP = 4352, CONVW = 4, CHUNK = 64;
constexpr int DFF = 2816;
constexpr int NPAGES = PAST / PAGE;
constexpr float RMS_EPS = 1e-6f, L2_EPS = 1e-6f;
constexpr int NTHREADS = 512, NWAVES = 8;

constexpr size_t O_Y = 0;
constexpr size_t O_ROWS = (size_t)MV * DM;
constexpr size_t O_SP = O_ROWS + (size_t)MV * MLA_ROW;
constexpr size_t O_SS = O_SP + (size_t)BATCH * 8 * 128 * 128;
constexpr size_t O_CP = O_SS + (size_t)DECB * 8 * 128 * 128;
constexpr size_t O_CS = O_CP + (size_t)BATCH * 3 * DN_QKV;
constexpr size_t O_END = O_CS + (size_t)DECB * 3 * DN_QKV;

constexpr size_t MiB = 1u << 20;
constexpr size_t WS_CTL = 0;
constexpr size_t CTL_BYTES = 1 * MiB;
constexpr size_t WS_ROPE = 1 * MiB;
constexpr size_t WS_WT_IN0 = 2 * MiB;
constexpr size_t WS_WT_Q = 856 * MiB;
constexpr size_t WS_WT_UVO = 6 * MiB;
constexpr size_t WS_BD_UV = 10 * MiB;
constexpr size_t WS_WOT = 14 * MiB;
constexpr size_t WS_BD_UK = 16 * MiB;
constexpr size_t WS_UQN = 20 * MiB;
constexpr size_t WS_WT_F1 = 22 * MiB;
constexpr size_t WS_WT_F2 = 44 * MiB;
constexpr size_t WS_WT_DIN = 56 * MiB;
constexpr size_t WS_WT_DO = 65 * MiB;
constexpr size_t WS_U = 68 * MiB;
constexpr size_t WS_A0 = 102 * MiB;
constexpr size_t WS_CQ = 152 * MiB;
constexpr size_t WS_ROWSB = 166 * MiB;
constexpr size_t WS_Q = 178 * MiB;
constexpr size_t WS_OL = 260 * MiB;
constexpr size_t WS_MIX = 326 * MiB;
constexpr size_t WS_SLAB = 392 * MiB;
constexpr size_t WS_H = 400 * MiB;
constexpr size_t WS_PROJ = 490 * MiB;
constexpr size_t WS_PART = 632 * MiB;
constexpr size_t WS_ML = 641 * MiB;
constexpr size_t WS_DO = 642 * MiB;
constexpr size_t WS_DOG = 676 * MiB;
constexpr size_t WS_UU = 710 * MiB;
constexpr size_t WS_WW = 742 * MiB;
constexpr size_t WS_QD = 774 * MiB;
constexpr size_t WS_KDT = 806 * MiB;
constexpr size_t WS_QKM = 838 * MiB;
constexpr size_t WS_GL = 854 * MiB;
constexpr size_t WS_HB = 860 * MiB;
constexpr size_t WS_END = 894 * MiB;
constexpr int NSLAB_MAX = 16;

constexpr int CW_GEN = 64;
constexpr int CW_ATT = 8192;

__device__ __forceinline__ float bf2f(unsigned short b) { return __builtin_bit_cast(float, (unsigned)b << 16); }
typedef float f32x2_t __attribute__((ext_vector_type(2)));
typedef __bf16 bf16x2_t __attribute__((ext_vector_type(2)));
__device__ __forceinline__ unsigned cvt_pk_bf16(float lo, float hi) { f32x2_t v = {lo, hi}; bf16x2_t b = __builtin_convertvector(v, bf16x2_t); return __builtin_bit_cast(unsigned, b); }
__device__ __forceinline__ unsigned f2bf(float f) { return cvt_pk_bf16(f, 0.f) & 0xffffu; }
__device__ __forceinline__ unsigned pk2(float lo, float hi) { return cvt_pk_bf16(lo, hi); }
__device__ __forceinline__ float wave_sum(float v) {
#pragma unroll
    for (int o = 1; o < 64; o <<= 1) v += __shfl_xor(v, o);
    return v;
}
#define LDS_WAIT() asm volatile("s_waitcnt lgkmcnt(0)" ::: "memory")
#define VM_WAIT() asm volatile("s_waitcnt vmcnt(0)" ::: "memory")

typedef __attribute__((address_space(1))) unsigned char g_u8_t;
#define OPAQUE_WS(ws) do { g_u8_t* w1_ = (g_u8_t*)(ws); asm volatile("" : "+s"(w1_)); ws = (unsigned char*)w1_; } while (0)
namespace pg8 {
constexpr int BM = 256, BK = 64, HALF = 128, HTB = HALF * BK * 2, STAGE_BYTES = 8 * HTB, NXCD = 8, WGM = 8;
__host__ __device__ __forceinline__ int lds_byte(int r, int c) { const int st = (r >> 4) * 2 + (c >> 5), rr = r & 15, cc = c & 31, ob = rr * 64 + cc * 2; return st * 1024 + (ob ^ (((ob >> 9) & 1) << 5)); }
__host__ __device__ __forceinline__ void stage_rc(int b, int& R, int& C) { const int st = b / 1024, sb = b % 1024, swz = sb ^ (((sb >> 9) & 1) << 5); R = (st >> 1) * 16 + swz / 64; C = (st & 1) * 32 + (swz % 64) / 2; }
__host__ __device__ __forceinline__ int perm32(int rho) { const int n = rho >> 4, i = rho & 15; return 8 * (i >> 2) + 4 * n + (i & 3); }

struct Unit { int pm, pn, kt0, nkt, z; };
struct Gemm { const bf16_t* A; const bf16_t* Bt; int lda, ldb; };

struct MainOrder {
    int nM, nN, nwg, G, c, nkt;
    __device__ __forceinline__ void init(int nM_, int nN_, int nkt_, int G_, int c_) { nM = nM_; nN = nN_; nwg = nM * nN; G = G_; c = c_; nkt = nkt_; asm volatile("" : "+s"(c)); }
    __device__ __forceinline__ void main_map(int L, int& pm, int& pn) const {
        int wgid = L; { const int q = nwg / NXCD, r = nwg % NXCD, xcd = wgid % NXCD, off = wgid / NXCD; wgid = (xcd < r ? xcd * (q + 1) : r * (q + 1) + (xcd - r) * q) + off; }
        const int nig = WGM * nN, gid = wgid / nig, fm = gid * WGM, gsz = (nM - fm) < WGM ? (nM - fm) : WGM;
        pm = fm + ((wgid % nig) % gsz); pn = (wgid % nig) / gsz;
    }
};
struct SplitOrder : MainOrder {
    int pmx, nsplit;
    __device__ __forceinline__ bool next(int i, Unit& u) const {
        const int L = i * G + c; const bool is_main = L < nwg; const int e = L - nwg; const bool ok = is_main || e < nsplit * nN;
        int pm = 0, pn = 0; main_map(is_main ? L : 0, pm, pn);
        const int per = nkt / nsplit, z = e / nN;
        Unit r; r.pm = is_main ? pm : pmx; r.pn = is_main ? pn : e % nN; r.kt0 = is_main ? 0 : z * per; r.nkt = is_main ? nkt : per; r.z = is_main ? -1 : z;
        u = r; return ok;
    }
};
struct PlainOrder : MainOrder {
    __device__ __forceinline__ bool next(int i, Unit& u) const {
        const int L = i * G + c; const bool ok = L < nwg; int pm = 0, pn = 0; main_map(ok ? L : 0, pm, pn);
        Unit r; r.pm = pm; r.pn = pn; r.kt0 = 0; r.nkt = nkt; r.z = -1; u = r; return ok;
    }
};
struct PrepOrder {
    int nM, nN, G, c, c0, by_m;
    __device__ __forceinline__ bool next(int i, Unit& u) const {
        const int i0 = c < c0 ? (c0 - c + G - 1) / G : 0; const int L = (i + i0) * G + c - c0; const bool ok = L < nM * nN;
        const int pm = ok ? L / nN : 0, pn = ok ? L % nN : 0; const int h = by_m ? pm : pn;
        int four = 4; asm volatile("" : "+s"(four));
        Unit r; r.pm = pm; r.pn = pn; r.kt0 = 4 * (h >> 1); r.nkt = four; r.z = -1; u = r; return ok;
    }
};

struct EpiF32 {
    static constexpr bool PERM = false;
    float* C; int ldc; float* slab;
    __device__ __forceinline__ void operator()(const f32x4 (&acc)[2][2][4][2], const Unit& u, int wr, int wc, int fr, int fq) const {
        const bool split = u.z >= 0;
        float* base = (split ? slab + (size_t)u.z * 128 * ldc : C + (size_t)u.pm * BM * ldc) + (size_t)(wr * 64 + fr) * ldc + u.pn * BM + wc * 32 + 4 * fq;
#pragma unroll
        for (int ai = 0; ai < 2; ++ai) {
            if (ai == 1 && split) break;
#pragma unroll
            for (int m = 0; m < 4; ++m) { float* rowp = base + (size_t)(ai * HALF + m * 16) * ldc;
#pragma unroll
                for (int bj = 0; bj < 2; ++bj)
#pragma unroll
                    for (int n = 0; n < 2; ++n) *(f32x4*)(rowp + bj * HALF + n * 16) = acc[ai][bj][m][n]; }
        }
    }
};
struct EpiMix {
    static constexpr bool PERM = true;
    bf16_t* C; int ldc; float* slab;
    __device__ __forceinline__ void operator()(const f32x4 (&acc)[2][2][4][2], const Unit& u, int wr, int wc, int fr, int fq) const {
        const int col0 = u.pn * BM + wc * 32 + 8 * fq;
        if (u.z < 0) {
            const int row0 = u.pm * BM + wr * 64 + fr;
#pragma unroll
            for (int ai = 0; ai < 2; ++ai)
#pragma unroll
                for (int m = 0; m < 4; ++m) { bf16_t* rowp = C + (size_t)(row0 + ai * HALF + m * 16) * ldc + col0;
#pragma unroll
                    for (int bj = 0; bj < 2; ++bj) { const f32x4 v0 = acc[ai][bj][m][0], v1 = acc[ai][bj][m][1];
                        u32x4 w; w.x = cvt_pk_bf16(v0[0], v0[1]); w.y = cvt_pk_bf16(v0[2], v0[3]); w.z = cvt_pk_bf16(v1[0], v1[1]); w.w = cvt_pk_bf16(v1[2], v1[3]);
                        *(u32x4*)(rowp + bj * HALF) = w; } }
        } else {
            float* base = slab + (size_t)u.z * 128 * ldc + (size_t)(wr * 64 + fr) * ldc + col0;
#pragma unroll
            for (int m = 0; m < 4; ++m)
#pragma unroll
                for (int bj = 0; bj < 2; ++bj) { float* p = base + (size_t)(m * 16) * ldc + bj * HALF; *(f32x4*)p = acc[0][bj][m][0]; *(f32x4*)(p + 4) = acc[0][bj][m][1]; }
        }
    }
};
struct EpiBf16 {
    static constexpr bool PERM = true;
    bf16_t* C; int ldc;
    __device__ __forceinline__ void operator()(const f32x4 (&acc)[2][2][4][2], const Unit& u, int wr, int wc, int fr, int fq) const {
        const int row0 = u.pm * BM + wr * 64 + fr, col0 = u.pn * BM + wc * 32 + 8 * fq;
#pragma unroll
        for (int ai = 0; ai < 2; ++ai)
#pragma unroll
            for (int m = 0; m < 4; ++m) { bf16_t* rowp = C + (size_t)(row0 + ai * HALF + m * 16) * ldc + col0;
#pragma unroll
                for (int bj = 0; bj < 2; ++bj) { const f32x4 v0 = acc[ai][bj][m][0], v1 = acc[ai][bj][m][1];
                    u32x4 w; w.x = cvt_pk_bf16(v0[0], v0[1]); w.y = cvt_pk_bf16(v0[2], v0[3]); w.z = cvt_pk_bf16(v1[0], v1[1]); w.w = cvt_pk_bf16(v1[2], v1[3]);
                    *(u32x4*)(rowp + bj * HALF) = w; } }
    }
};
struct EpiSwiglu {
    static constexpr bool PERM = true;
    bf16_t* C; int ldc;
    __device__ __forceinline__ void operator()(const f32x4 (&acc)[2][2][4][2], const Unit& u, int wr, int wc, int fr, int fq) const {
        const int row0 = u.pm * BM + wr * 64 + fr, col0 = u.pn * HALF + wc * 32 + 8 * fq;
#pragma unroll
        for (int ai = 0; ai < 2; ++ai)
#pragma unroll
            for (int m = 0; m < 4; ++m) { float o[8];
#pragma unroll
                for (int n = 0; n < 2; ++n)
#pragma unroll
                    for (int j = 0; j < 4; ++j) { const float g = acc[ai][0][m][n][j], up = acc[ai][1][m][n][j]; o[4 * n + j] = g * __builtin_amdgcn_rcpf(1.f + __expf(-g)) * up; }
                u32x4 w; w.x = cvt_pk_bf16(o[0], o[1]); w.y = cvt_pk_bf16(o[2], o[3]); w.z = cvt_pk_bf16(o[4], o[5]); w.w = cvt_pk_bf16(o[6], o[7]);
                *(u32x4*)(C + (size_t)(row0 + ai * HALF + m * 16) * ldc + col0) = w; }
    }
};
struct EpiQ {
    static constexpr bool PERM = true;
    bf16_t* C; const f32x2* rope; float scale;
    __device__ __forceinline__ void operator()(const f32x4 (&acc)[2][2][4][2], const Unit& u, int wr, int wc, int fr, int fq) const {
        const int row0 = u.pm * BM + wr * 64 + fr, col0 = u.pn * BM + wc * 32 + 8 * fq;
        const bool rp = u.pn >= 8;
#pragma unroll
        for (int ai = 0; ai < 2; ++ai)
#pragma unroll
            for (int m = 0; m < 4; ++m) { const int row = row0 + ai * HALF + m * 16;
                int pidx = row < MP ? (row & (SEQ - 1)) : (SEQ + ((row - MP) & 3)); if (row >= MV) pidx = 0;
                bf16_t* rowp = C + (size_t)row * NQ + col0;
#pragma unroll
                for (int bj = 0; bj < 2; ++bj) { f32x4 v0 = acc[ai][bj][m][0], v1 = acc[ai][bj][m][1];
                    if (rp) { const int i0 = ((col0 + bj * HALF) & 63) >> 1; const f32x2* t = rope + pidx * 32 + i0;
                        const f32x2 c0 = t[0], c1 = t[1], c2 = t[2], c3 = t[3];
                        const f32x4 r0 = {v0[0] * c0.x - v0[1] * c0.y, v0[1] * c0.x + v0[0] * c0.y, v0[2] * c1.x - v0[3] * c1.y, v0[3] * c1.x + v0[2] * c1.y};
                        const f32x4 r1 = {v1[0] * c2.x - v1[1] * c2.y, v1[1] * c2.x + v1[0] * c2.y, v1[2] * c3.x - v1[3] * c3.y, v1[3] * c3.x + v1[2] * c3.y};
                        v0 = r0; v1 = r1; }
                    v0 = v0 * scale; v1 = v1 * scale;
                    if (rp) {
                        const int cc = col0 + bj * HALF - 2048, hh = cc >> 6, i0 = (cc & 63) >> 1; bf16_t* qp = C + (size_t)row * NQ + 2048 + hh * 64 + i0;
                        u32x2 a, b; a.x = cvt_pk_bf16(v0[0], v0[2]); a.y = cvt_pk_bf16(v1[0], v1[2]); b.x = cvt_pk_bf16(v0[1], v0[3]); b.y = cvt_pk_bf16(v1[1], v1[3]);
                        *(u32x2*)qp = a; *(u32x2*)(qp + 32) = b;
                    } else {
                    u32x4 w; w.x = cvt_pk_bf16(v0[0], v0[1]); w.y = cvt_pk_bf16(v0[2], v0[3]); w.z = cvt_pk_bf16(v1[0], v1[1]); w.w = cvt_pk_bf16(v1[2], v1[3]);
                    *(u32x4*)(rowp + bj * HALF) = w; } } }
    }
};

template <class Epi, class Sched>
__device__ __forceinline__ void gemm_phase(LAS unsigned char* lds, const Gemm g, const Sched& S, const Epi& E) {
    int tid = threadIdx.x; asm volatile("" : "+v"(tid));
    const int wid = __builtin_amdgcn_readfirstlane(tid >> 6), lane = tid & 63, wr = wid >> 2, wc = wid & 3, fr = lane & 15, fq = lane >> 4;
    unsigned voffA[2], voffB[2];
#pragma unroll
    for (int i = 0; i < 2; ++i) { int R, C; stage_rc(tid * 16 + i * 8192, R, C); const int Rb = Epi::PERM ? ((R & ~31) + perm32(R & 31)) : R;
        voffA[i] = (unsigned)(R * g.lda + C) * 2u; voffB[i] = (unsigned)(Rb * g.ldb + C) * 2u; }
    const size_t kstep = (size_t)(BK * 2);
    const size_t hstepA = (size_t)HALF * g.lda * 2, hstepB = (size_t)HALF * g.ldb * 2;
    const size_t tstepA = 2 * hstepA, tstepB = 2 * hstepB;
    const unsigned ldsw = (unsigned)wid * 1024u;
    const int aoff = lds_byte(wr * 64 + fr, fq * 8), boff = lds_byte(wc * 32 + fr, fq * 8);
#define PG8_SA(b, h) (((b) * 2 + (h)) * HTB)
#define PG8_SB(b, h) ((4 + (b) * 2 + (h)) * HTB)
#define PG8_STAGE(bufoff, gbase, voff) do { _Pragma("unroll") for (int _i = 0; _i < 2; ++_i) \
        __builtin_amdgcn_global_load_lds((const unsigned*)((const char*)(gbase) + (voff)[_i]), (LAS unsigned*)(lds + (bufoff) + ldsw + _i * 8192), 16, 0, 0); } while (0)
#define PG8_LDA(dst, b, h) do { _Pragma("unroll") for (int m = 0; m < 4; ++m) _Pragma("unroll") for (int k = 0; k < 2; ++k) dst[m][k] = *(const LAS bf16x8*)(lds + PG8_SA(b, h) + aoff + m * 2048 + k * 1024); } while (0)
#define PG8_LDB(dst, b, h) do { _Pragma("unroll") for (int n = 0; n < 2; ++n) _Pragma("unroll") for (int k = 0; k < 2; ++k) dst[n][k] = *(const LAS bf16x8*)(lds + PG8_SB(b, h) + boff + n * 2048 + k * 1024); } while (0)
#define PG8_MMA(ai, bj, At, Bt) do { __builtin_amdgcn_s_setprio(1); _Pragma("unroll") for (int m = 0; m < 4; ++m) _Pragma("unroll") for (int n = 0; n < 2; ++n) _Pragma("unroll") for (int k = 0; k < 2; ++k) \
        acc[ai][bj][m][n] = __builtin_amdgcn_mfma_f32_16x16x32_bf16(Bt[n][k], At[m][k], acc[ai][bj][m][n], 0, 0, 0); __builtin_amdgcn_s_setprio(0); } while (0)
#define PG8_WAIT_V(n) asm volatile("s_waitcnt vmcnt(" #n ")" ::: "memory")
#define PG8_WAIT_L(n) asm volatile("s_waitcnt lgkmcnt(" #n ")" ::: "memory")
#define PG8_BAR __builtin_amdgcn_s_barrier()
#define PG8_SCHED __builtin_amdgcn_sched_barrier(0)
    Unit cur, nxt; int ui = 0;
    if (!S.next(0, cur)) return;
    f32x4 acc[2][2][4][2];
#pragma unroll
    for (int a = 0; a < 2; ++a)
#pragma unroll
        for (int b = 0; b < 2; ++b)
#pragma unroll
            for (int m = 0; m < 4; ++m)
#pragma unroll
                for (int n = 0; n < 2; ++n) acc[a][b][m][n] = (f32x4){0.f, 0.f, 0.f, 0.f};
    bf16x8 At[4][2], B0[2][2], B1[2][2];
    const char* cA = (const char*)g.A + (size_t)cur.pm * tstepA + (size_t)cur.kt0 * kstep; const char* cB = (const char*)g.Bt + (size_t)cur.pn * tstepB + (size_t)cur.kt0 * kstep;
    PG8_STAGE(PG8_SB(0, 0), cB, voffB); PG8_STAGE(PG8_SB(0, 1), cB + hstepB, voffB); PG8_STAGE(PG8_SA(0, 0), cA, voffA); PG8_STAGE(PG8_SA(0, 1), cA + hstepA, voffA);
    if (wr == 1) PG8_BAR;
    PG8_WAIT_V(2); PG8_BAR;
    PG8_STAGE(PG8_SB(1, 0), cB + kstep, voffB); PG8_STAGE(PG8_SA(1, 0), cA + kstep, voffA); PG8_STAGE(PG8_SB(1, 1), cB + hstepB + kstep, voffB);
    PG8_WAIT_V(6); PG8_BAR;
    for (;;) {
        const bool has_next = S.next(ui + 1, nxt);
        const char* nA = has_next ? (const char*)g.A + (size_t)nxt.pm * tstepA + (size_t)nxt.kt0 * kstep : cA;
        const char* nB = has_next ? (const char*)g.Bt + (size_t)nxt.pn * tstepB + (size_t)nxt.kt0 * kstep : cB;
        const int nt = cur.nkt;
        for (int t = 0; t < nt; t += 2) {
            const bool last = (t == nt - 2);
            const char* a1 = cA + (size_t)(t + 1) * kstep;
            const char* a2 = last ? nA : cA + (size_t)(t + 2) * kstep; const char* b2 = last ? nB : cB + (size_t)(t + 2) * kstep;
            const char* a3 = a2 + kstep; const char* b3 = b2 + kstep;
            PG8_LDB(B0, 0, 0); PG8_LDB(B1, 0, 1); PG8_SCHED; PG8_LDA(At, 0, 0); PG8_STAGE(PG8_SA(1, 1), a1 + hstepA, voffA);
            PG8_WAIT_V(8); PG8_WAIT_L(0); PG8_BAR; PG8_MMA(0, 0, At, B0); PG8_MMA(0, 1, At, B1); PG8_BAR; PG8_SCHED;
            PG8_LDA(At, 0, 1); PG8_STAGE(PG8_SB(0, 0), b2, voffB); PG8_STAGE(PG8_SB(0, 1), b2 + hstepB, voffB); PG8_STAGE(PG8_SA(0, 0), a2, voffA);
            PG8_WAIT_V(8); PG8_WAIT_L(0); PG8_BAR; PG8_MMA(1, 0, At, B0); PG8_MMA(1, 1, At, B1); PG8_BAR; PG8_SCHED;
            PG8_LDB(B0, 1, 0); PG8_LDB(B1, 1, 1); PG8_SCHED; PG8_LDA(At, 1, 0); PG8_STAGE(PG8_SA(0, 1), a2 + hstepA, voffA);
            PG8_WAIT_V(8); PG8_WAIT_L(0); PG8_BAR; PG8_MMA(0, 0, At, B0); PG8_MMA(0, 1, At, B1); PG8_BAR; PG8_SCHED;
            PG8_LDA(At, 1, 1); PG8_STAGE(PG8_SB(1, 0), b3, voffB); PG8_STAGE(PG8_SB(1, 1), b3 + hstepB, voffB); PG8_STAGE(PG8_SA(1, 0), a3, voffA);
            PG8_WAIT_V(8); PG8_WAIT_L(0); PG8_BAR; PG8_MMA(1, 0, At, B0); PG8_MMA(1, 1, At, B1); PG8_BAR; PG8_SCHED;
        }
        if (wr == 0) PG8_BAR;
        E(acc, cur, wr, wc, fr, fq);
        if (!has_next) break;
#pragma unroll
        for (int a = 0; a < 2; ++a)
#pragma unroll
            for (int b = 0; b < 2; ++b)
#pragma unroll
                for (int m = 0; m < 4; ++m)
#pragma unroll
                    for (int n = 0; n < 2; ++n) acc[a][b][m][n] = (f32x4){0.f, 0.f, 0.f, 0.f};
        cur = nxt; cA = nA; cB = nB; ++ui;
        if (wr == 1) PG8_BAR;
    }
    PG8_WAIT_V(0);
    PG8_BAR;
#undef PG8_SA
#undef PG8_SB
#undef PG8_STAGE
#undef PG8_LDA
#undef PG8_LDB
#undef PG8_MMA
#undef PG8_WAIT_V
#undef PG8_WAIT_L
#undef PG8_BAR
#undef PG8_SCHED
}
}


#define XB_TMO      128
#define XB_XCNT(j)  (256  + 64 * (j))
#define XB_XSUB(j)  (1280 + 64 * (j))
#define XB_XGEN(j)  (2304 + 64 * (j))
#define XB_TOP      3328
#define XB_TOPGEN   3392
#define XCD_BAR_WORDS 3456
#define XB_SPIN_CAP (1u << 22)
__device__ __forceinline__ unsigned xb_ld(unsigned* p)              { return __hip_atomic_load(p, __ATOMIC_RELAXED, __HIP_MEMORY_SCOPE_AGENT); }
__device__ __forceinline__ unsigned xb_add(unsigned* p, unsigned v) { return __hip_atomic_fetch_add(p, v, __ATOMIC_RELAXED, __HIP_MEMORY_SCOPE_AGENT); }
__device__ __forceinline__ unsigned xb_xcc_id() { return (unsigned)__builtin_amdgcn_s_getreg((3 << 11) | 20) & 0xFu; }
#define XB_SPIN(cond, bar) do { unsigned _sp = 0; while (cond) { __builtin_amdgcn_s_sleep(1); \
    if ((++_sp & 255u) == 0u) { if (xb_ld(&(bar)[XB_TMO])) break; if (_sp > XB_SPIN_CAP) { atomicAdd(&(bar)[XB_TMO], 1u); break; } } } } while (0)
struct XcdBarrier { unsigned* bar; unsigned x; volatile LAS unsigned* st; };
__device__ __forceinline__ XcdBarrier xcd_barrier_post(unsigned* bar, volatile LAS unsigned* st) {
    XcdBarrier b; b.bar = bar; b.x = xb_xcc_id(); b.st = st;
    if (threadIdx.x == 0) (void)xb_add(&bar[XB_XCNT(b.x)], 1u);
    return b;
}
__device__ __forceinline__ void xcd_barrier_complete(unsigned* bar, unsigned x, unsigned& nloc, unsigned& nx) {
    const unsigned G = gridDim.x * gridDim.y * gridDim.z;
    unsigned sum, cnt, mine, sp = 0u;
    for (;;) {
        sum = 0u; cnt = 0u; mine = 0u;
#pragma unroll
        for (unsigned j = 0; j < 16; ++j) { const unsigned c = xb_ld(&bar[XB_XCNT(j)]); sum += c; cnt += (c > 0u) ? 1u : 0u; mine = (j == x) ? c : mine; }
        if (sum == G) break;
        __builtin_amdgcn_s_sleep(1);
        if ((++sp & 255u) == 0u) { if (xb_ld(&bar[XB_TMO])) break; if (sp > XB_SPIN_CAP) { atomicAdd(&bar[XB_TMO], 1u); break; } }
    }
    nloc = mine > 0u ? mine : 1u; nx = cnt > 0u ? cnt : 1u;
}
__device__ __forceinline__ void xcd_barrier(const XcdBarrier& b0) {
    XcdBarrier b; b.bar = b0.bar; b.st = b0.st; b.x = (unsigned)__builtin_amdgcn_readfirstlane((int)xb_xcc_id());
    asm volatile("s_waitcnt vmcnt(0)" ::: "memory");
    __syncthreads();
    if (threadIdx.x == 0) {
        unsigned* bar = b.bar;
        __builtin_amdgcn_s_waitcnt(0);
        unsigned nloc = b.st[0], nx = b.st[1];
        if (nloc == 0u) { xcd_barrier_complete(bar, b.x, nloc, nx); b.st[0] = nloc; b.st[1] = nx; }
        const unsigned old = xb_add(&bar[XB_XSUB(b.x)], 1u);
        const unsigned gen = old / nloc;
        if (old + 1u == (gen + 1u) * nloc) {
            __builtin_amdgcn_fence(__ATOMIC_RELEASE, "agent");
            asm volatile("s_waitcnt vmcnt(0)" ::: "memory");
            const unsigned og = xb_add(&bar[XB_TOP], 1u);
            const unsigned tg = og / nx;
            if (og + 1u == (tg + 1u) * nx) xb_add(&bar[XB_TOPGEN], 1u);
            else XB_SPIN(xb_ld(&bar[XB_TOPGEN]) == tg, bar);
            __builtin_amdgcn_fence(__ATOMIC_ACQUIRE, "agent");
            xb_add(&bar[XB_XGEN(b.x)], 1u);
            asm volatile("s_waitcnt vmcnt(0)" ::: "memory");
        } else {
            XB_SPIN(xb_ld(&bar[XB_XGEN(b.x)]) == gen, bar);
            __builtin_amdgcn_fence(__ATOMIC_ACQUIRE, "agent");
            asm volatile("s_waitcnt vmcnt(0)" ::: "memory");
        }
    }
    __syncthreads();
}

constexpr int CW_HAND = 32768;
__device__ __forceinline__ void hand_signal(unsigned* cnt) {
    asm volatile("s_waitcnt vmcnt(0)" ::: "memory");
    __syncthreads();
    if (threadIdx.x == 0) { __builtin_amdgcn_fence(__ATOMIC_RELEASE, "agent"); asm volatile("s_waitcnt vmcnt(0)" ::: "memory");
        __hip_atomic_fetch_add(cnt, 1u, __ATOMIC_RELAXED, __HIP_MEMORY_SCOPE_AGENT); }
}
__device__ __forceinline__ void hand_wait(unsigned* cnt, unsigned need) {
    if (threadIdx.x == 0) { unsigned sp = 0;
        while (__hip_atomic_load(cnt, __ATOMIC_RELAXED, __HIP_MEMORY_SCOPE_AGENT) < need) { __builtin_amdgcn_s_sleep(2); if (++sp > (1u << 24)) break; }
        __builtin_amdgcn_fence(__ATOMIC_ACQUIRE, "agent"); asm volatile("s_waitcnt vmcnt(0)" ::: "memory"); }
    __syncthreads();
}

constexpr int LDS_BYTES = 147456;
struct Params {
    const float* in[22]; const int* page_table; float* out; unsigned char* ws; int pad0, pad1;
};
struct Frame {
    LAS unsigned char* lds;
    int tid, lane, wave, G, c;
    const Params* p;
};

__device__ __forceinline__ void transpose_item(const float* W, int ldw, int k0, int n_src0, int n_valid, bf16_t* WT, int ldd, int row_base, int row_stride, LAS float* scr, int lane) {
    const int n4 = (lane & 7) * 4;
    f32x4 v[8];
#pragma unroll
    for (int i = 0; i < 8; ++i) { const int kk = 8 * i + (lane >> 3); v[i] = (n_src0 + n4 < n_valid) ? __builtin_nontemporal_load((const f32x4*)(W + (size_t)(k0 + kk) * ldw + n_src0 + n4)) : (f32x4){0.f, 0.f, 0.f, 0.f}; }
#pragma unroll
    for (int i = 0; i < 8; ++i) { LAS float* d = scr + (8 * i + (lane >> 3)) * 33 + n4; d[0] = v[i].x; d[1] = v[i].y; d[2] = v[i].z; d[3] = v[i].w; }
    LDS_WAIT(); asm volatile("" ::: "memory");
    const int c = lane & 7;
#pragma unroll
    for (int j = 0; j < 4; ++j) { const int n = (lane >> 3) + 8 * j; const LAS float* s = scr + (8 * c) * 33 + n;
        u32x4 o; o.x = pk2(s[0 * 33], s[1 * 33]); o.y = pk2(s[2 * 33], s[3 * 33]); o.z = pk2(s[4 * 33], s[5 * 33]); o.w = pk2(s[6 * 33], s[7 * 33]);
        if (n_src0 + n < n_valid) *(u32x4*)(WT + (size_t)(row_base + n * row_stride) * ldd + k0 + 8 * c) = o; }
    LDS_WAIT(); asm volatile("" ::: "memory");
}
__device__ __forceinline__ void rms_row_to_bf16(const float* xrow, const float* w, bf16_t* orow, int lane) {
    const f32x4* xr = (const f32x4*)xrow + lane; const f32x4* wr = (const f32x4*)w + lane;
    f32x4 v[4]; float s = 0.f;
#pragma unroll
    for (int j = 0; j < 4; ++j) { v[j] = xr[64 * j]; s += (v[j].x * v[j].x + v[j].y * v[j].y) + (v[j].z * v[j].z + v[j].w * v[j].w); }
    const float rs = rsqrtf(wave_sum(s) * (1.f / DM) + RMS_EPS);
    u32x2* o8 = (u32x2*)orow + lane;
#pragma unroll
    for (int j = 0; j < 4; ++j) { const f32x4 g = wr[64 * j]; u32x2 o; o.x = pk2(v[j].x * rs * g.x, v[j].y * rs * g.y); o.y = pk2(v[j].z * rs * g.z, v[j].w * rs * g.w); o8[64 * j] = o; }
}

__device__ __forceinline__ void p0_prologue(Frame& F) {
    const Params& P = *F.p;
    unsigned char* ws = P.ws;
    LAS float* scr = (LAS float*)(F.lds + F.wave * 16384);
    const int gw = F.c * NWAVES + F.wave, NGW = F.G * NWAVES;
    const int gt = F.c * NTHREADS + F.tid, NGT = F.G * NTHREADS;
    constexpr int I_IN0 = 16 * 22, I_ROPE = 6 * 16, I_WO = 16 * 32, I_F1 = 16 * 176, I_F2 = 44 * 32, I_DIN = 16 * 129, I_DO = 16 * 32;
    constexpr int NITEMS = I_IN0 + I_ROPE + I_WO + 2 * I_F1 + 2 * I_F2 + I_DIN + I_DO;
    for (int it = gw; it < NITEMS; it += NGW) {
        int r = it;
        if (r < I_IN0) { const int kb = r / 22, nb = r % 22; transpose_item(P.in[7], NIN0, 64 * kb, 32 * nb, NIN0, (bf16_t*)(ws + WS_WT_IN0), 1024, 32 * nb, 1, scr, F.lane); continue; } r -= I_IN0;
        if (r < I_ROPE) { const int kb = r / 16, hs = r % 16, h = hs >> 1, s = hs & 1;
            transpose_item(P.in[10], 1536, 64 * kb, h * 192 + 128 + 32 * s, 1536, (bf16_t*)(ws + WS_WT_Q), 512, 2048 + h * 64 + s, 2, scr, F.lane); continue; } r -= I_ROPE;
        if (r < I_WO) { const int kb = r / 32, nb = r % 32; transpose_item(P.in[13], 1024, 64 * kb, 32 * nb, 1024, (bf16_t*)(ws + WS_WOT), 1024, 32 * nb, 1, scr, F.lane); continue; } r -= I_WO;
        if (r < 2 * I_F1) { const int l = r / I_F1, q = r % I_F1, kb = q / 176, nb = q % 176; const int n0 = 32 * nb; const int nn = n0 < DFF ? n0 : n0 - DFF;
            const int row = 256 * (nn / 128) + (n0 < DFF ? 0 : 128) + (nn % 128);
            transpose_item(P.in[20] + (size_t)l * 1024 * 5632, 5632, 64 * kb, n0, 5632, (bf16_t*)(ws + WS_WT_F1) + (size_t)l * 5632 * 1024, 1024, row, 1, scr, F.lane); continue; } r -= 2 * I_F1;
        if (r < 2 * I_F2) { const int l = r / I_F2, q = r % I_F2, kb = q / 32, nb = q % 32;
            transpose_item(P.in[21] + (size_t)l * DFF * 1024, 1024, 64 * kb, 32 * nb, 1024, (bf16_t*)(ws + WS_WT_F2) + (size_t)l * 1024 * DFF, DFF, 32 * nb, 1, scr, F.lane); continue; } r -= 2 * I_F2;
        if (r < I_DIN) { const int kb = r / 129, nb = r % 129; transpose_item(P.in[14], DN_N, 64 * kb, 32 * nb, DN_N, (bf16_t*)(ws + WS_WT_DIN), 1024, 32 * nb, 1, scr, F.lane); continue; } r -= I_DIN;
        { const int kb = r / 32, nb = r % 32; transpose_item(P.in[19], 1024, 64 * kb, 32 * nb, 1024, (bf16_t*)(ws + WS_WT_DO), 1024, 32 * nb, 1, scr, F.lane); }
    }
    {
        constexpr int N_BD = 2048 * 128, N_UQ = 512 * 128, N_PADIN = 64 * 128, N_PADD = (DN_NP - DN_N) * 128;
        for (int it = gt; it < 2 * N_BD + N_UQ + N_PADIN + N_PADD; it += NGT) {
            int r = it; u32x4 o = {0u, 0u, 0u, 0u}; bf16_t* dst;
            if (r < 2 * N_BD) { const int which = r / N_BD, q = r % N_BD, row = q >> 7, c8 = (q & 127) * 8, h = row >> 8, rr = row & 255;
                const float* src = (which ? P.in[11] : P.in[12]) + ((size_t)h * 256 + rr) * 128;
                if ((c8 >> 7) == h) { const f32x4 a = *(const f32x4*)(src + (c8 & 127)), b = *(const f32x4*)(src + (c8 & 127) + 4); o.x = pk2(a.x, a.y); o.y = pk2(a.z, a.w); o.z = pk2(b.x, b.y); o.w = pk2(b.z, b.w); }
                dst = (bf16_t*)(ws + (which ? WS_BD_UK : WS_BD_UV)) + (size_t)row * 1024 + c8;
            } else if ((r -= 2 * N_BD) < N_UQ) { const int row = r >> 7, c8 = (r & 127) * 8, h = c8 >> 7, n = c8 & 127;
                if (row < 384) { const float* src = P.in[10] + (size_t)row * 1536 + h * 192 + n; const f32x4 a = *(const f32x4*)src, b = *(const f32x4*)(src + 4); o.x = pk2(a.x, a.y); o.y = pk2(a.z, a.w); o.z = pk2(b.x, b.y); o.w = pk2(b.z, b.w); }
                dst = (bf16_t*)(ws + WS_UQN) + (size_t)row * 1024 + c8;
            } else if ((r -= N_UQ) < N_PADIN) { dst = (bf16_t*)(ws + WS_WT_IN0) + (size_t)(NIN0 + (r >> 7)) * 1024 + (r & 127) * 8;
            } else { r -= N_PADIN; dst = (bf16_t*)(ws + WS_WT_DIN) + (size_t)(DN_N + (r >> 7)) * 1024 + (r & 127) * 8; }
            *(u32x4*)dst = o;
        }
    }
    for (int it = gt; it < 2052 * 32; it += NGT) { const int pi = it >> 5, i = it & 31; const float pos = (float)(pi < SEQ ? pi : PAST + (pi - SEQ));
        const float freq = exp2f(-(float)i * (13.287712379549449f / 32.0f)); const float ang = pos * freq;
        ((f32x2*)(ws + WS_ROPE))[it] = (f32x2){cosf(ang), sinf(ang)}; }
    for (int m = gw; m < MT; m += NGW) {
        bf16_t* orow = (bf16_t*)(ws + WS_U) + (size_t)m * DM;
        if (m < MV) { const float* xrow = m < MP ? P.in[0] + (size_t)m * DM : P.in[1] + (size_t)(m - MP) * DM; rms_row_to_bf16(xrow, P.in[6], orow, F.lane); }
        else { u32x4 z = {0u, 0u, 0u, 0u}; ((u32x4*)orow)[F.lane] = z; ((u32x4*)orow)[F.lane + 64] = z; }
    }
}

__device__ __forceinline__ void m2_rows(Frame& F) {
    const Params& P = *F.p; unsigned char* ws = P.ws; OPAQUE_WS(ws);
    const int gw = F.c * NWAVES + F.wave, NGW = F.G * NWAVES, lane = F.lane;
    const float* gq = P.in[8]; const float* gkv = P.in[9];
    const f32x2* rope = (const f32x2*)(ws + WS_ROPE);
    for (int m = gw; m < MV; m += NGW) {
        const float* a = (const float*)(ws + WS_A0) + (size_t)m * NIN0P;
        float v[11];
#pragma unroll
        for (int j = 0; j < 11; ++j) v[j] = __builtin_nontemporal_load(a + lane + 64 * j);
        float sq = 0.f, sk = 0.f;
#pragma unroll
        for (int j = 0; j < 6; ++j) sq += v[j] * v[j];
#pragma unroll
        for (int j = 6; j < 10; ++j) sk += v[j] * v[j];
        const float rq = rsqrtf(wave_sum(sq) * (1.f / Q_LORA) + RMS_EPS), rk = rsqrtf(wave_sum(sk) * (1.f / KV_LORA) + RMS_EPS);
        bf16_t* cq = (bf16_t*)(ws + WS_CQ) + (size_t)m * Q_LORA;
#pragma unroll
        for (int j = 0; j < 6; ++j) cq[lane + 64 * j] = (bf16_t)f2bf(v[j] * rq * gq[lane + 64 * j]);
        float* orow = P.out + O_ROWS + (size_t)m * MLA_ROW; bf16_t* rb = (bf16_t*)(ws + WS_ROWSB) + (size_t)m * MLA_ROW;
#pragma unroll
        for (int j = 0; j < 4; ++j) { const float y = v[6 + j] * rk * gkv[lane + 64 * j]; __builtin_nontemporal_store(y, orow + lane + 64 * j); rb[lane + 64 * j] = (bf16_t)f2bf(y); }
        const int pidx = m < MP ? (m & (SEQ - 1)) : (SEQ + ((m - MP) & 3));
        const int i = lane & 31; const f32x2 cs = rope[pidx * 32 + i];
        const float other = __shfl_xor(v[10], 32);
        const float y = lane < 32 ? v[10] * cs.x - other * cs.y : v[10] * cs.x + other * cs.y;
        __builtin_nontemporal_store(y, orow + 256 + lane); rb[256 + lane] = (bf16_t)f2bf(y);
    }
}


#define LDS_BARRIER() do { asm volatile("s_waitcnt lgkmcnt(0)" ::: "memory"); __builtin_amdgcn_s_barrier(); asm volatile("" ::: "memory"); } while (0)
namespace attn {
typedef short v4i16_t __attribute__((ext_vector_type(4)));
constexpr int TILE_BYTES = 64 * 640;
__device__ __forceinline__ int koff(int row, int ch) { return 5120 * (row >> 3) + 512 * (ch >> 2) + 64 * (row & 7) + 16 * ((ch & 3) ^ ((row >> 2) & 3)); }

__device__ __forceinline__ float hmax32(float x) { const unsigned u = __builtin_bit_cast(unsigned, x); auto b = __builtin_amdgcn_permlane32_swap(u, u, false, false); return fmaxf(__builtin_bit_cast(float, b[0]), __builtin_bit_cast(float, b[1])); }
struct State { f32x4 o[16]; float m, l; };
struct Addr { int kb0, kb1, tb00, tb01, tb10, tb11; };
__device__ __forceinline__ Addr make_addr(int lane) {
    const int g = lane >> 4, rho = lane & 15, q4 = rho >> 2, p4 = lane & 3; Addr a;
    a.kb0 = 5120 * q4 + 64 * (rho & 3) + 16 * (g ^ (2 * (q4 & 1)));  a.kb1 = a.kb0 ^ 16;
    const int t0 = 5120 * g + 64 * q4 + 8 * (p4 & 1) + 32 * (g & 1) + 16 * (p4 >> 1);
    a.tb00 = t0; a.tb01 = t0 ^ 16; a.tb10 = t0 ^ 32; a.tb11 = t0 ^ 48;
    return a;
}
__device__ __forceinline__ void pv_load(bf16x8 (&vf)[8], const LAS unsigned char* buf, const Addr& A, int i) {
#pragma unroll
    for (int c = 0; c < 4; ++c) { const int cb = 4 * i + c;
        const LAS unsigned char* v0 = buf + ((cb & 1) ? A.tb10 : A.tb00) + 512 * (cb >> 1);
        const LAS unsigned char* v1 = buf + ((cb & 1) ? A.tb11 : A.tb01) + 512 * (cb >> 1) + 256;
#pragma unroll
        for (int ks = 0; ks < 2; ++ks) {
            const v4i16_t t0 = __builtin_amdgcn_ds_read_tr16_b64_v4i16((LAS v4i16_t*)(v0 + 20480 * ks));
            const v4i16_t t1 = __builtin_amdgcn_ds_read_tr16_b64_v4i16((LAS v4i16_t*)(v1 + 20480 * ks));
            vf[2 * c + ks] = __builtin_shufflevector(t0, t1, 0, 1, 2, 3, 4, 5, 6, 7); } }
}
__device__ __forceinline__ void pv_mma(State& st, const bf16x8 (&vf)[8], const bf16x8 (&pf)[2], int i) {
#pragma unroll
    for (int c = 0; c < 4; ++c)
#pragma unroll
        for (int ks = 0; ks < 2; ++ks) st.o[4 * i + c] = __builtin_amdgcn_mfma_f32_16x16x32_bf16(vf[2 * c + ks], pf[ks], st.o[4 * i + c], 0, 0, 0);
}
__device__ __forceinline__ void tile_scores(const LAS unsigned char* buf, const Addr& A, const bf16x8 (&qf)[10], State& st, int limit, bool need_mask, int lane, bf16x8 (&pf)[2], bf16x8 (&vf0)[8]) {
    const int g = lane >> 4;
    f32x4 sacc[4];
    __builtin_amdgcn_s_setprio(1);
    bf16x8 kf[2][5];
#pragma unroll
    for (int b = 0; b < 4; ++b) sacc[b] = (f32x4){0.f, 0.f, 0.f, 0.f};
#pragma unroll
    for (int j = 0; j < 5; ++j) kf[0][j] = *(const LAS bf16x8*)(buf + A.kb0 + 512 * j);
#pragma unroll
    for (int i = 0; i < 8; ++i) {
        if (i + 1 < 8) { const int b1 = (i + 1) >> 1; const LAS unsigned char* kp = buf + ((b1 & 1) ? A.kb1 : A.kb0) + 20480 * (b1 >> 1) + 256 * (b1 & 1) + 2560 * ((i + 1) & 1);
#pragma unroll
            for (int j = 0; j < 5; ++j) kf[(i + 1) & 1][j] = *(const LAS bf16x8*)(kp + 512 * j); }
        __builtin_amdgcn_sched_barrier(0);
#pragma unroll
        for (int j = 0; j < 5; ++j) sacc[i >> 1] = __builtin_amdgcn_mfma_f32_16x16x32_bf16(kf[i & 1][j], qf[5 * (i & 1) + j], sacc[i >> 1], 0, 0, 0);
        __builtin_amdgcn_sched_barrier(0);
    }
    __builtin_amdgcn_s_setprio(0);
    if (need_mask) {
#pragma unroll
        for (int b = 0; b < 4; ++b)
#pragma unroll
            for (int r = 0; r < 4; ++r) { const int key = 32 * (b >> 1) + 8 * g + 4 * (b & 1) + r; sacc[b][r] = key > limit ? -1e30f : sacc[b][r]; }
    }
    float mx = fmaxf(fmaxf(fmaxf(sacc[0][0], sacc[0][1]), fmaxf(sacc[0][2], sacc[0][3])), fmaxf(fmaxf(sacc[1][0], sacc[1][1]), fmaxf(sacc[1][2], sacc[1][3])));
    mx = fmaxf(mx, fmaxf(fmaxf(fmaxf(sacc[2][0], sacc[2][1]), fmaxf(sacc[2][2], sacc[2][3])), fmaxf(fmaxf(sacc[3][0], sacc[3][1]), fmaxf(sacc[3][2], sacc[3][3]))));
    mx = fmaxf(mx, __shfl_xor(mx, 16)); mx = hmax32(mx);
    __builtin_amdgcn_sched_barrier(0);
    pv_load(vf0, buf, A, 0);
    __builtin_amdgcn_sched_barrier(0);
    if (!__all(mx - st.m <= 6.0f)) {
        const float mnew = fmaxf(st.m, mx), alpha = __builtin_amdgcn_exp2f(st.m - mnew); st.m = mnew;
        st.l *= alpha;
#pragma unroll
        for (int cb = 0; cb < 16; ++cb) st.o[cb] = st.o[cb] * alpha;
    }
    float ps = 0.f;
#pragma unroll
    for (int b = 0; b < 4; ++b)
#pragma unroll
        for (int r = 0; r < 4; ++r) { const float p = __builtin_amdgcn_exp2f(sacc[b][r] - st.m); sacc[b][r] = p; ps += p; }
    st.l += ps;
#pragma unroll
    for (int ks = 0; ks < 2; ++ks) { u32x4 w; w.x = cvt_pk_bf16(sacc[2 * ks][0], sacc[2 * ks][1]); w.y = cvt_pk_bf16(sacc[2 * ks][2], sacc[2 * ks][3]);
        w.z = cvt_pk_bf16(sacc[2 * ks + 1][0], sacc[2 * ks + 1][1]); w.w = cvt_pk_bf16(sacc[2 * ks + 1][2], sacc[2 * ks + 1][3]); pf[ks] = __builtin_bit_cast(bf16x8, w); }
}
__device__ __forceinline__ void tile_pv(const LAS unsigned char* buf, const Addr& A, State& st, const bf16x8 (&pf)[2], bf16x8 (&vf0)[8]) {
    bf16x8 vf1[8];
    __builtin_amdgcn_s_setprio(1);
    pv_load(vf1, buf, A, 1); __builtin_amdgcn_sched_barrier(0); pv_mma(st, vf0, pf, 0); __builtin_amdgcn_sched_barrier(0);
    pv_load(vf0, buf, A, 2); __builtin_amdgcn_sched_barrier(0); pv_mma(st, vf1, pf, 1); __builtin_amdgcn_sched_barrier(0);
    pv_load(vf1, buf, A, 3); __builtin_amdgcn_sched_barrier(0); pv_mma(st, vf0, pf, 2); __builtin_amdgcn_sched_barrier(0);
    pv_mma(st, vf1, pf, 3);
    __builtin_amdgcn_s_setprio(0);
}
__device__ __forceinline__ void load_q(bf16x8 (&qf)[10], const bf16_t* Q, int row, int h, int g) {
    const bf16_t* qr = Q + (size_t)row * NQ;
#pragma unroll
    for (int s = 0; s < 8; ++s) qf[s] = __builtin_nontemporal_load((const bf16x8*)(qr + h * 256 + 32 * s + 8 * g));
#pragma unroll
    for (int s = 0; s < 2; ++s) qf[8 + s] = __builtin_nontemporal_load((const bf16x8*)(qr + 2048 + h * 64 + 32 * s + 8 * g));
}
__device__ __forceinline__ void state_init(State& st) {
#pragma unroll
    for (int cb = 0; cb < 16; ++cb) st.o[cb] = (f32x4){0.f, 0.f, 0.f, 0.f};
    st.m = -1e30f; st.l = 0.f;
}
__device__ __forceinline__ int stage_lds_off(int tid) { const int row = tid >> 3; return 5120 * (row >> 3) + 64 * (row & 7) + 512 * ((tid & 7) >> 2) + 16 * ((tid & 3) ^ ((row >> 2) & 3)); }
__device__ __forceinline__ void prompt_unit(Frame& F, int b, int qb) {
    unsigned char* ws = F.p->ws; OPAQUE_WS(ws); int tid = F.tid; asm volatile("" : "+v"(tid));
    const int lane = tid & 63, h = F.wave, g = lane >> 4, qi = lane & 15;
    const int p0 = 16 * qb, nt = (p0 + 15) / 64 + 1;
    const unsigned char* rows = (const unsigned char*)((const bf16_t*)(ws + WS_ROWSB) + (size_t)b * SEQ * MLA_ROW) + (tid >> 3) * 640 + (tid & 7) * 16;
    const int soff = stage_lds_off(tid);
    bf16x8 qf[10]; load_q(qf, (const bf16_t*)(ws + WS_Q), b * SEQ + p0 + qi, h, g);
    State st; state_init(st); const Addr AD = make_addr(lane);
    u32x4 pre[3];
#pragma unroll
    for (int j = 0; j < 5; ++j) *(LAS u32x4*)(F.lds + soff + 1024 * j) = *(const u32x4*)(rows + 128 * j);
    LDS_BARRIER();
    for (int kt = 0; kt < nt; ++kt) {
        const LAS unsigned char* buf = F.lds + (kt & 1) * TILE_BYTES; LAS unsigned char* nbuf = F.lds + ((kt + 1) & 1) * TILE_BYTES + soff;
        const bool more = kt + 1 < nt; const unsigned char* src = rows + (size_t)(more ? kt + 1 : kt) * (64 * 640);
        bf16x8 pf[2], vf0[8];
#pragma unroll
        for (int j = 0; j < 3; ++j) pre[j] = *(const u32x4*)(src + 128 * j);
        __builtin_amdgcn_sched_barrier(0);
        tile_scores(buf, AD, qf, st, p0 + qi - 64 * kt, 64 * kt + 63 > p0, lane, pf, vf0);
        if (more) {
#pragma unroll
            for (int j = 0; j < 3; ++j) *(LAS u32x4*)(nbuf + 1024 * j) = pre[j];
        }
#pragma unroll
        for (int j = 0; j < 2; ++j) pre[j] = *(const u32x4*)(src + 128 * (3 + j));
        __builtin_amdgcn_sched_barrier(0);
        tile_pv(buf, AD, st, pf, vf0);
        if (more) {
#pragma unroll
            for (int j = 0; j < 2; ++j) *(LAS u32x4*)(nbuf + 1024 * (3 + j)) = pre[j];
        }
        LDS_BARRIER();
    }
    float l = st.l; l += __shfl_xor(l, 16); l += __shfl_xor(l, 32);
    const float inv = 1.f / l;
    bf16_t* orow = (bf16_t*)(ws + WS_OL) + (size_t)(b * SEQ + p0 + qi) * 2048 + h * 256 + 4 * g;
#pragma unroll
    for (int cb = 0; cb < 16; ++cb) { u32x2 w; w.x = cvt_pk_bf16(st.o[cb][0] * inv, st.o[cb][1] * inv); w.y = cvt_pk_bf16(st.o[cb][2] * inv, st.o[cb][3] * inv); *(u32x2*)(orow + 16 * cb) = w; }
}
__device__ __forceinline__ void cache_load10(f32x4 (&pre)[10], const float* src) {
#pragma unroll
    for (int k = 0; k < 10; ++k) pre[k] = __builtin_nontemporal_load((const f32x4*)(src + 32 * k));
}
__device__ __forceinline__ void cache_store10(const f32x4 (&pre)[10], LAS unsigned char* dst) {
#pragma unroll
    for (int k = 0; k < 10; ++k) { u32x2 w; w.x = cvt_pk_bf16(pre[k][0], pre[k][1]); w.y = cvt_pk_bf16(pre[k][2], pre[k][3]); *(LAS u32x2*)(dst + 512 * k) = w; }
}
template <int J0, int J1>
__device__ __forceinline__ void load_cache_part(f32x4 (&pre)[10], const float* src) {
#pragma unroll
    for (int j = J0; j < J1; ++j) { pre[2 * (j - J0)] = *(const f32x4*)(src + 64 * j); pre[2 * (j - J0) + 1] = *(const f32x4*)(src + 64 * j + 4); }
}
template <int J0, int J1>
__device__ __forceinline__ void store_cache_part(const f32x4 (&pre)[10], LAS unsigned char* dst) {
#pragma unroll
    for (int j = J0; j < J1; ++j) { const int k = 2 * (j - J0); u32x4 w; w.x = cvt_pk_bf16(pre[k][0], pre[k][1]); w.y = cvt_pk_bf16(pre[k][2], pre[k][3]);
        w.z = cvt_pk_bf16(pre[k + 1][0], pre[k + 1][1]); w.w = cvt_pk_bf16(pre[k + 1][2], pre[k + 1][3]); *(LAS u32x4*)(dst + 1024 * j) = w; }
}
__device__ __forceinline__ const float* cache_tile_src(const float* cache, int pgv, int kt) {
    const int page = __builtin_amdgcn_readlane(pgv, kt >> 1);
    return cache + ((size_t)page * PAGE + (kt & 1) * 64) * MLA_ROW;
}
__device__ __forceinline__ void samp_tile(const LAS unsigned char* buf, const Addr& A, const bf16x8 (&qf)[10], State& st, int kb, int limit, bool need_mask, int lane) {
    const int g = lane >> 4;
    f32x4 sacc = {0.f, 0.f, 0.f, 0.f};
    const LAS unsigned char* kp = buf + ((kb & 1) ? A.kb1 : A.kb0) + 20480 * (kb >> 1) + 256 * (kb & 1);
#pragma unroll
    for (int s = 0; s < 10; ++s) { const bf16x8 kf = *(const LAS bf16x8*)(kp + 512 * s); sacc = __builtin_amdgcn_mfma_f32_16x16x32_bf16(kf, qf[s], sacc, 0, 0, 0); }
    if (need_mask) {
#pragma unroll
        for (int r = 0; r < 4; ++r) { const int key = 32 * (kb >> 1) + 8 * g + 4 * (kb & 1) + r; sacc[r] = key > limit ? -1e30f : sacc[r]; }
    }
    float mx = fmaxf(fmaxf(sacc[0], sacc[1]), fmaxf(sacc[2], sacc[3]));
    mx = fmaxf(mx, __shfl_xor(mx, 16)); mx = hmax32(mx);
    if (!__all(mx - st.m <= 6.0f)) {
        const float mnew = fmaxf(st.m, mx), alpha = __builtin_amdgcn_exp2f(st.m - mnew); st.m = mnew; st.l *= alpha;
#pragma unroll
        for (int cb = 0; cb < 16; ++cb) st.o[cb] = st.o[cb] * alpha;
    }
    float p[4];
#pragma unroll
    for (int r = 0; r < 4; ++r) p[r] = __builtin_amdgcn_exp2f(sacc[r] - st.m);
    st.l += (p[0] + p[1]) + (p[2] + p[3]);
    const unsigned w0 = cvt_pk_bf16(p[0], p[1]), w1 = cvt_pk_bf16(p[2], p[3]);
    const u32x4 pw = (kb & 1) ? (u32x4){0u, 0u, w0, w1} : (u32x4){w0, w1, 0u, 0u};
    const bf16x8 pf = __builtin_bit_cast(bf16x8, pw);
#pragma unroll
    for (int cb = 0; cb < 16; ++cb) {
        const LAS unsigned char* vp = buf + ((cb & 1) ? ((kb & 1) ? A.tb11 : A.tb10) : ((kb & 1) ? A.tb01 : A.tb00)) + 512 * (cb >> 1) + 256 * (kb & 1) + 20480 * (kb >> 1);
        const v4i16_t t0 = __builtin_amdgcn_ds_read_tr16_b64_v4i16((LAS v4i16_t*)vp);
        const bf16x8 vf = __builtin_shufflevector(t0, t0, 0, 1, 2, 3, 4, 5, 6, 7);
        st.o[cb] = __builtin_amdgcn_mfma_f32_16x16x32_bf16(vf, pf, st.o[cb], 0, 0, 0);
    }
}
__device__ __forceinline__ void sample_unit(Frame& F, int sb, int split) {
    unsigned char* ws = F.p->ws; OPAQUE_WS(ws); int tid = F.tid; asm volatile("" : "+v"(tid));
    const int lane = tid & 63, w = F.wave, g = lane >> 4, qi = lane & 15;
    const float* cache = F.p->in[2]; const int* pt = F.p->page_table;
    const int hg = w & 1, kb = w >> 1, head = 4 * hg + (qi >> 2), tq = qi & 3;
    bf16x8 qf[10]; load_q(qf, (const bf16_t*)(ws + WS_Q), MP + sb * DECS + tq, head, g);
    State st; state_init(st); const Addr AD = make_addr(lane);
    f32x4 pre[10];
    const int soff = stage_lds_off(tid);
    const int crow = tid >> 3, cq = tid & 7, goff = crow * MLA_ROW + 4 * cq, coff = 5120 * (crow >> 3) + 64 * (crow & 7) + 16 * ((cq >> 1) ^ ((crow >> 2) & 3)) + 8 * (cq & 1);
    const int pgv = pt[sb * NPAGES + 16 * split + (lane & 15)];
    { const float* src = cache_tile_src(cache, pgv, 0) + goff;
      cache_load10(pre, src); cache_store10(pre, F.lds + coff);
      cache_load10(pre, cache_tile_src(cache, pgv, 1) + goff); }
    __builtin_amdgcn_sched_barrier(0);
    LDS_BARRIER();
    constexpr int NT = 32;
    for (int kt = 0; kt < NT; ++kt) {
        const LAS unsigned char* buf = F.lds + (kt & 1) * TILE_BYTES; LAS unsigned char* nbuf = F.lds + ((kt + 1) & 1) * TILE_BYTES + coff;
        samp_tile(buf, AD, qf, st, kb, 63, false, lane);
        __builtin_amdgcn_sched_barrier(0);
        if (kt + 1 < NT) cache_store10(pre, nbuf);
        if (kt + 2 < NT) cache_load10(pre, cache_tile_src(cache, pgv, kt + 2) + goff);
        __builtin_amdgcn_sched_barrier(0);
        LDS_BARRIER();
    }
    if (split == 7) {
        const bf16_t* rows = (const bf16_t*)(ws + WS_ROWSB) + (size_t)(MP + sb * DECS) * MLA_ROW;
        unsigned zr = 0u; asm volatile("" : "+v"(zr));
#pragma unroll
        for (int j = 0; j < 5; ++j) { const int row = tid >> 3; u32x4 wv = {zr, zr, zr, zr}; if (row < 4) wv = *(const u32x4*)(rows + (size_t)row * MLA_ROW + ((tid & 7) + 8 * j) * 8); *(LAS u32x4*)(F.lds + soff + 1024 * j) = wv; }
        __syncthreads();
        if (kb == 0) samp_tile(F.lds, AD, qf, st, 0, tq, true, lane);
        __syncthreads();
    }
    float l = st.l; l += __shfl_xor(l, 16); l += __shfl_xor(l, 32);
    LAS float* OB = (LAS float*)F.lds; LAS float* MLB = (LAS float*)(F.lds + 131072);
#pragma unroll
    for (int cb = 0; cb < 16; ++cb) *(LAS f32x4*)(OB + (w * 16 + qi) * 256 + 16 * cb + 4 * g) = st.o[cb];
    if (g == 0) { MLB[(w * 16 + qi) * 2] = st.m; MLB[(w * 16 + qi) * 2 + 1] = l; }
    __syncthreads();
    {   const int hg2 = tid >> 8, q = (tid >> 4) & 15, c0 = (tid & 15) * 16;
        float ms[4], ls[4], mt = -1e30f;
#pragma unroll
        for (int k = 0; k < 4; ++k) { const int ww = 2 * k + hg2; ms[k] = MLB[(ww * 16 + q) * 2]; ls[k] = MLB[(ww * 16 + q) * 2 + 1]; mt = fmaxf(mt, ms[k]); }
        float L = 0.f; f32x4 acc[4];
#pragma unroll
        for (int j = 0; j < 4; ++j) acc[j] = (f32x4){0.f, 0.f, 0.f, 0.f};
#pragma unroll
        for (int k = 0; k < 4; ++k) { const int ww = 2 * k + hg2; const float wt = __builtin_amdgcn_exp2f(ms[k] - mt); L += wt * ls[k];
#pragma unroll
            for (int j = 0; j < 4; ++j) { const f32x4 v = *(const LAS f32x4*)(OB + (ww * 16 + q) * 256 + c0 + 4 * j); acc[j] = acc[j] + v * wt; } }
        const int hd = 4 * hg2 + (q >> 2), t = q & 3;
        float* po = (float*)(ws + WS_PART) + ((((size_t)sb * 8 + split) * 8 + hd) * 4 + t) * 256 + c0;
#pragma unroll
        for (int j = 0; j < 4; ++j) *(f32x4*)(po + 4 * j) = acc[j];
        if (c0 == 0) { float* ml = (float*)(ws + WS_ML) + ((((size_t)sb * 8 + split) * 8 + hd) * 4 + t) * 2; ml[0] = mt; ml[1] = L; }
    }
    __syncthreads();
}
__device__ __forceinline__ void sample_combine(Frame& F, int sb) {
    unsigned char* ws = F.p->ws; const int tid = F.tid;
    {
        const int row = tid >> 4, c0 = (tid & 15) * 16, hh = row >> 2, t = row & 3;
        float ms[8], ls[8], mt = -1e30f;
#pragma unroll
        for (int s = 0; s < 8; ++s) { const float* ml = (const float*)(ws + WS_ML) + ((((size_t)sb * 8 + s) * 8 + hh) * 4 + t) * 2;
            ms[s] = ml[0]; ls[s] = ml[1]; mt = fmaxf(mt, ms[s]); }
        float L = 0.f; f32x4 acc[4];
#pragma unroll
        for (int j = 0; j < 4; ++j) acc[j] = (f32x4){0.f, 0.f, 0.f, 0.f};
#pragma unroll
        for (int s = 0; s < 8; ++s) { const float w = __builtin_amdgcn_exp2f(ms[s] - mt); L += w * ls[s];
            const float* po = (const float*)(ws + WS_PART) + ((((size_t)sb * 8 + s) * 8 + hh) * 4 + t) * 256 + c0;
#pragma unroll
            for (int j = 0; j < 4; ++j) { const f32x4 v = *(const f32x4*)(po + 4 * j); acc[j] = acc[j] + v * w; } }
        const float inv = 1.f / L;
        bf16_t* orow = (bf16_t*)(ws + WS_OL) + (size_t)(MP + sb * DECS + t) * 2048 + hh * 256 + c0;
#pragma unroll
        for (int j = 0; j < 2; ++j) { u32x4 w; w.x = cvt_pk_bf16(acc[2 * j][0] * inv, acc[2 * j][1] * inv); w.y = cvt_pk_bf16(acc[2 * j][2] * inv, acc[2 * j][3] * inv);
            w.z = cvt_pk_bf16(acc[2 * j + 1][0] * inv, acc[2 * j + 1][1] * inv); w.w = cvt_pk_bf16(acc[2 * j + 1][2] * inv, acc[2 * j + 1][3] * inv); *(u32x4*)(orow + 8 * j) = w; }
    }
}
__device__ __forceinline__ void phase(Frame& F) {
    const int slot = (F.c >> 3) % 3; int done = 0;
    if (slot == 0) { for (int S = F.c; S < DECB * 8; S += F.G) sample_unit(F, S >> 3, S & 7); done = 1; }
    int np = 0;
    for (int L = F.c; L < 512; L += F.G) {
        const int b = L % 8, j = L / 8;
        prompt_unit(F, b, j); prompt_unit(F, b, 127 - j); ++np;
        if (!done && slot == 1 && np == 1) { for (int S = F.c; S < DECB * 8; S += F.G) sample_unit(F, S >> 3, S & 7); done = 1; }
    }
    if (!done) for (int S = F.c; S < DECB * 8; S += F.G) sample_unit(F, S >> 3, S & 7);
}
}


__device__ __forceinline__ void unpack8(const u32x4 v, float (&o)[8]) {
#pragma unroll
    for (int c = 0; c < 4; ++c) { o[2 * c] = __builtin_bit_cast(float, v[c] << 16); o[2 * c + 1] = __builtin_bit_cast(float, v[c] & 0xffff0000u); }
}
template <int R>
__device__ __forceinline__ void rowpass_rows(const Params& P, const int (&mrow)[R], bool first, bool last, const float* wa, const float* wb, int nslab, int lane) {
    unsigned char* ws = P.ws;
    float v[R][2][8], hv[R][2][8];
#pragma unroll
    for (int r = 0; r < R; ++r) { const int m = mrow[r];
        if (m < MP) { const u32x4* mr = (const u32x4*)((const bf16_t*)(ws + WS_MIX) + (size_t)m * DM) + lane; unpack8(__builtin_nontemporal_load(mr), v[r][0]); unpack8(__builtin_nontemporal_load(mr + 64), v[r][1]); }
        else {
#pragma unroll
            for (int j = 0; j < 2; ++j)
#pragma unroll
                for (int i = 0; i < 8; ++i) v[r][j][i] = 0.f;
            for (int z = 0; z < nslab; ++z) { const f32x4* mr = (const f32x4*)((const float*)(ws + WS_SLAB) + ((size_t)z * 128 + (m - MP)) * DM) + 2 * lane;
#pragma unroll
                for (int j = 0; j < 2; ++j) { const f32x4 a = mr[128 * j], b = mr[128 * j + 1]; v[r][j][0] += a.x; v[r][j][1] += a.y; v[r][j][2] += a.z; v[r][j][3] += a.w; v[r][j][4] += b.x; v[r][j][5] += b.y; v[r][j][6] += b.z; v[r][j][7] += b.w; } } }
        if (first) { const f32x4* hr = (const f32x4*)(m < MP ? P.in[0] + (size_t)m * DM : P.in[1] + (size_t)(m - MP) * DM) + 2 * lane;
#pragma unroll
            for (int j = 0; j < 2; ++j) { const f32x4 a = __builtin_nontemporal_load(hr + 128 * j), b = __builtin_nontemporal_load(hr + 128 * j + 1); hv[r][j][0] = a.x; hv[r][j][1] = a.y; hv[r][j][2] = a.z; hv[r][j][3] = a.w; hv[r][j][4] = b.x; hv[r][j][5] = b.y; hv[r][j][6] = b.z; hv[r][j][7] = b.w; }
        } else { const u32x4* hr = (const u32x4*)((const bf16_t*)(ws + WS_HB) + (size_t)m * DM) + lane; unpack8(__builtin_nontemporal_load(hr), hv[r][0]); unpack8(__builtin_nontemporal_load(hr + 64), hv[r][1]); } }
    float s[R];
#pragma unroll
    for (int r = 0; r < R; ++r) { s[r] = 0.f;
#pragma unroll
        for (int j = 0; j < 2; ++j)
#pragma unroll
            for (int i = 0; i < 8; ++i) s[r] += v[r][j][i] * v[r][j][i]; }
#pragma unroll
    for (int o = 1; o < 64; o <<= 1)
#pragma unroll
        for (int r = 0; r < R; ++r) s[r] += __shfl_xor(s[r], o);
    float s2[R];
#pragma unroll
    for (int r = 0; r < R; ++r) { const float rs = rsqrtf(s[r] * (1.f / DM) + RMS_EPS); s2[r] = 0.f;
#pragma unroll
        for (int j = 0; j < 2; ++j) { const f32x4 g0 = ((const f32x4*)wa)[2 * lane + 128 * j], g1 = ((const f32x4*)wa)[2 * lane + 128 * j + 1];
            const float g[8] = {g0.x, g0.y, g0.z, g0.w, g1.x, g1.y, g1.z, g1.w};
#pragma unroll
            for (int i = 0; i < 8; ++i) { v[r][j][i] = hv[r][j][i] + v[r][j][i] * rs * g[i]; s2[r] += v[r][j][i] * v[r][j][i]; } }
        const int m = mrow[r];
        if (last) { f32x4* yr = (f32x4*)(P.out + O_Y + (size_t)m * DM) + 2 * lane;
#pragma unroll
            for (int j = 0; j < 2; ++j) { __builtin_nontemporal_store((f32x4){v[r][j][0], v[r][j][1], v[r][j][2], v[r][j][3]}, yr + 128 * j); __builtin_nontemporal_store((f32x4){v[r][j][4], v[r][j][5], v[r][j][6], v[r][j][7]}, yr + 128 * j + 1); }
        } else { u32x4* hb = (u32x4*)((bf16_t*)(ws + WS_HB) + (size_t)m * DM) + lane;
#pragma unroll
            for (int j = 0; j < 2; ++j) hb[64 * j] = (u32x4){cvt_pk_bf16(v[r][j][0], v[r][j][1]), cvt_pk_bf16(v[r][j][2], v[r][j][3]), cvt_pk_bf16(v[r][j][4], v[r][j][5]), cvt_pk_bf16(v[r][j][6], v[r][j][7])}; } }
    if (wb) {
#pragma unroll
        for (int o = 1; o < 64; o <<= 1)
#pragma unroll
            for (int r = 0; r < R; ++r) s2[r] += __shfl_xor(s2[r], o);
#pragma unroll
        for (int r = 0; r < R; ++r) { const float r2 = rsqrtf(s2[r] * (1.f / DM) + RMS_EPS);
            u32x4* ur = (u32x4*)((bf16_t*)(ws + WS_U) + (size_t)mrow[r] * DM) + lane;
#pragma unroll
            for (int j = 0; j < 2; ++j) { const f32x4 g0 = ((const f32x4*)wb)[2 * lane + 128 * j], g1 = ((const f32x4*)wb)[2 * lane + 128 * j + 1];
                ur[64 * j] = (u32x4){cvt_pk_bf16(v[r][j][0] * r2 * g0.x, v[r][j][1] * r2 * g0.y), cvt_pk_bf16(v[r][j][2] * r2 * g0.z, v[r][j][3] * r2 * g0.w), cvt_pk_bf16(v[r][j][4] * r2 * g1.x, v[r][j][5] * r2 * g1.y), cvt_pk_bf16(v[r][j][6] * r2 * g1.z, v[r][j][7] * r2 * g1.w)}; } } }
}
__device__ __forceinline__ void rowpass(Frame& F, bool first, bool last, const float* wa, const float* wb, int nslab) {
    const Params& P = *F.p; int lane = F.lane; asm volatile("" : "+v"(lane));
    const int gw = F.c * NWAVES + F.wave, NGW = F.G * NWAVES;
    for (int p = gw; p < MP / 4; p += NGW) { const int mr[4] = {4 * p, 4 * p + 1, 4 * p + 2, 4 * p + 3}; rowpass_rows<4>(P, mr, first, last, wa, wb, nslab, lane); }
    for (int m = MP + gw; m < MV; m += NGW) { const int mr[1] = {m}; rowpass_rows<1>(P, mr, first, last, wa, wb, nslab, lane); }
}


namespace dn {
constexpr int SP = 132;
constexpr int L_S = 0;
constexpr int L_KB = 3 * 64 * SP * 4;
constexpr int L_QB = L_KB + 64 * 272;
constexpr int L_G = L_QB + 64 * 272;
constexpr int LP = 68;
constexpr int L_LB = L_G + 512;
constexpr int L_ST = L_KB;
static_assert(L_LB + 32 * 80 <= 131072 + 8192 && 256 * 80 <= 2 * 64 * 272, "dn LDS map");
__device__ __forceinline__ float silu(float x) { return x * __builtin_amdgcn_rcpf(1.f + __expf(-x)); }
__device__ __forceinline__ void gated_norm_row(unsigned char* ws, const float* gout, size_t row, int h, int lane) {
    const unsigned ov = *(const unsigned*)((const bf16_t*)(ws + WS_DO) + row * 1024 + h * 128 + 2 * lane);
    const unsigned zv = *(const unsigned*)((const bf16_t*)(ws + WS_PROJ) + row * DN_NP + 3072 + h * 128 + 2 * lane);
    const float o0 = __builtin_bit_cast(float, ov << 16), o1 = __builtin_bit_cast(float, ov & 0xffff0000u);
    const float z0 = __builtin_bit_cast(float, zv << 16), z1 = __builtin_bit_cast(float, zv & 0xffff0000u);
    const float rs = rsqrtf(wave_sum(o0 * o0 + o1 * o1) * (1.f / 128.f) + RMS_EPS);
    const f32x2 g = *(const f32x2*)(gout + 2 * lane);
    *(unsigned*)((bf16_t*)(ws + WS_DOG) + row * 1024 + h * 128 + 2 * lane) = cvt_pk_bf16(o0 * rs * g.x * silu(z0), o1 * rs * g.y * silu(z1));
}

struct ConvPre { u32x4 x[11]; bf16_t gb, ga; };
template <int I0, int I1, bool GATES>
__device__ __forceinline__ void conv_load_part(ConvPre& R, const bf16_t* proj, int b, int n, int tid, int h) {
    const int cgp = tid % 48, tg = tid / 48, part = cgp >> 4, d0 = (cgp & 15) * 8, col = part * 1024 + h * 128 + d0;
#pragma unroll
    for (int i = I0; i < I1; ++i) { int tok = n * CHUNK + 8 * tg - 3 + i; u32x4 v = {0u, 0u, 0u, 0u};
        int cl = col; if (tid >= 384) { tok = n * CHUNK; cl = h * 128; }
        if (tok >= 0) v = __builtin_nontemporal_load((const u32x4*)(proj + ((size_t)b * SEQ + tok) * DN_NP + cl));
        R.x[i] = v; }
    if (GATES) { const bf16_t* pr = proj + ((size_t)b * SEQ + n * CHUNK + (tid & 63)) * DN_NP + 4096 + h; R.gb = pr[0]; R.ga = pr[8]; }
}
__device__ __forceinline__ void conv_load(ConvPre& R, const bf16_t* proj, int b, int n, int tid, int h) { conv_load_part<0, 11, true>(R, proj, b, n, tid, h); }
__device__ __forceinline__ void chunk_phase(Frame& F) {
    const Params& P = *F.p; unsigned char* ws = P.ws; OPAQUE_WS(ws); int tid = F.tid; asm volatile("" : "+v"(tid));
    const int lane = tid & 63, wave = __builtin_amdgcn_readfirstlane(tid >> 6);
    LAS float* S = (LAS float*)(F.lds + L_S); LAS float* GB = (LAS float*)(F.lds + L_G);
    const bf16_t* proj = (const bf16_t*)(ws + WS_PROJ);
    const int h = F.c & 7; const int nun = (256 - (F.c >> 3) + (F.G >> 3) - 1) / (F.G >> 3);
    if ((F.G & 7) != 0 || nun <= 0) return;
    constexpr int L_CW = 131072 + 8192 + 256;
    LAS float* CW = (LAS float*)(F.lds + L_CW);
    for (int i = tid; i < 4 * 384; i += NTHREADS) { const int j = i / 384, cc = i % 384; CW[i] = P.in[15][j * DN_QKV + (cc >> 7) * 1024 + h * 128 + (cc & 127)]; }
    __syncthreads();
    ConvPre pre;
    { const int idx = F.c >> 3; conv_load(pre, proj, idx >> 5, idx & 31, tid, h); }
    const int tid0 = tid;
    for (int k = 0; k < nun; ++k) {
        int tid = tid0; asm volatile("" : "+v"(tid));
        const int lane = tid & 63;
        const int cgp = tid % 48, tg = tid / 48, part = cgp >> 4, d0c = (cgp & 15) * 8, col = part * 1024 + h * 128 + d0c;
        const int idx = (F.c >> 3) + k * (F.G >> 3), b = idx >> 5, n = idx & 31;
        const int t0 = n * CHUNK; const size_t row0 = (size_t)b * SEQ + t0; const int unit = (b * 8 + h) * 32 + n;
        if (tid < 384) {
#pragma unroll
            for (int c4 = 0; c4 < 2; ++c4) {
                float x[4][11], w[4][4];
#pragma unroll
                for (int i = 0; i < 11; ++i) { const unsigned p0 = pre.x[i][2 * c4], p1 = pre.x[i][2 * c4 + 1];
                    x[0][i] = __builtin_bit_cast(float, p0 << 16); x[1][i] = __builtin_bit_cast(float, p0 & 0xffff0000u); x[2][i] = __builtin_bit_cast(float, p1 << 16); x[3][i] = __builtin_bit_cast(float, p1 & 0xffff0000u); }
#pragma unroll
                for (int j = 0; j < 4; ++j) { const f32x4 wv = *(const LAS f32x4*)(CW + j * 384 + part * 128 + d0c + 4 * c4); w[0][j] = wv.x; w[1][j] = wv.y; w[2][j] = wv.z; w[3][j] = wv.w; }
#pragma unroll
                for (int tt = 0; tt < 8; ++tt) { float a[4] = {0.f, 0.f, 0.f, 0.f};
#pragma unroll
                    for (int j = 0; j < 4; ++j)
#pragma unroll
                        for (int c = 0; c < 4; ++c) a[c] += w[c][j] * x[c][tt + j];
                    *(LAS f32x4*)(S + (part * 64 + 8 * tg + tt) * SP + d0c + 4 * c4) = (f32x4){silu(a[0]), silu(a[1]), silu(a[2]), silu(a[3])}; }
                if (n == 31 && tg == 7) {
#pragma unroll
                    for (int r = 0; r < 3; ++r) *(f32x4*)(P.out + O_CP + ((size_t)b * 3 + r) * DN_QKV + col + 4 * c4) = (f32x4){x[0][8 + r], x[1][8 + r], x[2][8 + r], x[3][8 + r]}; }
            }
        }
        if (wave == 7) {
            const float braw = bf2f(pre.gb), araw = bf2f(pre.ga);
            const float beta = 1.f / (1.f + __expf(-braw));
            const float xs = araw + P.in[17][h]; const float sp = xs > 20.f ? xs : log1pf(__expf(xs));
            float g = -__expf(P.in[16][h]) * sp;
#pragma unroll
            for (int o = 1; o < 64; o <<= 1) { const float t = __shfl_up(g, o); if (lane >= o) g += t; }
            GB[lane] = beta; GB[64 + lane] = g;
        }
        LDS_BARRIER();
        const int nidx = k + 1 < nun ? idx + (F.G >> 3) : idx;
        conv_load_part<0, 4, false>(pre, proj, nidx >> 5, nidx & 31, tid, h);
        {   const int r = tid >> 2, qd = tid & 3; LAS float* rp = S + r * SP + 4 * qd;
            f32x4 a[8]; float ss = 0.f;
#pragma unroll
            for (int j = 0; j < 8; ++j) { a[j] = *(const LAS f32x4*)(rp + 16 * j); ss += (a[j].x * a[j].x + a[j].y * a[j].y) + (a[j].z * a[j].z + a[j].w * a[j].w); }
            ss += __shfl_xor(ss, 1); ss += __shfl_xor(ss, 2);
            float sc = rsqrtf(ss + L2_EPS); if (r < 64) sc *= 0.08838834764831845f;
#pragma unroll
            for (int j = 0; j < 8; ++j) *(LAS f32x4*)(rp + 16 * j) = a[j] * sc;
        }
        LDS_BARRIER();
        conv_load_part<4, 8, false>(pre, proj, nidx >> 5, nidx & 31, tid, h);
        const float gl = GB[64 + 63];
        {   const int t = tid >> 3, d0 = (tid & 7) * 16; const float eg = __expf(GB[64 + t]);
            const LAS float* qp = S + t * SP + d0; const LAS float* kp = S + (64 + t) * SP + d0;
            float q[16], kk[16];
#pragma unroll
            for (int j = 0; j < 4; ++j) { const f32x4 a = *(const LAS f32x4*)(qp + 4 * j), c = *(const LAS f32x4*)(kp + 4 * j); q[4 * j] = a.x; q[4 * j + 1] = a.y; q[4 * j + 2] = a.z; q[4 * j + 3] = a.w; kk[4 * j] = c.x; kk[4 * j + 1] = c.y; kk[4 * j + 2] = c.z; kk[4 * j + 3] = c.w; }
            u32x4 w0, w1;
            w0 = (u32x4){cvt_pk_bf16(q[0], q[1]), cvt_pk_bf16(q[2], q[3]), cvt_pk_bf16(q[4], q[5]), cvt_pk_bf16(q[6], q[7])}; w1 = (u32x4){cvt_pk_bf16(q[8], q[9]), cvt_pk_bf16(q[10], q[11]), cvt_pk_bf16(q[12], q[13]), cvt_pk_bf16(q[14], q[15])};
            *(LAS u32x4*)(F.lds + L_QB + t * 272 + d0 * 2) = w0; *(LAS u32x4*)(F.lds + L_QB + t * 272 + d0 * 2 + 16) = w1;
            w0 = (u32x4){cvt_pk_bf16(kk[0], kk[1]), cvt_pk_bf16(kk[2], kk[3]), cvt_pk_bf16(kk[4], kk[5]), cvt_pk_bf16(kk[6], kk[7])}; w1 = (u32x4){cvt_pk_bf16(kk[8], kk[9]), cvt_pk_bf16(kk[10], kk[11]), cvt_pk_bf16(kk[12], kk[13]), cvt_pk_bf16(kk[14], kk[15])};
            *(LAS u32x4*)(F.lds + L_KB + t * 272 + d0 * 2) = w0; *(LAS u32x4*)(F.lds + L_KB + t * 272 + d0 * 2 + 16) = w1;
            w0 = (u32x4){cvt_pk_bf16(q[0] * eg, q[1] * eg), cvt_pk_bf16(q[2] * eg, q[3] * eg), cvt_pk_bf16(q[4] * eg, q[5] * eg), cvt_pk_bf16(q[6] * eg, q[7] * eg)};
            w1 = (u32x4){cvt_pk_bf16(q[8] * eg, q[9] * eg), cvt_pk_bf16(q[10] * eg, q[11] * eg), cvt_pk_bf16(q[12] * eg, q[13] * eg), cvt_pk_bf16(q[14] * eg, q[15] * eg)};
            bf16_t* qd = (bf16_t*)(ws + WS_QD) + (row0 + t) * 1024 + h * 128 + d0; *(u32x4*)qd = w0; *(u32x4*)(qd + 8) = w1;
        }
        {   const int d = tid >> 2, tq = (tid & 3) * 16; float kd[16];
#pragma unroll
            for (int j = 0; j < 16; ++j) kd[j] = S[(64 + tq + j) * SP + d] * __expf(gl - GB[64 + tq + j]);
            bf16_t* o = (bf16_t*)(ws + WS_KDT) + ((size_t)unit * 128 + d) * 64 + tq;
            *(u32x4*)o = (u32x4){cvt_pk_bf16(kd[0], kd[1]), cvt_pk_bf16(kd[2], kd[3]), cvt_pk_bf16(kd[4], kd[5]), cvt_pk_bf16(kd[6], kd[7])};
            *(u32x4*)(o + 8) = (u32x4){cvt_pk_bf16(kd[8], kd[9]), cvt_pk_bf16(kd[10], kd[11]), cvt_pk_bf16(kd[12], kd[13]), cvt_pk_bf16(kd[14], kd[15])};
        }
        if (tid == 0) ((float*)(ws + WS_GL))[unit] = __expf(gl);
        LDS_BARRIER();
        conv_load_part<8, 11, true>(pre, proj, nidx >> 5, nidx & 31, tid, h);
        {   const int mat = wave >> 2, bi = wave & 3, g = lane >> 4, jl = lane & 15;
            LAS float* Lt = S;
            const LAS unsigned char* ab = F.lds + (mat ? L_QB : L_KB) + (16 * bi + jl) * 272 + 16 * g;
            bf16x8 af[4];
#pragma unroll
            for (int ks = 0; ks < 4; ++ks) af[ks] = *(const LAS bf16x8*)(ab + 64 * ks);
            float gi[4], bt[4];
#pragma unroll
            for (int r = 0; r < 4; ++r) { gi[r] = GB[64 + 16 * bi + 4 * g + r]; bt[r] = GB[16 * bi + 4 * g + r]; }
            for (int bj = 0; bj < 4; ++bj) {
                f32x4 acc = {0.f, 0.f, 0.f, 0.f};
                if (bj <= bi) {
                    const LAS unsigned char* bb = F.lds + L_KB + (16 * bj + jl) * 272 + 16 * g;
#pragma unroll
                    for (int ks = 0; ks < 4; ++ks) { const bf16x8 bf = *(const LAS bf16x8*)(bb + 64 * ks); acc = __builtin_amdgcn_mfma_f32_16x16x32_bf16(af[ks], bf, acc, 0, 0, 0); }
                }
                const int j = 16 * bj + jl; const float gj = GB[64 + j];
                if (mat == 0) { if (bj <= bi) { f32x4 lv;
#pragma unroll
                        for (int r = 0; r < 4; ++r) { const int i = 16 * bi + 4 * g + r; lv[r] = (i > j) ? bt[r] * acc[r] * __expf(gi[r] - gj) : 0.f; }
                        *(LAS f32x4*)(Lt + j * LP + 16 * bi + 4 * g) = lv;
                        if (bi >= 2 && bj < 2) {
#pragma unroll
                            for (int r = 0; r < 4; ++r) *(LAS bf16_t*)(F.lds + L_LB + (16 * (bi - 2) + 4 * g + r) * 80 + j * 2) = (bf16_t)f2bf(-lv[r]); } } }
                else {
#pragma unroll
                    for (int r = 0; r < 4; ++r) { const int i = 16 * bi + 4 * g + r; const float v = (i >= j) ? acc[r] * __expf(gi[r] - gj) : 0.f; ((bf16_t*)(ws + WS_QKM))[((size_t)unit * 64 + i) * 64 + j] = (bf16_t)f2bf(v); } }
            }
        }
        {   const int t = tid >> 3, d0 = (tid & 7) * 16; const float beta = GB[t], be = beta * __expf(GB[64 + t]);
            LAS float* kp = S + (64 + t) * SP + d0; LAS float* vp = S + (128 + t) * SP + d0;
#pragma unroll
            for (int j = 0; j < 4; ++j) { f32x4 a = *(LAS f32x4*)(kp + 4 * j); a = a * be; *(LAS f32x4*)(kp + 4 * j) = a; f32x4 c = *(LAS f32x4*)(vp + 4 * j); c = c * beta; *(LAS f32x4*)(vp + 4 * j) = c; }
        }
        LDS_BARRIER();
        const LAS float* Lt = S;
        if (wave == 0) {
            const int bi = lane >> 4, cc = lane & 15; float x[16];
#pragma unroll
            for (int i = 0; i < 16; ++i) x[i] = (i == cc) ? 1.f : 0.f;
#pragma unroll
            for (int j = 0; j < 15; ++j) { const float sj = x[j];
#pragma unroll
                for (int q4 = (j + 1) / 4; q4 < 4; ++q4) { const f32x4 l4 = *(const LAS f32x4*)(Lt + (16 * bi + j) * LP + 16 * bi + 4 * q4);
#pragma unroll
                    for (int jj = 0; jj < 4; ++jj) x[4 * q4 + jj] -= l4[jj] * sj; } }
#pragma unroll
            for (int i = 0; i < 16; ++i) *(LAS bf16_t*)(F.lds + L_ST + (16 * bi + i) * 32 + cc * 2) = (bf16_t)f2bf(x[i]);
        }
        LDS_BARRIER();
        {   const int g = lane >> 4, jl = lane & 15;
            bf16x8 At[4], Al[6];
#pragma unroll
            for (int bi = 0; bi < 4; ++bi) { const u32x2 t = *(const LAS u32x2*)(F.lds + L_ST + (16 * bi + jl) * 32 + 8 * g); At[bi] = __builtin_bit_cast(bf16x8, (u32x4){t.x, t.y, 0u, 0u}); }
#pragma unroll
            for (int bi = 1; bi < 4; ++bi)
#pragma unroll
                for (int bj = 0; bj < bi; ++bj) { const LAS float* lp = Lt + (16 * bj + 4 * g) * LP + 16 * bi + jl;
                    Al[bi * (bi - 1) / 2 + bj] = __builtin_bit_cast(bf16x8, (u32x4){cvt_pk_bf16(-lp[0], -lp[LP]), cvt_pk_bf16(-lp[2 * LP], -lp[3 * LP]), 0u, 0u}); }
#pragma unroll
            for (int q = 0; q < 2; ++q) { const int cc = 16 * (2 * wave + q) + jl;
                const LAS float* rp = S + (cc < 128 ? 128 * SP + cc : 64 * SP + (cc - 128)) + (4 * g) * SP;
                bf16_t* og = (bf16_t*)(ws + (cc < 128 ? WS_UU : WS_WW)) + (row0 + 4 * g) * 1024 + h * 128 + (cc & 127);
                f32x4 y[4]; bf16x8 sb[4];
#pragma unroll
                for (int bi = 0; bi < 4; ++bi) y[bi] = (f32x4){rp[(16 * bi) * SP], rp[(16 * bi + 1) * SP], rp[(16 * bi + 2) * SP], rp[(16 * bi + 3) * SP]};
#pragma unroll
                for (int bi = 0; bi < 4; ++bi) {
#pragma unroll
                    for (int bj = 0; bj < bi; ++bj) y[bi] = __builtin_amdgcn_mfma_f32_16x16x32_bf16(Al[bi * (bi - 1) / 2 + bj], sb[bj], y[bi], 0, 0, 0);
                    const bf16x8 yb = __builtin_bit_cast(bf16x8, (u32x4){cvt_pk_bf16(y[bi][0], y[bi][1]), cvt_pk_bf16(y[bi][2], y[bi][3]), 0u, 0u});
                    const f32x4 sv = __builtin_amdgcn_mfma_f32_16x16x32_bf16(At[bi], yb, (f32x4){0.f, 0.f, 0.f, 0.f}, 0, 0, 0);
                    const unsigned p0 = cvt_pk_bf16(sv[0], sv[1]), p1 = cvt_pk_bf16(sv[2], sv[3]);
                    sb[bi] = __builtin_bit_cast(bf16x8, (u32x4){p0, p1, 0u, 0u});
                    og[(size_t)(16 * bi) * 1024] = (bf16_t)p0; og[(size_t)(16 * bi + 1) * 1024] = (bf16_t)(p0 >> 16); og[(size_t)(16 * bi + 2) * 1024] = (bf16_t)p1; og[(size_t)(16 * bi + 3) * 1024] = (bf16_t)(p1 >> 16);
                }
            }
        }
        LDS_BARRIER();
    }
}
__device__ __forceinline__ void sample_item(Frame& F, int sb, int h) {
    const Params& P = *F.p; unsigned char* ws = P.ws; OPAQUE_WS(ws); int tid = F.tid; asm volatile("" : "+v"(tid));
    const int lane = tid & 63, wave = __builtin_amdgcn_readfirstlane(tid >> 6);
    LAS float* SQ = (LAS float*)F.lds;
    LAS float* GT = SQ + 3 * 4 * 128;
    LAS float* RED = GT + 16;
    const bf16_t* proj = (const bf16_t*)(ws + WS_PROJ) + (size_t)(MP + sb * DECS) * DN_NP;
    const int dg = tid >> 7, e = tid & 127;
    float St[32];
    const float* s0 = P.in[3] + (((size_t)sb * 8 + h) * 128 + 32 * dg) * 128 + e;
#pragma unroll
    for (int i = 0; i < 32; ++i) St[i] = __builtin_nontemporal_load(s0 + (size_t)i * 128);
    if (tid < 384) {
        const int part = tid >> 7, d = tid & 127, col = part * 1024 + h * 128 + d;
        float xs[7];
#pragma unroll
        for (int j = 0; j < 3; ++j) xs[j] = P.in[4][((size_t)sb * 3 + j) * DN_QKV + col];
#pragma unroll
        for (int t = 0; t < 4; ++t) xs[3 + t] = bf2f(proj[(size_t)t * DN_NP + col]);
        float cw[4];
#pragma unroll
        for (int j = 0; j < 4; ++j) cw[j] = P.in[15][j * DN_QKV + col];
#pragma unroll
        for (int t = 0; t < 4; ++t) { float a = 0.f;
#pragma unroll
            for (int j = 0; j < 4; ++j) a += cw[j] * xs[t + j];
            SQ[(part * 4 + t) * 128 + d] = silu(a); }
#pragma unroll
        for (int j = 0; j < 3; ++j) P.out[O_CS + ((size_t)sb * 3 + j) * DN_QKV + col] = xs[4 + j];
    }
    if (tid >= 384 && tid < 388) { const int t = tid - 384; const float braw = bf2f(proj[(size_t)t * DN_NP + 4096 + h]), araw = bf2f(proj[(size_t)t * DN_NP + 4104 + h]);
        const float xs = araw + P.in[17][h]; const float sp = xs > 20.f ? xs : log1pf(__expf(xs));
        GT[t] = -__expf(P.in[16][h]) * sp; GT[4 + t] = 1.f / (1.f + __expf(-braw)); }
    LDS_BARRIER();
    { LAS float* rp = SQ + wave * 128; const float a = rp[lane], c = rp[lane + 64];
      float sc = rsqrtf(wave_sum(a * a + c * c) + L2_EPS); if (wave < 4) sc *= 0.08838834764831845f;
      rp[lane] = a * sc; rp[lane + 64] = c * sc; }
    LDS_BARRIER();
    for (int t = 0; t < 4; ++t) {
        const float dec = __expf(GT[t]), beta = GT[4 + t];
        const LAS float* qp = SQ + t * 128 + 32 * dg; const LAS float* kp = SQ + (4 + t) * 128 + 32 * dg;
        float kv = 0.f;
#pragma unroll
        for (int i = 0; i < 32; ++i) { St[i] *= dec; kv += kp[i] * St[i]; }
        RED[dg * 128 + e] = kv;
        LDS_BARRIER();
        const float kvt = (RED[e] + RED[128 + e]) + (RED[256 + e] + RED[384 + e]);
        const float delta = (SQ[(8 + t) * 128 + e] - kvt) * beta;
        float ov = 0.f;
#pragma unroll
        for (int i = 0; i < 32; ++i) { St[i] += kp[i] * delta; ov += qp[i] * St[i]; }
        LDS_BARRIER();
        RED[dg * 128 + e] = ov;
        LDS_BARRIER();
        if (dg == 0) { const float o = (RED[e] + RED[128 + e]) + (RED[256 + e] + RED[384 + e]); ((bf16_t*)(ws + WS_DO))[(size_t)(MP + sb * DECS + t) * 1024 + h * 128 + e] = (bf16_t)f2bf(o); }
        LDS_BARRIER();
    }
    float* so = P.out + O_SS + (((size_t)sb * 8 + h) * 128 + 32 * dg) * 128 + e;
#pragma unroll
    for (int i = 0; i < 32; ++i) __builtin_nontemporal_store(St[i], so + (size_t)i * 128);
    asm volatile("s_waitcnt vmcnt(0)" ::: "memory"); __syncthreads();
    if (wave < 4) gated_norm_row(ws, P.in[18], (size_t)(MP + sb * DECS + wave), h, lane);
}

struct StepRegs { bf16x8 a1[4]; bf16x8 a3[2]; bf16x8 a4[2]; };
__device__ __forceinline__ void scan_load(StepRegs& R, const unsigned char* ws, int b, int h, int sl, int n, int w, int g, int jl) {
    const int unit = (b * 8 + h) * 32 + n; const size_t row0 = (size_t)b * SEQ + 64 * n; const int tb = w & 3;
    const bf16_t* A1 = (const bf16_t*)(ws + (w < 4 ? WS_WW : WS_QD)) + (row0 + 16 * tb + jl) * 1024 + h * 128 + 8 * g;
#pragma unroll
    for (int ks = 0; ks < 4; ++ks) R.a1[ks] = *(const bf16x8*)(A1 + 32 * ks);
    const bf16_t* A4 = (const bf16_t*)(ws + WS_KDT) + ((size_t)unit * 128 + 16 * w + jl) * 64 + 8 * g;
#pragma unroll
    for (int ks = 0; ks < 2; ++ks) R.a4[ks] = *(const bf16x8*)(A4 + 32 * ks);
    const bf16_t* X = w >= 4 ? (const bf16_t*)(ws + WS_QKM) + ((size_t)unit * 64 + 16 * tb + jl) * 64 + 8 * g
                             : (const bf16_t*)(ws + WS_UU) + (row0 + 16 * tb + jl) * 1024 + h * 128 + 32 * sl + 8 * g;
    R.a3[0] = *(const bf16x8*)X; R.a3[1] = *(const bf16x8*)(X + (w >= 4 ? 32 : 0));
}
__device__ __forceinline__ void scan_step(unsigned char* ws, LAS unsigned char* ST, LAS unsigned char* VT, const StepRegs& cur, f32x4 (&sacc)[2], int b, int h, int sl, int n, int w, int g, int jl) {
    const int tb = w & 3; const size_t row0 = (size_t)b * SEQ + 64 * n;
    f32x4 tacc[2] = {{0.f, 0.f, 0.f, 0.f}, {0.f, 0.f, 0.f, 0.f}};
#pragma unroll
    for (int cb = 0; cb < 2; ++cb)
#pragma unroll
        for (int ks = 0; ks < 4; ++ks) { const bf16x8 bf = *(const LAS bf16x8*)(ST + (16 * cb + jl) * 272 + (32 * ks + 8 * g) * 2); tacc[cb] = __builtin_amdgcn_mfma_f32_16x16x32_bf16(bf, cur.a1[ks], tacc[cb], 0, 0, 0); }
    if (w < 4) {
        float uf[8]; unpack8(__builtin_bit_cast(u32x4, cur.a3[0]), uf);
#pragma unroll
        for (int cb = 0; cb < 2; ++cb) {
            const unsigned p0 = cvt_pk_bf16(uf[4 * cb + 0] - tacc[cb][0], uf[4 * cb + 1] - tacc[cb][1]), p1 = cvt_pk_bf16(uf[4 * cb + 2] - tacc[cb][2], uf[4 * cb + 3] - tacc[cb][3]);
            LAS unsigned short* vp = (LAS unsigned short*)(VT + (16 * cb + 4 * g) * 144 + (16 * tb + jl) * 2);
            vp[0] = (unsigned short)p0; vp[72] = (unsigned short)(p0 >> 16); vp[144] = (unsigned short)p1; vp[216] = (unsigned short)(p1 >> 16); }
    }
    LDS_BARRIER();
    if (w >= 4) {
#pragma unroll
        for (int cb = 0; cb < 2; ++cb)
#pragma unroll
            for (int ks = 0; ks < 2; ++ks) { const bf16x8 bf = *(const LAS bf16x8*)(VT + (16 * cb + jl) * 144 + (32 * ks + 8 * g) * 2); tacc[cb] = __builtin_amdgcn_mfma_f32_16x16x32_bf16(bf, cur.a3[ks], tacc[cb], 0, 0, 0); }
        *(u32x4*)((bf16_t*)(ws + WS_DO) + (row0 + 16 * tb + jl) * 1024 + h * 128 + 32 * sl + 8 * g) =
            (u32x4){cvt_pk_bf16(tacc[0][0], tacc[0][1]), cvt_pk_bf16(tacc[0][2], tacc[0][3]), cvt_pk_bf16(tacc[1][0], tacc[1][1]), cvt_pk_bf16(tacc[1][2], tacc[1][3])};
    }
    const float gl = ((const LAS float*)(VT + 32 * 144))[n];
#pragma unroll
    for (int cb = 0; cb < 2; ++cb) { sacc[cb] = sacc[cb] * gl;
#pragma unroll
        for (int ks = 0; ks < 2; ++ks) { const bf16x8 bf = *(const LAS bf16x8*)(VT + (16 * cb + jl) * 144 + (32 * ks + 8 * g) * 2); sacc[cb] = __builtin_amdgcn_mfma_f32_16x16x32_bf16(cur.a4[ks], bf, sacc[cb], 0, 0, 0); }
        *(LAS u32x2*)(ST + (16 * cb + jl) * 272 + (16 * w + 4 * g) * 2) = (u32x2){cvt_pk_bf16(sacc[cb][0], sacc[cb][1]), cvt_pk_bf16(sacc[cb][2], sacc[cb][3])}; }
    LDS_BARRIER();
}
__device__ __forceinline__ void scan_item(Frame& F, int b, int h, int sl) {
    const Params& P = *F.p; unsigned char* ws = P.ws; OPAQUE_WS(ws); int tid = F.tid; asm volatile("" : "+v"(tid));
    const int lane = tid & 63, w = __builtin_amdgcn_readfirstlane(tid >> 6), g = lane >> 4, jl = lane & 15;
    LAS unsigned char* ST = F.lds;
    LAS unsigned char* VT = F.lds + 32 * 272;
    for (int i = tid; i < 32 * 272 / 4; i += NTHREADS) ((LAS unsigned*)ST)[i] = 0u;
    if (tid < 32) ((LAS float*)(VT + 32 * 144))[tid] = ((const float*)(ws + WS_GL))[(b * 8 + h) * 32 + tid];
    f32x4 sacc[2] = {{0.f, 0.f, 0.f, 0.f}, {0.f, 0.f, 0.f, 0.f}};
    StepRegs A, B, C;
    scan_load(A, ws, b, h, sl, 0, w, g, jl); scan_load(B, ws, b, h, sl, 1, w, g, jl);
    __syncthreads();
    for (int n = 0; n < 30; n += 3) {
        scan_load(C, ws, b, h, sl, n + 2, w, g, jl); __builtin_amdgcn_sched_barrier(0); scan_step(ws, ST, VT, A, sacc, b, h, sl, n, w, g, jl);
        scan_load(A, ws, b, h, sl, n + 3, w, g, jl); __builtin_amdgcn_sched_barrier(0); scan_step(ws, ST, VT, B, sacc, b, h, sl, n + 1, w, g, jl);
        scan_load(B, ws, b, h, sl, n + 4, w, g, jl); __builtin_amdgcn_sched_barrier(0); scan_step(ws, ST, VT, C, sacc, b, h, sl, n + 2, w, g, jl);
    }
    scan_step(ws, ST, VT, A, sacc, b, h, sl, 30, w, g, jl);
    scan_step(ws, ST, VT, B, sacc, b, h, sl, 31, w, g, jl);
    float* so = P.out + O_SP + (((size_t)b * 8 + h) * 128 + 16 * w + 4 * g) * 128 + 32 * sl + 8 * (jl >> 2) + (jl & 3);
#pragma unroll
    for (int cb = 0; cb < 2; ++cb)
#pragma unroll
        for (int r = 0; r < 4; ++r) __builtin_nontemporal_store(sacc[cb][r], so + (size_t)r * 128 + 4 * cb);
}
template <int NB>
__device__ __forceinline__ void gated_norm_batch(unsigned char* ws, const float* gout, size_t row0, int h, int lane) {
    const size_t rowb = row0 + (lane >> 4); const int c0 = (lane & 15) * 8;
    u32x4 ov[NB], zv[NB];
#pragma unroll
    for (int i = 0; i < NB; ++i) { ov[i] = *(const u32x4*)((const bf16_t*)(ws + WS_DO) + (rowb + 32 * i) * 1024 + h * 128 + c0);
        zv[i] = __builtin_nontemporal_load((const u32x4*)((const bf16_t*)(ws + WS_PROJ) + (rowb + 32 * i) * DN_NP + 3072 + h * 128 + c0)); }
    const f32x4 g0 = *(const f32x4*)(gout + c0), g1 = *(const f32x4*)(gout + c0 + 4);
    const float g[8] = {g0.x, g0.y, g0.z, g0.w, g1.x, g1.y, g1.z, g1.w};
    __builtin_amdgcn_sched_barrier(0);
#pragma unroll
    for (int i = 0; i < NB; ++i) {
        float o[8], z[8]; unpack8(ov[i], o); unpack8(zv[i], z);
        float ss = 0.f;
#pragma unroll
        for (int k = 0; k < 8; ++k) ss += o[k] * o[k];
        ss += __shfl_xor(ss, 1); ss += __shfl_xor(ss, 2); ss += __shfl_xor(ss, 4); ss += __shfl_xor(ss, 8);
        const float rs = rsqrtf(ss * (1.f / 128.f) + RMS_EPS);
        float y[8];
#pragma unroll
        for (int k = 0; k < 8; ++k) y[k] = o[k] * rs * g[k] * silu(z[k]);
        *(u32x4*)((bf16_t*)(ws + WS_DOG) + (rowb + 32 * i) * 1024 + h * 128 + c0) = (u32x4){cvt_pk_bf16(y[0], y[1]), cvt_pk_bf16(y[2], y[3]), cvt_pk_bf16(y[4], y[5]), cvt_pk_bf16(y[6], y[7])};
    }
}
__device__ __forceinline__ void scan_tail(Frame& F, int b, int h, int sl) {
    unsigned char* ws = F.p->ws; unsigned* cnt = (unsigned*)(ws + WS_CTL) + CW_HAND + 64 * (16 + b * 8 + h);
    hand_signal(cnt);
    hand_wait(cnt, 4u);
    const int lane = F.lane;
    for (int bt = 0; bt < 2; ++bt) gated_norm_batch<8>(ws, F.p->in[18], (size_t)b * SEQ + 512 * sl + 4 * F.wave + 256 * bt, h, lane);
}
}

__global__ void __launch_bounds__(NTHREADS, 2) fwd_kernel(Params prm) {
    extern __shared__ __attribute__((aligned(16))) unsigned char lds_raw[];
    Frame F; F.lds = (LAS unsigned char*)lds_raw; F.tid = threadIdx.x; F.lane = F.tid & 63; F.wave = __builtin_amdgcn_readfirstlane(F.tid >> 6);
    F.G = gridDim.x; F.c = blockIdx.x; F.p = &prm;
    unsigned char* ws = prm.ws;
    volatile LAS unsigned* MISC = (volatile LAS unsigned*)(F.lds + 131072 + 8192);
    if (F.tid < 16) MISC[F.tid] = 0u;
    __syncthreads();
    (void)xcd_barrier_post((unsigned*)(ws + WS_CTL) + 1024, MISC + 8);
#define GSYNC() do { XcdBarrier gb_; gb_.bar = (unsigned*)(ws + WS_CTL) + 1024; gb_.x = 0; gb_.st = MISC + 8; xcd_barrier(gb_); OPAQUE_WS(ws); } while (0)
    const float QSCALE = 0.07216878364870322f * 1.4426950408889634f;

    p0_prologue(F);
    GSYNC();
    {
        pg8::Gemm g{(const bf16_t*)(ws + WS_U), (const bf16_t*)(ws + WS_WT_IN0), 1024, 1024};
        pg8::PlainOrder S; S.init(MT / 256, NIN0P / 256, 16, F.G, F.c);
        pg8::EpiF32 E{(float*)(ws + WS_A0), NIN0P, nullptr};
        pg8::gemm_phase(F.lds, g, S, E);
    }
    {
        pg8::Gemm g1{(const bf16_t*)(ws + WS_WOT), (const bf16_t*)(ws + WS_BD_UV), 1024, 1024};
        pg8::PrepOrder S1{4, 8, F.G, F.c, 195, 0};
        pg8::EpiBf16 E1{(bf16_t*)(ws + WS_WT_UVO), 2048};
        pg8::gemm_phase(F.lds, g1, S1, E1);
        pg8::Gemm g2{(const bf16_t*)(ws + WS_BD_UK), (const bf16_t*)(ws + WS_UQN), 1024, 1024};
        pg8::PrepOrder S2{8, 2, F.G, F.c, 227, 1};
        pg8::EpiBf16 E2{(bf16_t*)(ws + WS_WT_Q), 512};
        pg8::gemm_phase(F.lds, g2, S2, E2);
    }
    GSYNC();
    m2_rows(F);
    GSYNC();
    {
        pg8::Gemm g{(const bf16_t*)(ws + WS_CQ), (const bf16_t*)(ws + WS_WT_Q), 384, 512};
        pg8::PlainOrder S; S.init(MT / 256, NQ / 256, 6, F.G, F.c);
        pg8::EpiQ E{(bf16_t*)(ws + WS_Q), (const f32x2*)(ws + WS_ROPE), QSCALE};
        pg8::gemm_phase(F.lds, g, S, E);
    }
    GSYNC();
    attn::phase(F);
    GSYNC();
    for (int sb = F.c; sb < DECB; sb += F.G) attn::sample_combine(F, sb);
    GSYNC();
    {
        pg8::Gemm g{(const bf16_t*)(ws + WS_OL), (const bf16_t*)(ws + WS_WT_UVO), 2048, 2048};
        pg8::SplitOrder S; S.init(MP / 256, 4, 32, F.G, F.c); S.pmx = MP / 256; S.nsplit = 8;
        pg8::EpiMix E{(bf16_t*)(ws + WS_MIX), DM, (float*)(ws + WS_SLAB)};
        pg8::gemm_phase(F.lds, g, S, E);
    }
    GSYNC();
    rowpass(F, true, false, F.p->in[6] + 1 * DM, F.p->in[6] + 2 * DM, 8);
    GSYNC();
#pragma unroll
    for (int l = 0; l < 2; ++l) {
        if (l == 1) {
            {
                pg8::Gemm g{(const bf16_t*)(ws + WS_U), (const bf16_t*)(ws + WS_WT_DIN), 1024, 1024};
                pg8::PlainOrder S; S.init(MT / 256, DN_NP / 256, 16, F.G, F.c);
                pg8::EpiBf16 E{(bf16_t*)(ws + WS_PROJ), DN_NP};
                pg8::gemm_phase(F.lds, g, S, E);
            }
            GSYNC();
            dn::chunk_phase(F);
            for (int L = F.c; L < DECB * 8; L += F.G) dn::sample_item(F, L >> 3, L & 7);
            GSYNC();
            for (int L = F.c; L < 256; L += F.G) { const int sl = (L >> 3) & 3, bh = (L & 7) + 8 * (L >> 5); dn::scan_item(F, bh >> 3, bh & 7, sl); }
            for (int L = F.c; L < 256; L += F.G) { const int sl = (L >> 3) & 3, bh = (L & 7) + 8 * (L >> 5); dn::scan_tail(F, bh >> 3, bh & 7, sl); }
            GSYNC();
            {
                pg8::Gemm g{(const bf16_t*)(ws + WS_DOG), (const bf16_t*)(ws + WS_WT_DO), 1024, 1024};
                pg8::SplitOrder S; S.init(MP / 256, 4, 16, F.G, F.c); S.pmx = MP / 256; S.nsplit = 4;
                pg8::EpiMix E{(bf16_t*)(ws + WS_MIX), DM, (float*)(ws + WS_SLAB)};
                pg8::gemm_phase(F.lds, g, S, E);
            }
            GSYNC();
            rowpass(F, false, false, F.p->in[6] + 5 * DM, F.p->in[6] + 6 * DM, 4);
            GSYNC();
        }
        {
            pg8::Gemm g{(const bf16_t*)(ws + WS_U), (const bf16_t*)(ws + WS_WT_F1) + (size_t)l * 5632 * 1024, 1024, 1024};
            pg8::PlainOrder S; S.init(MT / 256, 22, 16, F.G, F.c);
            pg8::EpiSwiglu E{(bf16_t*)(ws + WS_H), DFF};
            pg8::gemm_phase(F.lds, g, S, E);
        }
        GSYNC();
        {
            pg8::Gemm g{(const bf16_t*)(ws + WS_H), (const bf16_t*)(ws + WS_WT_F2) + (size_t)l * 1024 * DFF, DFF, DFF};
            pg8::SplitOrder S; S.init(MP / 256, 4, 44, F.G, F.c); S.pmx = MP / 256; S.nsplit = 11;
            pg8::EpiMix E{(bf16_t*)(ws + WS_MIX), DM, (float*)(ws + WS_SLAB)};
            pg8::gemm_phase(F.lds, g, S, E);
        }
        GSYNC();
        rowpass(F, false, l == 1, F.p->in[6] + (l * 4 + 3) * DM, l == 0 ? F.p->in[6] + 4 * DM : nullptr, 11);
        if (l == 0) GSYNC();
    }
}

extern "C" void kernel_launch(void* const* d_in, const int* in_sizes, int n_in, void* d_out, int out_size, void* d_ws, size_t ws_size, hipStream_t stream) {
    static int grid = 0;
    if (grid == 0) {
        int dev = 0, cus = 0, per_cu = 0;
        hipGetDevice(&dev);
        hipDeviceGetAttribute(&cus, hipDeviceAttributeMultiprocessorCount, dev);
        hipFuncSetAttribute((const void*)fwd_kernel, hipFuncAttributeMaxDynamicSharedMemorySize, LDS_BYTES);
        hipOccupancyMaxActiveBlocksPerMultiprocessor(&per_cu, (const void*)fwd_kernel, NTHREADS, LDS_BYTES);
        if (per_cu < 1) { fprintf(stderr, "kernel_launch: occupancy query reports %d blocks per CU\n", per_cu); per_cu = 1; }
        (void)hipGetLastError();
        grid = cus;
        if (n_in != 22 || (size_t)out_size != O_END || ws_size < WS_END) fprintf(stderr, "kernel_launch: unexpected sizes n_in %d out %d ws %zu\n", n_in, out_size, ws_size);
    }
    if (ws_size < WS_END || n_in != 22 || (size_t)out_size != O_END) return;
    hipMemsetAsync((char*)d_ws + WS_CTL, 0, CTL_BYTES, stream);
    Params p{};
    for (int i = 0; i < 22; ++i) p.in[i] = (const float*)d_in[i];
    p.page_table = (const int*)d_in[5]; p.out = (float*)d_out; p.ws = (unsigned char*)d_ws;
    void* args[] = {&p};
    hipError_t e = hipLaunchCooperativeKernel((const void*)fwd_kernel, dim3(grid), dim3(NTHREADS), args, LDS_BYTES, stream);
    if (e != hipSuccess) fprintf(stderr, "cooperative launch failed: %s (grid %d)\n", hipGetErrorString(e), grid);
}
```

```cpp
#include <hip/hip_runtime.h>
#include <hip/hip_cooperative_groups.h>
#include <cstdio>
#include <cstdint>
namespace cg = cooperative_groups;

#define LAS __attribute__((address_space(3)))
#define GAS __attribute__((address_space(1)))
typedef unsigned short bf16_t;
typedef short bf16x8 __attribute__((ext_vector_type(8)));
typedef short s16x4 __attribute__((ext_vector_type(4)));
typedef float f32x4 __attribute__((ext_vector_type(4)));
typedef float f32x2 __attribute__((ext_vector_type(2)));
typedef unsigned u32x4 __attribute__((ext_vector_type(4)));
typedef unsigned u32x2 __attribute__((ext_vector_type(2)));

constexpr int DM = 1024, BATCH = 8, SEQ = 2048, DECB = 32, DECS = 4, PAST = 16384, PAGE = 128;
constexpr int MP = BATCH * SEQ;
constexpr int MS = DECB * DECS;
constexpr int MV = MP + MS;
constexpr int MT = 16640;
constexpr int HEADS = 8, QK_NOPE = 128, QK_ROPE = 64, V_HEAD = 128, KV_LORA = 256, Q_LORA = 384, MLA_ROW = 320;
constexpr int NIN0 = Q_LORA + MLA_ROW;
constexpr int NIN0P = 768;
constexpr int NQ = HEADS * KV_LORA + HEADS * QK_ROPE;
constexpr int DN_HK = 1024, DN_QKV = 3072, DN_Z = 1024, DN_N = 4112, DN_NP = 4352, CONVW = 4, CHUNK = 64;
constexpr int DFF = 2816;
constexpr int NPAGES = PAST / PAGE;
constexpr float RMS_EPS = 1e-6f, L2_EPS = 1e-6f;
constexpr int NTHREADS = 512, NWAVES = 8;

constexpr size_t O_Y = 0;
constexpr size_t O_ROWS = (size_t)MV * DM;
constexpr size_t O_SP = O_ROWS + (size_t)MV * MLA_ROW;
constexpr size_t O_SS = O_SP + (size_t)BATCH * 8 * 128 * 128;
constexpr size_t O_CP = O_SS + (size_t)DECB * 8 * 128 * 128;
constexpr size_t O_CS = O_CP + (size_t)BATCH * 3 * DN_QKV;
constexpr size_t O_END = O_CS + (size_t)DECB * 3 * DN_QKV;

constexpr size_t MiB = 1u << 20;
constexpr size_t WS_CTL = 0;
constexpr size_t CTL_BYTES = 1 * MiB;
constexpr size_t WS_ROPE = 1 * MiB;
constexpr size_t WS_WT_IN0 = 2 * MiB;
constexpr size_t WS_WT_Q = 856 * MiB;
constexpr size_t WS_WT_UVO = 6 * MiB;
constexpr size_t WS_BD_UV = 10 * MiB;
constexpr size_t WS_WOT = 14 * MiB;
constexpr size_t WS_BD_UK = 16 * MiB;
constexpr size_t WS_UQN = 20 * MiB;
constexpr size_t WS_WT_F1 = 22 * MiB;
constexpr size_t WS_WT_F2 = 44 * MiB;
constexpr size_t WS_WT_DIN = 56 * MiB;
constexpr size_t WS_WT_DO = 65 * MiB;
constexpr size_t WS_U = 68 * MiB;
constexpr size_t WS_A0 = 102 * MiB;
constexpr size_t WS_CQ = 152 * MiB;
constexpr size_t WS_ROWSB = 166 * MiB;
constexpr size_t WS_Q = 178 * MiB;
constexpr size_t WS_OL = 260 * MiB;
constexpr size_t WS_MIX = 326 * MiB;
constexpr size_t WS_SLAB = 392 * MiB;
constexpr size_t WS_H = 400 * MiB;
constexpr size_t WS_PROJ = 490 * MiB;
constexpr size_t WS_PART = 632 * MiB;
constexpr size_t WS_ML = 641 * MiB;
constexpr size_t WS_DO = 642 * MiB;
constexpr size_t WS_DOG = 676 * MiB;
constexpr size_t WS_UU = 710 * MiB;
constexpr size_t WS_WW = 742 * MiB;
constexpr size_t WS_QD = 774 * MiB;
constexpr size_t WS_KDT = 806 * MiB;
constexpr size_t WS_QKM = 838 * MiB;
constexpr size_t WS_GL = 854 * MiB;
constexpr size_t WS_HB = 860 * MiB;
constexpr size_t WS_END = 894 * MiB;
constexpr int NSLAB_MAX = 16;

constexpr int CW_GEN = 64;
constexpr int CW_ATT = 8192;

__device__ __forceinline__ float bf2f(unsigned short b) { return __builtin_bit_cast(float, (unsigned)b << 16); }
typedef float f32x2_t __attribute__((ext_vector_type(2)));
typedef __bf16 bf16x2_t __attribute__((ext_vector_type(2)));
__device__ __forceinline__ unsigned cvt_pk_bf16(float lo, float hi) { f32x2_t v = {lo, hi}; bf16x2_t b = __builtin_convertvector(v, bf16x2_t); return __builtin_bit_cast(unsigned, b); }
__device__ __forceinline__ unsigned f2bf(float f) { return cvt_pk_bf16(f, 0.f) & 0xffffu; }
__device__ __forceinline__ unsigned pk2(float lo, float hi) { return cvt_pk_bf16(lo, hi); }
__device__ __forceinline__ float wave_sum(float v) {
#pragma unroll
    for (int o = 1; o < 64; o <<= 1) v += __shfl_xor(v, o);
    return v;
}
#define LDS_WAIT() asm volatile("s_waitcnt lgkmcnt(0)" ::: "memory")
#define VM_WAIT() asm volatile("s_waitcnt vmcnt(0)" ::: "memory")

typedef __attribute__((address_space(1))) unsigned char g_u8_t;
#define OPAQUE_WS(ws) do { g_u8_t* w1_ = (g_u8_t*)(ws); asm volatile("" : "+s"(w1_)); ws = (unsigned char*)w1_; } while (0)
namespace pg8 {
constexpr int BM = 256, BK = 64, HALF = 128, HTB = HALF * BK * 2, STAGE_BYTES = 8 * HTB, NXCD = 8, WGM = 8;
__host__ __device__ __forceinline__ int lds_byte(int r, int c) { const int st = (r >> 4) * 2 + (c >> 5), rr = r & 15, cc = c & 31, ob = rr * 64 + cc * 2; return st * 1024 + (ob ^ (((ob >> 9) & 1) << 5)); }
__host__ __device__ __forceinline__ void stage_rc(int b, int& R, int& C) { const int st = b / 1024, sb = b % 1024, swz = sb ^ (((sb >> 9) & 1) << 5); R = (st >> 1) * 16 + swz / 64; C = (st & 1) * 32 + (swz % 64) / 2; }
__host__ __device__ __forceinline__ int perm32(int rho) { const int n = rho >> 4, i = rho & 15; return 8 * (i >> 2) + 4 * n + (i & 3); }

struct Unit { int pm, pn, kt0, nkt, z; };
struct Gemm { const bf16_t* A; const bf16_t* Bt; int lda, ldb; };

struct MainOrder {
    int nM, nN, nwg, G, c, nkt;
    __device__ __forceinline__ void init(int nM_, int nN_, int nkt_, int G_, int c_) { nM = nM_; nN = nN_; nwg = nM * nN; G = G_; c = c_; nkt = nkt_; asm volatile("" : "+s"(c)); }
    __device__ __forceinline__ void main_map(int L, int& pm, int& pn) const {
        int wgid = L; { const int q = nwg / NXCD, r = nwg % NXCD, xcd = wgid % NXCD, off = wgid / NXCD; wgid = (xcd < r ? xcd * (q + 1) : r * (q + 1) + (xcd - r) * q) + off; }
        const int nig = WGM * nN, gid = wgid / nig, fm = gid * WGM, gsz = (nM - fm) < WGM ? (nM - fm) : WGM;
        pm = fm + ((wgid % nig) % gsz); pn = (wgid % nig) / gsz;
    }
};
struct SplitOrder : MainOrder {
    int pmx, nsplit;
    __device__ __forceinline__ bool next(int i, Unit& u) const {
        const int L = i * G + c; const bool is_main = L < nwg; const int e = L - nwg; const bool ok = is_main || e < nsplit * nN;
        int pm = 0, pn = 0; main_map(is_main ? L : 0, pm, pn);
        const int per = nkt / nsplit, z = e / nN;
        Unit r; r.pm = is_main ? pm : pmx; r.pn = is_main ? pn : e % nN; r.kt0 = is_main ? 0 : z * per; r.nkt = is_main ? nkt : per; r.z = is_main ? -1 : z;
        u = r; return ok;
    }
};
struct PlainOrder : MainOrder {
    __device__ __forceinline__ bool next(int i, Unit& u) const {
        const int L = i * G + c; const bool ok = L < nwg; int pm = 0, pn = 0; main_map(ok ? L : 0, pm, pn);
        Unit r; r.pm = pm; r.pn = pn; r.kt0 = 0; r.nkt = nkt; r.z = -1; u = r; return ok;
    }
};
struct PrepOrder {
    int nM, nN, G, c, c0, by_m;
    __device__ __forceinline__ bool next(int i, Unit& u) const {
        const int i0 = c < c0 ? (c0 - c + G - 1) / G : 0; const int L = (i + i0) * G + c - c0; const bool ok = L < nM * nN;
        const int pm = ok ? L / nN : 0, pn = ok ? L % nN : 0; const int h = by_m ? pm : pn;
        int four = 4; asm volatile("" : "+s"(four));
        Unit r; r.pm = pm; r.pn = pn; r.kt0 = 4 * (h >> 1); r.nkt = four; r.z = -1; u = r; return ok;
    }
};

struct EpiF32 {
    static constexpr bool PERM = false;
    float* C; int ldc; float* slab;
    __device__ __forceinline__ void operator()(const f32x4 (&acc)[2][2][4][2], const Unit& u, int wr, int wc, int fr, int fq) const {
        const bool split = u.z >= 0;
        float* base = (split ? slab + (size_t)u.z * 128 * ldc : C + (size_t)u.pm * BM * ldc) + (size_t)(wr * 64 + fr) * ldc + u.pn * BM + wc * 32 + 4 * fq;
#pragma unroll
        for (int ai = 0; ai < 2; ++ai) {
            if (ai == 1 && split) break;
#pragma unroll
            for (int m = 0; m < 4; ++m) { float* rowp = base + (size_t)(ai * HALF + m * 16) * ldc;
#pragma unroll
                for (int bj = 0; bj < 2; ++bj)
#pragma unroll
                    for (int n = 0; n < 2; ++n) *(f32x4*)(rowp + bj * HALF + n * 16) = acc[ai][bj][m][n]; }
        }
    }
};
struct EpiMix {
    static constexpr bool PERM = true;
    bf16_t* C; int ldc; float* slab;
    __device__ __forceinline__ void operator()(const f32x4 (&acc)[2][2][4][2], const Unit& u, int wr, int wc, int fr, int fq) const {
        const int col0 = u.pn * BM + wc * 32 + 8 * fq;
        if (u.z < 0) {
            const int row0 = u.pm * BM + wr * 64 + fr;
#pragma unroll
            for (int ai = 0; ai < 2; ++ai)
#pragma unroll
                for (int m = 0; m < 4; ++m) { bf16_t* rowp = C + (size_t)(row0 + ai * HALF + m * 16) * ldc + col0;
#pragma unroll
                    for (int bj = 0; bj < 2; ++bj) { const f32x4 v0 = acc[ai][bj][m][0], v1 = acc[ai][bj][m][1];
                        u32x4 w; w.x = cvt_pk_bf16(v0[0], v0[1]); w.y = cvt_pk_bf16(v0[2], v0[3]); w.z = cvt_pk_bf16(v1[0], v1[1]); w.w = cvt_pk_bf16(v1[2], v1[3]);
                        *(u32x4*)(rowp + bj * HALF) = w; } }
        } else {
            float* base = slab + (size_t)u.z * 128 * ldc + (size_t)(wr * 64 + fr) * ldc + col0;
#pragma unroll
            for (int m = 0; m < 4; ++m)
#pragma unroll
                for (int bj = 0; bj < 2; ++bj) { float* p = base + (size_t)(m * 16) * ldc + bj * HALF; *(f32x4*)p = acc[0][bj][m][0]; *(f32x4*)(p + 4) = acc[0][bj][m][1]; }
        }
    }
};
struct EpiBf16 {
    static constexpr bool PERM = true;
    bf16_t* C; int ldc;
    __device__ __forceinline__ void operator()(const f32x4 (&acc)[2][2][4][2], const Unit& u, int wr, int wc, int fr, int fq) const {
        const int row0 = u.pm * BM + wr * 64 + fr, col0 = u.pn * BM + wc * 32 + 8 * fq;
#pragma unroll
        for (int ai = 0; ai < 2; ++ai)
#pragma unroll
            for (int m = 0; m < 4; ++m) { bf16_t* rowp = C + (size_t)(row0 + ai * HALF + m * 16) * ldc + col0;
#pragma unroll
                for (int bj = 0; bj < 2; ++bj) { const f32x4 v0 = acc[ai][bj][m][0], v1 = acc[ai][bj][m][1];
                    u32x4 w; w.x = cvt_pk_bf16(v0[0], v0[1]); w.y = cvt_pk_bf16(v0[2], v0[3]); w.z = cvt_pk_bf16(v1[0], v1[1]); w.w = cvt_pk_bf16(v1[2], v1[3]);
                    *(u32x4*)(rowp + bj * HALF) = w; } }
    }
};
struct EpiSwiglu {
    static constexpr bool PERM = true;
    bf16_t* C; int ldc;
    __device__ __forceinline__ void operator()(const f32x4 (&acc)[2][2][4][2], const Unit& u, int wr, int wc, int fr, int fq) const {
        const int row0 = u.pm * BM + wr * 64 + fr, col0 = u.pn * HALF + wc * 32 + 8 * fq;
#pragma unroll
        for (int ai = 0; ai < 2; ++ai)
#pragma unroll
            for (int m = 0; m < 4; ++m) { float o[8];
#pragma unroll
                for (int n = 0; n < 2; ++n)
#pragma unroll
                    for (int j = 0; j < 4; ++j) { const float g = acc[ai][0][m][n][j], up = acc[ai][1][m][n][j]; o[4 * n + j] = g * __builtin_amdgcn_rcpf(1.f + __expf(-g)) * up; }
                u32x4 w; w.x = cvt_pk_bf16(o[0], o[1]); w.y = cvt_pk_bf16(o[2], o[3]); w.z = cvt_pk_bf16(o[4], o[5]); w.w = cvt_pk_bf16(o[6], o[7]);
                *(u32x4*)(C + (size_t)(row0 + ai * HALF + m * 16) * ldc + col0) = w; }
    }
};
struct EpiQ {
    static constexpr bool PERM = true;
    bf16_t* C; const f32x2* rope; float scale;
    __device__ __forceinline__ void operator()(const f32x4 (&acc)[2][2][4][2], const Unit& u, int wr, int wc, int fr, int fq) const {
        const int row0 = u.pm * BM + wr * 64 + fr, col0 = u.pn * BM + wc * 32 + 8 * fq;
        const bool rp = u.pn >= 8;
#pragma unroll
        for (int ai = 0; ai < 2; ++ai)
#pragma unroll
            for (int m = 0; m < 4; ++m) { const int row = row0 + ai * HALF + m * 16;
                int pidx = row < MP ? (row & (SEQ - 1)) : (SEQ + ((row - MP) & 3)); if (row >= MV) pidx = 0;
                bf16_t* rowp = C + (size_t)row * NQ + col0;
#pragma unroll
                for (int bj = 0; bj < 2; ++bj) { f32x4 v0 = acc[ai][bj][m][0], v1 = acc[ai][bj][m][1];
                    if (rp) { const int i0 = ((col0 + bj * HALF) & 63) >> 1; const f32x2* t = rope + pidx * 32 + i0;
                        const f32x2 c0 = t[0], c1 = t[1], c2 = t[2], c3 = t[3];
                        const f32x4 r0 = {v0[0] * c0.x - v0[1] * c0.y, v0[1] * c0.x + v0[0] * c0.y, v0[2] * c1.x - v0[3] * c1.y, v0[3] * c1.x + v0[2] * c1.y};
                        const f32x4 r1 = {v1[0] * c2.x - v1[1] * c2.y, v1[1] * c2.x + v1[0] * c2.y, v1[2] * c3.x - v1[3] * c3.y, v1[3] * c3.x + v1[2] * c3.y};
                        v0 = r0; v1 = r1; }
                    v0 = v0 * scale; v1 = v1 * scale;
                    if (rp) {
                        const int cc = col0 + bj * HALF - 2048, hh = cc >> 6, i0 = (cc & 63) >> 1; bf16_t* qp = C + (size_t)row * NQ + 2048 + hh * 64 + i0;
                        u32x2 a, b; a.x = cvt_pk_bf16(v0[0], v0[2]); a.y = cvt_pk_bf16(v1[0], v1[2]); b.x = cvt_pk_bf16(v0[1], v0[3]); b.y = cvt_pk_bf16(v1[1], v1[3]);
                        *(u32x2*)qp = a; *(u32x2*)(qp + 32) = b;
                    } else {
                    u32x4 w; w.x = cvt_pk_bf16(v0[0], v0[1]); w.y = cvt_pk_bf16(v0[2], v0[3]); w.z = cvt_pk_bf16(v1[0], v1[1]); w.w = cvt_pk_bf16(v1[2], v1[3]);
                    *(u32x4*)(rowp + bj * HALF) = w; } } }
    }
};

template <class Epi, class Sched>
__device__ __forceinline__ void gemm_phase(LAS unsigned char* lds, const Gemm g, const Sched& S, const Epi& E) {
    int tid = threadIdx.x; asm volatile("" : "+v"(tid));
    const int wid = __builtin_amdgcn_readfirstlane(tid >> 6), lane = tid & 63, wr = wid >> 2, wc = wid & 3, fr = lane & 15, fq = lane >> 4;
    unsigned voffA[2], voffB[2];
#pragma unroll
    for (int i = 0; i < 2; ++i) { int R, C; stage_rc(tid * 16 + i * 8192, R, C); const int Rb = Epi::PERM ? ((R & ~31) + perm32(R & 31)) : R;
        voffA[i] = (unsigned)(R * g.lda + C) * 2u; voffB[i] = (unsigned)(Rb * g.ldb + C) * 2u; }
    const size_t kstep = (size_t)(BK * 2);
    const size_t hstepA = (size_t)HALF * g.lda * 2, hstepB = (size_t)HALF * g.ldb * 2;
    const size_t tstepA = 2 * hstepA, tstepB = 2 * hstepB;
    const unsigned ldsw = (unsigned)wid * 1024u;
    const int aoff = lds_byte(wr * 64 + fr, fq * 8), boff = lds_byte(wc * 32 + fr, fq * 8);
#define PG8_SA(b, h) (((b) * 2 + (h)) * HTB)
#define PG8_SB(b, h) ((4 + (b) * 2 + (h)) * HTB)
#define PG8_STAGE(bufoff, gbase, voff) do { _Pragma("unroll") for (int _i = 0; _i < 2; ++_i) \
        __builtin_amdgcn_global_load_lds((const unsigned*)((const char*)(gbase) + (voff)[_i]), (LAS unsigned*)(lds + (bufoff) + ldsw + _i * 8192), 16, 0, 0); } while (0)
#define PG8_LDA(dst, b, h) do { _Pragma("unroll") for (int m = 0; m < 4; ++m) _Pragma("unroll") for (int k = 0; k < 2; ++k) dst[m][k] = *(const LAS bf16x8*)(lds + PG8_SA(b, h) + aoff + m * 2048 + k * 1024); } while (0)
#define PG8_LDB(dst, b, h) do { _Pragma("unroll") for (int n = 0; n < 2; ++n) _Pragma("unroll") for (int k = 0; k < 2; ++k) dst[n][k] = *(const LAS bf16x8*)(lds + PG8_SB(b, h) + boff + n * 2048 + k * 1024); } while (0)
#define PG8_MMA(ai, bj, At, Bt) do { __builtin_amdgcn_s_setprio(1); _Pragma("unroll") for (int m = 0; m < 4; ++m) _Pragma("unroll") for (int n = 0; n < 2; ++n) _Pragma("unroll") for (int k = 0; k < 2; ++k) \
        acc[ai][bj][m][n] = __builtin_amdgcn_mfma_f32_16x16x32_bf16(Bt[n][k], At[m][k], acc[ai][bj][m][n], 0, 0, 0); __builtin_amdgcn_s_setprio(0); } while (0)
#define PG8_WAIT_V(n) asm volatile("s_waitcnt vmcnt(" #n ")" ::: "memory")
#define PG8_WAIT_L(n) asm volatile("s_waitcnt lgkmcnt(" #n ")" ::: "memory")
#define PG8_BAR __builtin_amdgcn_s_barrier()
#define PG8_SCHED __builtin_amdgcn_sched_barrier(0)
    Unit cur, nxt; int ui = 0;
    if (!S.next(0, cur)) return;
    f32x4 acc[2][2][4][2];
#pragma unroll
    for (int a = 0; a < 2; ++a)
#pragma unroll
        for (int b = 0; b < 2; ++b)
#pragma unroll
            for (int m = 0; m < 4; ++m)
#pragma unroll
                for (int n = 0; n < 2; ++n) acc[a][b][m][n] = (f32x4){0.f, 0.f, 0.f, 0.f};
    bf16x8 At[4][2], B0[2][2], B1[2][2];
    const char* cA = (const char*)g.A + (size_t)cur.pm * tstepA + (size_t)cur.kt0 * kstep; const char* cB = (const char*)g.Bt + (size_t)cur.pn * tstepB + (size_t)cur.kt0 * kstep;
    PG8_STAGE(PG8_SB(0, 0), cB, voffB); PG8_STAGE(PG8_SB(0, 1), cB + hstepB, voffB); PG8_STAGE(PG8_SA(0, 0), cA, voffA); PG8_STAGE(PG8_SA(0, 1), cA + hstepA, voffA);
    if (wr == 1) PG8_BAR;
    PG8_WAIT_V(2); PG8_BAR;
    PG8_STAGE(PG8_SB(1, 0), cB + kstep, voffB); PG8_STAGE(PG8_SA(1, 0), cA + kstep, voffA); PG8_STAGE(PG8_SB(1, 1), cB + hstepB + kstep, voffB);
    PG8_WAIT_V(6); PG8_BAR;
    for (;;) {
        const bool has_next = S.next(ui + 1, nxt);
        const char* nA = has_next ? (const char*)g.A + (size_t)nxt.pm * tstepA + (size_t)nxt.kt0 * kstep : cA;
        const char* nB = has_next ? (const char*)g.Bt + (size_t)nxt.pn * tstepB + (size_t)nxt.kt0 * kstep : cB;
        const int nt = cur.nkt;
        for (int t = 0; t < nt; t += 2) {
            const bool last = (t == nt - 2);
            const char* a1 = cA + (size_t)(t + 1) * kstep;
            const char* a2 = last ? nA : cA + (size_t)(t + 2) * kstep; const char* b2 = last ? nB : cB + (size_t)(t + 2) * kstep;
            const char* a3 = a2 + kstep; const char* b3 = b2 + kstep;
            PG8_LDB(B0, 0, 0); PG8_LDB(B1, 0, 1); PG8_SCHED; PG8_LDA(At, 0, 0); PG8_STAGE(PG8_SA(1, 1), a1 + hstepA, voffA);
            PG8_WAIT_V(8); PG8_WAIT_L(0); PG8_BAR; PG8_MMA(0, 0, At, B0); PG8_MMA(0, 1, At, B1); PG8_BAR; PG8_SCHED;
            PG8_LDA(At, 0, 1); PG8_STAGE(PG8_SB(0, 0), b2, voffB); PG8_STAGE(PG8_SB(0, 1), b2 + hstepB, voffB); PG8_STAGE(PG8_SA(0, 0), a2, voffA);
            PG8_WAIT_V(8); PG8_WAIT_L(0); PG8_BAR; PG8_MMA(1, 0, At, B0); PG8_MMA(1, 1, At, B1); PG8_BAR; PG8_SCHED;
            PG8_LDB(B0, 1, 0); PG8_LDB(B1, 1, 1); PG8_SCHED; PG8_LDA(At, 1, 0); PG8_STAGE(PG8_SA(0, 1), a2 + hstepA, voffA);
            PG8_WAIT_V(8); PG8_WAIT_L(0); PG8_BAR; PG8_MMA(0, 0, At, B0); PG8_MMA(0, 1, At, B1); PG8_BAR; PG8_SCHED;
            PG8_LDA(At, 1, 1); PG8_STAGE(PG8_SB(1, 0), b3, voffB); PG8_STAGE(PG8_SB(1, 1), b3 + hstepB, voffB); PG8_STAGE(PG8_SA(1, 0), a3, voffA);
            PG8_WAIT_V(8); PG8_WAIT_L(0); PG8_BAR; PG8_MMA(1, 0, At, B0); PG8_MMA(1, 1, At, B1); PG8_BAR; PG8_SCHED;
        }
        if (wr == 0) PG8_BAR;
        E(acc, cur, wr, wc, fr, fq);
        if (!has_next) break;
#pragma unroll
        for (int a = 0; a < 2; ++a)
#pragma unroll
            for (int b = 0; b < 2; ++b)
#pragma unroll
                for (int m = 0; m < 4; ++m)
#pragma unroll
                    for (int n = 0; n < 2; ++n) acc[a][b][m][n] = (f32x4){0.f, 0.f, 0.f, 0.f};
        cur = nxt; cA = nA; cB = nB; ++ui;
        if (wr == 1) PG8_BAR;
    }
    PG8_WAIT_V(0);
    PG8_BAR;
#undef PG8_SA
#undef PG8_SB
#undef PG8_STAGE
#undef PG8_LDA
#undef PG8_LDB
#undef PG8_MMA
#undef PG8_WAIT_V
#undef PG8_WAIT_L
#undef PG8_BAR
#undef PG8_SCHED
}
}


#define XB_TMO      128
#define XB_XCNT(j)  (256  + 64 * (j))
#define XB_XSUB(j)  (1280 + 64 * (j))
#define XB_XGEN(j)  (2304 + 64 * (j))
#define XB_TOP      3328
#define XB_TOPGEN   3392
#define XCD_BAR_WORDS 3456
#define XB_SPIN_CAP (1u << 22)
__device__ __forceinline__ unsigned xb_ld(unsigned* p)              { return __hip_atomic_load(p, __ATOMIC_RELAXED, __HIP_MEMORY_SCOPE_AGENT); }
__device__ __forceinline__ unsigned xb_add(unsigned* p, unsigned v) { return __hip_atomic_fetch_add(p, v, __ATOMIC_RELAXED, __HIP_MEMORY_SCOPE_AGENT); }
__device__ __forceinline__ unsigned xb_xcc_id() { return (unsigned)__builtin_amdgcn_s_getreg((3 << 11) | 20) & 0xFu; }
#define XB_SPIN(cond, bar) do { unsigned _sp = 0; while (cond) { __builtin_amdgcn_s_sleep(1); \
    if ((++_sp & 255u) == 0u) { if (xb_ld(&(bar)[XB_TMO])) break; if (_sp > XB_SPIN_CAP) { atomicAdd(&(bar)[XB_TMO], 1u); break; } } } } while (0)
struct XcdBarrier { unsigned* bar; unsigned x; volatile LAS unsigned* st; };
__device__ __forceinline__ XcdBarrier xcd_barrier_post(unsigned* bar, volatile LAS unsigned* st) {
    XcdBarrier b; b.bar = bar; b.x = xb_xcc_id(); b.st = st;
    if (threadIdx.x == 0) (void)xb_add(&bar[XB_XCNT(b.x)], 1u);
    return b;
}
__device__ __forceinline__ void xcd_barrier_complete(unsigned* bar, unsigned x, unsigned& nloc, unsigned& nx) {
    const unsigned G = gridDim.x * gridDim.y * gridDim.z;
    unsigned sum, cnt, mine, sp = 0u;
    for (;;) {
        sum = 0u; cnt = 0u; mine = 0u;
#pragma unroll
        for (unsigned j = 0; j < 16; ++j) { const unsigned c = xb_ld(&bar[XB_XCNT(j)]); sum += c; cnt += (c > 0u) ? 1u : 0u; mine = (j == x) ? c : mine; }
        if (sum == G) break;
        __builtin_amdgcn_s_sleep(1);
        if ((++sp & 255u) == 0u) { if (xb_ld(&bar[XB_TMO])) break; if (sp > XB_SPIN_CAP) { atomicAdd(&bar[XB_TMO], 1u); break; } }
    }
    nloc = mine > 0u ? mine : 1u; nx = cnt > 0u ? cnt : 1u;
}
__device__ __forceinline__ void xcd_barrier(const XcdBarrier& b0) {
    XcdBarrier b; b.bar = b0.bar; b.st = b0.st; b.x = (unsigned)__builtin_amdgcn_readfirstlane((int)xb_xcc_id());
    asm volatile("s_waitcnt vmcnt(0)" ::: "memory");
    __syncthreads();
    if (threadIdx.x == 0) {
        unsigned* bar = b.bar;
        __builtin_amdgcn_s_waitcnt(0);
        unsigned nloc = b.st[0], nx = b.st[1];
        if (nloc == 0u) { xcd_barrier_complete(bar, b.x, nloc, nx); b.st[0] = nloc; b.st[1] = nx; }
        const unsigned old = xb_add(&bar[XB_XSUB(b.x)], 1u);
        const unsigned gen = old / nloc;
        if (old + 1u == (gen + 1u) * nloc) {
            __builtin_amdgcn_fence(__ATOMIC_RELEASE, "agent");
            asm volatile("s_waitcnt vmcnt(0)" ::: "memory");
            const unsigned og = xb_add(&bar[XB_TOP], 1u);
            const unsigned tg = og / nx;
            if (og + 1u == (tg + 1u) * nx) xb_add(&bar[XB_TOPGEN], 1u);
            else XB_SPIN(xb_ld(&bar[XB_TOPGEN]) == tg, bar);
            __builtin_amdgcn_fence(__ATOMIC_ACQUIRE, "agent");
            xb_add(&bar[XB_XGEN(b.x)], 1u);
            asm volatile("s_waitcnt vmcnt(0)" ::: "memory");
        } else {
            XB_SPIN(xb_ld(&bar[XB_XGEN(b.x)]) == gen, bar);
            __builtin_amdgcn_fence(__ATOMIC_ACQUIRE, "agent");
            asm volatile("s_waitcnt vmcnt(0)" ::: "memory");
        }
    }
    __syncthreads();
}

constexpr int CW_HAND = 32768;
__device__ __forceinline__ void hand_signal(unsigned* cnt) {
    asm volatile("s_waitcnt vmcnt(0)" ::: "memory");
    __syncthreads();
    if (threadIdx.x == 0) { __builtin_amdgcn_fence(__ATOMIC_RELEASE, "agent"); asm volatile("s_waitcnt vmcnt(0)" ::: "memory");
        __hip_atomic_fetch_add(cnt, 1u, __ATOMIC_RELAXED, __HIP_MEMORY_SCOPE_AGENT); }
}
__device__ __forceinline__ void hand_wait(unsigned* cnt, unsigned need) {
    if (threadIdx.x == 0) { unsigned sp = 0;
        while (__hip_atomic_load(cnt, __ATOMIC_RELAXED, __HIP_MEMORY_SCOPE_AGENT) < need) { __builtin_amdgcn_s_sleep(2); if (++sp > (1u << 24)) break; }
        __builtin_amdgcn_fence(__ATOMIC_ACQUIRE, "agent"); asm volatile("s_waitcnt vmcnt(0)" ::: "memory"); }
    __syncthreads();
}

constexpr int LDS_BYTES = 147456;
struct Params {
    const float* in[22]; const int* page_table; float* out; unsigned char* ws; int pad0, pad1;
};
struct Frame {
    LAS unsigned char* lds;
    int tid, lane, wave, G, c;
    const Params* p;
};

__device__ __forceinline__ void transpose_item(const float* W, int ldw, int k0, int n_src0, int n_valid, bf16_t* WT, int ldd, int row_base, int row_stride, LAS float* scr, int lane) {
    const int n4 = (lane & 7) * 4;
    f32x4 v[8];
#pragma unroll
    for (int i = 0; i < 8; ++i) { const int kk = 8 * i + (lane >> 3); v[i] = (n_src0 + n4 < n_valid) ? __builtin_nontemporal_load((const f32x4*)(W + (size_t)(k0 + kk) * ldw + n_src0 + n4)) : (f32x4){0.f, 0.f, 0.f, 0.f}; }
#pragma unroll
    for (int i = 0; i < 8; ++i) { LAS float* d = scr + (8 * i + (lane >> 3)) * 33 + n4; d[0] = v[i].x; d[1] = v[i].y; d[2] = v[i].z; d[3] = v[i].w; }
    LDS_WAIT(); asm volatile("" ::: "memory");
    const int c = lane & 7;
#pragma unroll
    for (int j = 0; j < 4; ++j) { const int n = (lane >> 3) + 8 * j; const LAS float* s = scr + (8 * c) * 33 + n;
        u32x4 o; o.x = pk2(s[0 * 33], s[1 * 33]); o.y = pk2(s[2 * 33], s[3 * 33]); o.z = pk2(s[4 * 33], s[5 * 33]); o.w = pk2(s[6 * 33], s[7 * 33]);
        if (n_src0 + n < n_valid) *(u32x4*)(WT + (size_t)(row_base + n * row_stride) * ldd + k0 + 8 * c) = o; }
    LDS_WAIT(); asm volatile("" ::: "memory");
}
__device__ __forceinline__ void rms_row_to_bf16(const float* xrow, const float* w, bf16_t* orow, int lane) {
    const f32x4* xr = (const f32x4*)xrow + lane; const f32x4* wr = (const f32x4*)w + lane;
    f32x4 v[4]; float s = 0.f;
#pragma unroll
    for (int j = 0; j < 4; ++j) { v[j] = xr[64 * j]; s += (v[j].x * v[j].x + v[j].y * v[j].y) + (v[j].z * v[j].z + v[j].w * v[j].w); }
    const float rs = rsqrtf(wave_sum(s) * (1.f / DM) + RMS_EPS);
    u32x2* o8 = (u32x2*)orow + lane;
#pragma unroll
    for (int j = 0; j < 4; ++j) { const f32x4 g = wr[64 * j]; u32x2 o; o.x = pk2(v[j].x * rs * g.x, v[j].y * rs * g.y); o.y = pk2(v[j].z * rs * g.z, v[j].w * rs * g.w); o8[64 * j] = o; }
}

__device__ __forceinline__ void p0_prologue(Frame& F) {
    const Params& P = *F.p;
    unsigned char* ws = P.ws;
    LAS float* scr = (LAS float*)(F.lds + F.wave * 16384);
    const int gw = F.c * NWAVES + F.wave, NGW = F.G * NWAVES;
    const int gt = F.c * NTHREADS + F.tid, NGT = F.G * NTHREADS;
    constexpr int I_IN0 = 16 * 22, I_ROPE = 6 * 16, I_WO = 16 * 32, I_F1 = 16 * 176, I_F2 = 44 * 32, I_DIN = 16 * 129, I_DO = 16 * 32;
    constexpr int NITEMS = I_IN0 + I_ROPE + I_WO + 2 * I_F1 + 2 * I_F2 + I_DIN + I_DO;
    for (int it = gw; it < NITEMS; it += NGW) {
        int r = it;
        if (r < I_IN0) { const int kb = r / 22, nb = r % 22; transpose_item(P.in[7], NIN0, 64 * kb, 32 * nb, NIN0, (bf16_t*)(ws + WS_WT_IN0), 1024, 32 * nb, 1, scr, F.lane); continue; } r -= I_IN0;
        if (r < I_ROPE) { const int kb = r / 16, hs = r % 16, h = hs >> 1, s = hs & 1;
            transpose_item(P.in[10], 1536, 64 * kb, h * 192 + 128 + 32 * s, 1536, (bf16_t*)(ws + WS_WT_Q), 512, 2048 + h * 64 + s, 2, scr, F.lane); continue; } r -= I_ROPE;
        if (r < I_WO) { const int kb = r / 32, nb = r % 32; transpose_item(P.in[13], 1024, 64 * kb, 32 * nb, 1024, (bf16_t*)(ws + WS_WOT), 1024, 32 * nb, 1, scr, F.lane); continue; } r -= I_WO;
        if (r < 2 * I_F1) { const int l = r / I_F1, q = r % I_F1, kb = q / 176, nb = q % 176; const int n0 = 32 * nb; const int nn = n0 < DFF ? n0 : n0 - DFF;
            const int row = 256 * (nn / 128) + (n0 < DFF ? 0 : 128) + (nn % 128);
            transpose_item(P.in[20] + (size_t)l * 1024 * 5632, 5632, 64 * kb, n0, 5632, (bf16_t*)(ws + WS_WT_F1) + (size_t)l * 5632 * 1024, 1024, row, 1, scr, F.lane); continue; } r -= 2 * I_F1;
        if (r < 2 * I_F2) { const int l = r / I_F2, q = r % I_F2, kb = q / 32, nb = q % 32;
            transpose_item(P.in[21] + (size_t)l * DFF * 1024, 1024, 64 * kb, 32 * nb, 1024, (bf16_t*)(ws + WS_WT_F2) + (size_t)l * 1024 * DFF, DFF, 32 * nb, 1, scr, F.lane); continue; } r -= 2 * I_F2;
        if (r < I_DIN) { const int kb = r / 129, nb = r % 129; transpose_item(P.in[14], DN_N, 64 * kb, 32 * nb, DN_N, (bf16_t*)(ws + WS_WT_DIN), 1024, 32 * nb, 1, scr, F.lane); continue; } r -= I_DIN;
        { const int kb = r / 32, nb = r % 32; transpose_item(P.in[19], 1024, 64 * kb, 32 * nb, 1024, (bf16_t*)(ws + WS_WT_DO), 1024, 32 * nb, 1, scr, F.lane); }
    }
    {
        constexpr int N_BD = 2048 * 128, N_UQ = 512 * 128, N_PADIN = 64 * 128, N_PADD = (DN_NP - DN_N) * 128;
        for (int it = gt; it < 2 * N_BD + N_UQ + N_PADIN + N_PADD; it += NGT) {
            int r = it; u32x4 o = {0u, 0u, 0u, 0u}; bf16_t* dst;
            if (r < 2 * N_BD) { const int which = r / N_BD, q = r % N_BD, row = q >> 7, c8 = (q & 127) * 8, h = row >> 8, rr = row & 255;
                const float* src = (which ? P.in[11] : P.in[12]) + ((size_t)h * 256 + rr) * 128;
                if ((c8 >> 7) == h) { const f32x4 a = *(const f32x4*)(src + (c8 & 127)), b = *(const f32x4*)(src + (c8 & 127) + 4); o.x = pk2(a.x, a.y); o.y = pk2(a.z, a.w); o.z = pk2(b.x, b.y); o.w = pk2(b.z, b.w); }
                dst = (bf16_t*)(ws + (which ? WS_BD_UK : WS_BD_UV)) + (size_t)row * 1024 + c8;
            } else if ((r -= 2 * N_BD) < N_UQ) { const int row = r >> 7, c8 = (r & 127) * 8, h = c8 >> 7, n = c8 & 127;
                if (row < 384) { const float* src = P.in[10] + (size_t)row * 1536 + h * 192 + n; const f32x4 a = *(const f32x4*)src, b = *(const f32x4*)(src + 4); o.x = pk2(a.x, a.y); o.y = pk2(a.z, a.w); o.z = pk2(b.x, b.y); o.w = pk2(b.z, b.w); }
                dst = (bf16_t*)(ws + WS_UQN) + (size_t)row * 1024 + c8;
            } else if ((r -= N_UQ) < N_PADIN) { dst = (bf16_t*)(ws + WS_WT_IN0) + (size_t)(NIN0 + (r >> 7)) * 1024 + (r & 127) * 8;
            } else { r -= N_PADIN; dst = (bf16_t*)(ws + WS_WT_DIN) + (size_t)(DN_N + (r >> 7)) * 1024 + (r & 127) * 8; }
            *(u32x4*)dst = o;
        }
    }
    for (int it = gt; it < 2052 * 32; it += NGT) { const int pi = it >> 5, i = it & 31; const float pos = (float)(pi < SEQ ? pi : PAST + (pi - SEQ));
        const float freq = exp2f(-(float)i * (13.287712379549449f / 32.0f)); const float ang = pos * freq;
        ((f32x2*)(ws + WS_ROPE))[it] = (f32x2){cosf(ang), sinf(ang)}; }
    for (int m = gw; m < MT; m += NGW) {
        bf16_t* orow = (bf16_t*)(ws + WS_U) + (size_t)m * DM;
        if (m < MV) { const float* xrow = m < MP ? P.in[0] + (size_t)m * DM : P.in[1] + (size_t)(m - MP) * DM; rms_row_to_bf16(xrow, P.in[6], orow, F.lane); }
        else { u32x4 z = {0u, 0u, 0u, 0u}; ((u32x4*)orow)[F.lane] = z; ((u32x4*)orow)[F.lane + 64] = z; }
    }
}

__device__ __forceinline__ void m2_rows(Frame& F) {
    const Params& P = *F.p; unsigned char* ws = P.ws; OPAQUE_WS(ws);
    const int gw = F.c * NWAVES + F.wave, NGW = F.G * NWAVES, lane = F.lane;
    const float* gq = P.in[8]; const float* gkv = P.in[9];
    const f32x2* rope = (const f32x2*)(ws + WS_ROPE);
    for (int m = gw; m < MV; m += NGW) {
        const float* a = (const float*)(ws + WS_A0) + (size_t)m * NIN0P;
        float v[11];
#pragma unroll
        for (int j = 0; j < 11; ++j) v[j] = __builtin_nontemporal_load(a + lane + 64 * j);
        float sq = 0.f, sk = 0.f;
#pragma unroll
        for (int j = 0; j < 6; ++j) sq += v[j] * v[j];
#pragma unroll
        for (int j = 6; j < 10; ++j) sk += v[j] * v[j];
        const float rq = rsqrtf(wave_sum(sq) * (1.f / Q_LORA) + RMS_EPS), rk = rsqrtf(wave_sum(sk) * (1.f / KV_LORA) + RMS_EPS);
        bf16_t* cq = (bf16_t*)(ws + WS_CQ) + (size_t)m * Q_LORA;
#pragma unroll
        for (int j = 0; j < 6; ++j) cq[lane + 64 * j] = (bf16_t)f2bf(v[j] * rq * gq[lane + 64 * j]);
        float* orow = P.out + O_ROWS + (size_t)m * MLA_ROW; bf16_t* rb = (bf16_t*)(ws + WS_ROWSB) + (size_t)m * MLA_ROW;
#pragma unroll
        for (int j = 0; j < 4; ++j) { const float y = v[6 + j] * rk * gkv[lane + 64 * j]; __builtin_nontemporal_store(y, orow + lane + 64 * j); rb[lane + 64 * j] = (bf16_t)f2bf(y); }
        const int pidx = m < MP ? (m & (SEQ - 1)) : (SEQ + ((m - MP) & 3));
        const int i = lane & 31; const f32x2 cs = rope[pidx * 32 + i];
        const float other = __shfl_xor(v[10], 32);
        const float y = lane < 32 ? v[10] * cs.x - other * cs.y : v[10] * cs.x + other * cs.y;
        __builtin_nontemporal_store(y, orow + 256 + lane); rb[256 + lane] = (bf16_t)f2bf(y);
    }
}


#define LDS_BARRIER() do { asm volatile("s_waitcnt lgkmcnt(0)" ::: "memory"); __builtin_amdgcn_s_barrier(); asm volatile("" ::: "memory"); } while (0)
namespace attn {
typedef short v4i16_t __attribute__((ext_vector_type(4)));
constexpr int TILE_BYTES = 64 * 640;
__device__ __forceinline__ int koff(int row, int ch) { return 5120 * (row >> 3) + 512 * (ch >> 2) + 64 * (row & 7) + 16 * ((ch & 3) ^ ((row >> 2) & 3)); }

__device__ __forceinline__ float hmax16(float x) { const unsigned u = __builtin_bit_cast(unsigned, x); auto b = __builtin_amdgcn_permlane16_swap(u, u, false, false); return fmaxf(__builtin_bit_cast(float, b[0]), __builtin_bit_cast(float, b[1])); }
__device__ __forceinline__ float hmax32(float x) { const unsigned u = __builtin_bit_cast(unsigned, x); auto b = __builtin_amdgcn_permlane32_swap(u, u, false, false); return fmaxf(__builtin_bit_cast(float, b[0]), __builtin_bit_cast(float, b[1])); }
struct State { f32x4 o[16]; float m, l; };
struct Addr { int kb0, kb1, tb00, tb01, tb10, tb11; };
__device__ __forceinline__ Addr make_addr(int lane) {
    const int g = lane >> 4, rho = lane & 15, q4 = rho >> 2, p4 = lane & 3; Addr a;
    a.kb0 = 5120 * q4 + 64 * (rho & 3) + 16 * (g ^ (2 * (q4 & 1)));  a.kb1 = a.kb0 ^ 16;
    const int t0 = 5120 * g + 64 * q4 + 8 * (p4 & 1) + 32 * (g & 1) + 16 * (p4 >> 1);
    a.tb00 = t0; a.tb01 = t0 ^ 16; a.tb10 = t0 ^ 32; a.tb11 = t0 ^ 48;
    return a;
}
__device__ __forceinline__ void pv_load(bf16x8 (&vf)[8], const LAS unsigned char* buf, const Addr& A, int i) {
#pragma unroll
    for (int c = 0; c < 4; ++c) { const int cb = 4 * i + c;
        const LAS unsigned char* v0 = buf + ((cb & 1) ? A.tb10 : A.tb00) + 512 * (cb >> 1);
        const LAS unsigned char* v1 = buf + ((cb & 1) ? A.tb11 : A.tb01) + 512 * (cb >> 1) + 256;
#pragma unroll
        for (int ks = 0; ks < 2; ++ks) {
            const v4i16_t t0 = __builtin_amdgcn_ds_read_tr16_b64_v4i16((LAS v4i16_t*)(v0 + 20480 * ks));
            const v4i16_t t1 = __builtin_amdgcn_ds_read_tr16_b64_v4i16((LAS v4i16_t*)(v1 + 20480 * ks));
            vf[2 * c + ks] = __builtin_shufflevector(t0, t1, 0, 1, 2, 3, 4, 5, 6, 7); } }
}
__device__ __forceinline__ void pv_mma(State& st, const bf16x8 (&vf)[8], const bf16x8 (&pf)[2], int i) {
#pragma unroll
    for (int c = 0; c < 4; ++c)
#pragma unroll
        for (int ks = 0; ks < 2; ++ks) st.o[4 * i + c] = __builtin_amdgcn_mfma_f32_16x16x32_bf16(vf[2 * c + ks], pf[ks], st.o[4 * i + c], 0, 0, 0);
}
__device__ __forceinline__ void tile_scores(const LAS unsigned char* buf, const Addr& A, const bf16x8 (&qf)[10], State& st, int limit, bool need_mask, int lane, bf16x8 (&pf)[2], bf16x8 (&vf0)[8]) {
    const int g = lane >> 4;
    f32x4 sacc[4];
    __builtin_amdgcn_s_setprio(1);
    bf16x8 kf[2][5];
#pragma unroll
    for (int b = 0; b < 4; ++b) sacc[b] = (f32x4){0.f, 0.f, 0.f, 0.f};
#pragma unroll
    for (int j = 0; j < 5; ++j) kf[0][j] = *(const LAS bf16x8*)(buf + A.kb0 + 512 * j);
#pragma unroll
    for (int i = 0; i < 8; ++i) {
        if (i + 1 < 8) { const int b1 = (i + 1) >> 1; const LAS unsigned char* kp = buf + ((b1 & 1) ? A.kb1 : A.kb0) + 20480 * (b1 >> 1) + 256 * (b1 & 1) + 2560 * ((i + 1) & 1);
#pragma unroll
            for (int j = 0; j < 5; ++j) kf[(i + 1) & 1][j] = *(const LAS bf16x8*)(kp + 512 * j); }
        __builtin_amdgcn_sched_barrier(0);
#pragma unroll
        for (int j = 0; j < 5; ++j) sacc[i >> 1] = __builtin_amdgcn_mfma_f32_16x16x32_bf16(kf[i & 1][j], qf[5 * (i & 1) + j], sacc[i >> 1], 0, 0, 0);
        __builtin_amdgcn_sched_barrier(0);
    }
    __builtin_amdgcn_s_setprio(0);
    if (need_mask) {
#pragma unroll
        for (int b = 0; b < 4; ++b)
#pragma unroll
            for (int r = 0; r < 4; ++r) { const int key = 32 * (b >> 1) + 8 * g + 4 * (b & 1) + r; sacc[b][r] = key > limit ? -1e30f : sacc[b][r]; }
    }
    float mx = fmaxf(fmaxf(fmaxf(sacc[0][0], sacc[0][1]), fmaxf(sacc[0][2], sacc[0][3])), fmaxf(fmaxf(sacc[1][0], sacc[1][1]), fmaxf(sacc[1][2], sacc[1][3])));
    mx = fmaxf(mx, fmaxf(fmaxf(fmaxf(sacc[2][0], sacc[2][1]), fmaxf(sacc[2][2], sacc[2][3])), fmaxf(fmaxf(sacc[3][0], sacc[3][1]), fmaxf(sacc[3][2], sacc[3][3]))));
    mx = hmax16(mx); mx = hmax32(mx);
    __builtin_amdgcn_sched_barrier(0);
    pv_load(vf0, buf, A, 0);
    __builtin_amdgcn_sched_barrier(0);
    if (!__all(mx - st.m <= 6.0f)) {
        const float mnew = fmaxf(st.m, mx), alpha = __builtin_amdgcn_exp2f(st.m - mnew); st.m = mnew;
        st.l *= alpha;
#pragma unroll
        for (int cb = 0; cb < 16; ++cb) st.o[cb] = st.o[cb] * alpha;
    }
    float ps = 0.f;
#pragma unroll
    for (int b = 0; b < 4; ++b)
#pragma unroll
        for (int r = 0; r < 4; ++r) { const float p = __builtin_amdgcn_exp2f(sacc[b][r] - st.m); sacc[b][r] = p; ps += p; }
    st.l += ps;
#pragma unroll
    for (int ks = 0; ks < 2; ++ks) { u32x4 w; w.x = cvt_pk_bf16(sacc[2 * ks][0], sacc[2 * ks][1]); w.y = cvt_pk_bf16(sacc[2 * ks][2], sacc[2 * ks][3]);
        w.z = cvt_pk_bf16(sacc[2 * ks + 1][0], sacc[2 * ks + 1][1]); w.w = cvt_pk_bf16(sacc[2 * ks + 1][2], sacc[2 * ks + 1][3]); pf[ks] = __builtin_bit_cast(bf16x8, w); }
}
__device__ __forceinline__ void tile_pv(const LAS unsigned char* buf, const Addr& A, State& st, const bf16x8 (&pf)[2], bf16x8 (&vf0)[8]) {
    bf16x8 vf1[8];
    __builtin_amdgcn_s_setprio(1);
    pv_load(vf1, buf, A, 1); __builtin_amdgcn_sched_barrier(0); pv_mma(st, vf0, pf, 0); __builtin_amdgcn_sched_barrier(0);
    pv_load(vf0, buf, A, 2); __builtin_amdgcn_sched_barrier(0); pv_mma(st, vf1, pf, 1); __builtin_amdgcn_sched_barrier(0);
    pv_load(vf1, buf, A, 3); __builtin_amdgcn_sched_barrier(0); pv_mma(st, vf0, pf, 2); __builtin_amdgcn_sched_barrier(0);
    pv_mma(st, vf1, pf, 3);
    __builtin_amdgcn_s_setprio(0);
}
__device__ __forceinline__ void load_q(bf16x8 (&qf)[10], const bf16_t* Q, int row, int h, int g) {
    const bf16_t* qr = Q + (size_t)row * NQ;
#pragma unroll
    for (int s = 0; s < 8; ++s) qf[s] = __builtin_nontemporal_load((const bf16x8*)(qr + h * 256 + 32 * s + 8 * g));
#pragma unroll
    for (int s = 0; s < 2; ++s) qf[8 + s] = __builtin_nontemporal_load((const bf16x8*)(qr + 2048 + h * 64 + 32 * s + 8 * g));
}
__device__ __forceinline__ void state_init(State& st) {
#pragma unroll
    for (int cb = 0; cb < 16; ++cb) st.o[cb] = (f32x4){0.f, 0.f, 0.f, 0.f};
    st.m = -1e30f; st.l = 0.f;
}
__device__ __forceinline__ int stage_lds_off(int tid) { const int row = tid >> 3; return 5120 * (row >> 3) + 64 * (row & 7) + 512 * ((tid & 7) >> 2) + 16 * ((tid & 3) ^ ((row >> 2) & 3)); }
__device__ __forceinline__ void prompt_unit(Frame& F, int b, int qb) {
    unsigned char* ws = F.p->ws; OPAQUE_WS(ws); int tid = F.tid; asm volatile("" : "+v"(tid));
    const int lane = tid & 63, h = F.wave, g = lane >> 4, qi = lane & 15;
    const int p0 = 16 * qb, nt = (p0 + 15) / 64 + 1;
    const unsigned char* rows = (const unsigned char*)((const bf16_t*)(ws + WS_ROWSB) + (size_t)b * SEQ * MLA_ROW) + (tid >> 3) * 640 + (tid & 7) * 16;
    const int soff = stage_lds_off(tid);
    bf16x8 qf[10]; load_q(qf, (const bf16_t*)(ws + WS_Q), b * SEQ + p0 + qi, h, g);
    State st; state_init(st); const Addr AD = make_addr(lane);
    u32x4 pre[3];
#pragma unroll
    for (int j = 0; j < 5; ++j) *(LAS u32x4*)(F.lds + soff + 1024 * j) = *(const u32x4*)(rows + 128 * j);
    LDS_BARRIER();
    for (int kt = 0; kt < nt; ++kt) {
        const LAS unsigned char* buf = F.lds + (kt & 1) * TILE_BYTES; LAS unsigned char* nbuf = F.lds + ((kt + 1) & 1) * TILE_BYTES + soff;
        const bool more = kt + 1 < nt; const unsigned char* src = rows + (size_t)(more ? kt + 1 : kt) * (64 * 640);
        bf16x8 pf[2], vf0[8];
#pragma unroll
        for (int j = 0; j < 3; ++j) pre[j] = *(const u32x4*)(src + 128 * j);
        __builtin_amdgcn_sched_barrier(0);
        tile_scores(buf, AD, qf, st, p0 + qi - 64 * kt, 64 * kt + 63 > p0, lane, pf, vf0);
        if (more) {
#pragma unroll
            for (int j = 0; j < 3; ++j) *(LAS u32x4*)(nbuf + 1024 * j) = pre[j];
        }
#pragma unroll
        for (int j = 0; j < 2; ++j) pre[j] = *(const u32x4*)(src + 128 * (3 + j));
        __builtin_amdgcn_sched_barrier(0);
        tile_pv(buf, AD, st, pf, vf0);
        if (more) {
#pragma unroll
            for (int j = 0; j < 2; ++j) *(LAS u32x4*)(nbuf + 1024 * (3 + j)) = pre[j];
        }
        LDS_BARRIER();
    }
    float l = st.l; l += __shfl_xor(l, 16); l += __shfl_xor(l, 32);
    const float inv = 1.f / l;
    bf16_t* orow = (bf16_t*)(ws + WS_OL) + (size_t)(b * SEQ + p0 + qi) * 2048 + h * 256 + 4 * g;
#pragma unroll
    for (int cb = 0; cb < 16; ++cb) { u32x2 w; w.x = cvt_pk_bf16(st.o[cb][0] * inv, st.o[cb][1] * inv); w.y = cvt_pk_bf16(st.o[cb][2] * inv, st.o[cb][3] * inv); *(u32x2*)(orow + 16 * cb) = w; }
}
__device__ __forceinline__ void cache_load10(f32x4 (&pre)[10], const float* src) {
#pragma unroll
    for (int k = 0; k < 10; ++k) pre[k] = __builtin_nontemporal_load((const f32x4*)(src + 32 * k));
}
__device__ __forceinline__ void cache_store10(const f32x4 (&pre)[10], LAS unsigned char* dst) {
#pragma unroll
    for (int k = 0; k < 10; ++k) { u32x2 w; w.x = cvt_pk_bf16(pre[k][0], pre[k][1]); w.y = cvt_pk_bf16(pre[k][2], pre[k][3]); *(LAS u32x2*)(dst + 512 * k) = w; }
}
template <int J0, int J1>
__device__ __forceinline__ void load_cache_part(f32x4 (&pre)[10], const float* src) {
#pragma unroll
    for (int j = J0; j < J1; ++j) { pre[2 * (j - J0)] = *(const f32x4*)(src + 64 * j); pre[2 * (j - J0) + 1] = *(const f32x4*)(src + 64 * j + 4); }
}
template <int J0, int J1>
__device__ __forceinline__ void store_cache_part(const f32x4 (&pre)[10], LAS unsigned char* dst) {
#pragma unroll
    for (int j = J0; j < J1; ++j) { const int k = 2 * (j - J0); u32x4 w; w.x = cvt_pk_bf16(pre[k][0], pre[k][1]); w.y = cvt_pk_bf16(pre[k][2], pre[k][3]);
        w.z = cvt_pk_bf16(pre[k + 1][0], pre[k + 1][1]); w.w = cvt_pk_bf16(pre[k + 1][2], pre[k + 1][3]); *(LAS u32x4*)(dst + 1024 * j) = w; }
}
__device__ __forceinline__ const float* cache_tile_src(const float* cache, int pgv, int kt) {
    const int page = __builtin_amdgcn_readlane(pgv, kt >> 1);
    return cache + ((size_t)page * PAGE + (kt & 1) * 64) * MLA_ROW;
}
__device__ __forceinline__ void samp_tile(const LAS unsigned char* buf, const Addr& A, const bf16x8 (&qf)[10], State& st, int kb, int limit, bool need_mask, int lane) {
    const int g = lane >> 4;
    f32x4 sacc = {0.f, 0.f, 0.f, 0.f};
    const LAS unsigned char* kp = buf + ((kb & 1) ? A.kb1 : A.kb0) + 20480 * (kb >> 1) + 256 * (kb & 1);
#pragma unroll
    for (int s = 0; s < 10; ++s) { const bf16x8 kf = *(const LAS bf16x8*)(kp + 512 * s); sacc = __builtin_amdgcn_mfma_f32_16x16x32_bf16(kf, qf[s], sacc, 0, 0, 0); }
    if (need_mask) {
#pragma unroll
        for (int r = 0; r < 4; ++r) { const int key = 32 * (kb >> 1) + 8 * g + 4 * (kb & 1) + r; sacc[r] = key > limit ? -1e30f : sacc[r]; }
    }
    float mx = fmaxf(fmaxf(sacc[0], sacc[1]), fmaxf(sacc[2], sacc[3]));
    mx = hmax16(mx); mx = hmax32(mx);
    if (!__all(mx - st.m <= 6.0f)) {
        const float mnew = fmaxf(st.m, mx), alpha = __builtin_amdgcn_exp2f(st.m - mnew); st.m = mnew; st.l *= alpha;
#pragma unroll
        for (int cb = 0; cb < 16; ++cb) st.o[cb] = st.o[cb] * alpha;
    }
    float p[4];
#pragma unroll
    for (int r = 0; r < 4; ++r) p[r] = __builtin_amdgcn_exp2f(sacc[r] - st.m);
    st.l += (p[0] + p[1]) + (p[2] + p[3]);
    const unsigned w0 = cvt_pk_bf16(p[0], p[1]), w1 = cvt_pk_bf16(p[2], p[3]);
    const u32x4 pw = (kb & 1) ? (u32x4){0u, 0u, w0, w1} : (u32x4){w0, w1, 0u, 0u};
    const bf16x8 pf = __builtin_bit_cast(bf16x8, pw);
#pragma unroll
    for (int cb = 0; cb < 16; ++cb) {
        const LAS unsigned char* vp = buf + ((cb & 1) ? ((kb & 1) ? A.tb11 : A.tb10) : ((kb & 1) ? A.tb01 : A.tb00)) + 512 * (cb >> 1) + 256 * (kb & 1) + 20480 * (kb >> 1);
        const v4i16_t t0 = __builtin_amdgcn_ds_read_tr16_b64_v4i16((LAS v4i16_t*)vp);
        const bf16x8 vf = __builtin_shufflevector(t0, t0, 0, 1, 2, 3, 4, 5, 6, 7);
        st.o[cb] = __builtin_amdgcn_mfma_f32_16x16x32_bf16(vf, pf, st.o[cb], 0, 0, 0);
    }
}
__device__ __forceinline__ void sample_unit(Frame& F, int sb, int split) {
    unsigned char* ws = F.p->ws; OPAQUE_WS(ws); int tid = F.tid; asm volatile("" : "+v"(tid));
    const int lane = tid & 63, w = F.wave, g = lane >> 4, qi = lane & 15;
    const float* cache = F.p->in[2]; const int* pt = F.p->page_table;
    const int hg = w & 1, kb = w >> 1, head = 4 * hg + (qi >> 2), tq = qi & 3;
    bf16x8 qf[10]; load_q(qf, (const bf16_t*)(ws + WS_Q), MP + sb * DECS + tq, head, g);
    State st; state_init(st); const Addr AD = make_addr(lane);
    f32x4 pre[10];
    const int soff = stage_lds_off(tid);
    const int crow = tid >> 3, cq = tid & 7, goff = crow * MLA_ROW + 4 * cq, coff = 5120 * (crow >> 3) + 64 * (crow & 7) + 16 * ((cq >> 1) ^ ((crow >> 2) & 3)) + 8 * (cq & 1);
    const int pgv = pt[sb * NPAGES + 16 * split + (lane & 15)];
    { const float* src = cache_tile_src(cache, pgv, 0) + goff;
      cache_load10(pre, src); cache_store10(pre, F.lds + coff);
      cache_load10(pre, cache_tile_src(cache, pgv, 1) + goff); }
    __builtin_amdgcn_sched_barrier(0);
    LDS_BARRIER();
    constexpr int NT = 32;
    for (int kt = 0; kt < NT; ++kt) {
        const LAS unsigned char* buf = F.lds + (kt & 1) * TILE_BYTES; LAS unsigned char* nbuf = F.lds + ((kt + 1) & 1) * TILE_BYTES + coff;
        samp_tile(buf, AD, qf, st, kb, 63, false, lane);
        __builtin_amdgcn_sched_barrier(0);
        if (kt + 1 < NT) cache_store10(pre, nbuf);
        if (kt + 2 < NT) cache_load10(pre, cache_tile_src(cache, pgv, kt + 2) + goff);
        __builtin_amdgcn_sched_barrier(0);
        LDS_BARRIER();
    }
    if (split == 7) {
        const bf16_t* rows = (const bf16_t*)(ws + WS_ROWSB) + (size_t)(MP + sb * DECS) * MLA_ROW;
        unsigned zr = 0u; asm volatile("" : "+v"(zr));
#pragma unroll
        for (int j = 0; j < 5; ++j) { const int row = tid >> 3; u32x4 wv = {zr, zr, zr, zr}; if (row < 4) wv = *(const u32x4*)(rows + (size_t)row * MLA_ROW + ((tid & 7) + 8 * j) * 8); *(LAS u32x4*)(F.lds + soff + 1024 * j) = wv; }
        __syncthreads();
        if (kb == 0) samp_tile(F.lds, AD, qf, st, 0, tq, true, lane);
        __syncthreads();
    }
    float l = st.l; l += __shfl_xor(l, 16); l += __shfl_xor(l, 32);
    LAS float* OB = (LAS float*)F.lds; LAS float* MLB = (LAS float*)(F.lds + 131072);
#pragma unroll
    for (int cb = 0; cb < 16; ++cb) *(LAS f32x4*)(OB + (w * 16 + qi) * 256 + 16 * cb + 4 * g) = st.o[cb];
    if (g == 0) { MLB[(w * 16 + qi) * 2] = st.m; MLB[(w * 16 + qi) * 2 + 1] = l; }
    __syncthreads();
    {   const int hg2 = tid >> 8, q = (tid >> 4) & 15, c0 = (tid & 15) * 16;
        float ms[4], ls[4], mt = -1e30f;
#pragma unroll
        for (int k = 0; k < 4; ++k) { const int ww = 2 * k + hg2; ms[k] = MLB[(ww * 16 + q) * 2]; ls[k] = MLB[(ww * 16 + q) * 2 + 1]; mt = fmaxf(mt, ms[k]); }
        float L = 0.f; f32x4 acc[4];
#pragma unroll
        for (int j = 0; j < 4; ++j) acc[j] = (f32x4){0.f, 0.f, 0.f, 0.f};
#pragma unroll
        for (int k = 0; k < 4; ++k) { const int ww = 2 * k + hg2; const float wt = __builtin_amdgcn_exp2f(ms[k] - mt); L += wt * ls[k];
#pragma unroll
            for (int j = 0; j < 4; ++j) { const f32x4 v = *(const LAS f32x4*)(OB + (ww * 16 + q) * 256 + c0 + 4 * j); acc[j] = acc[j] + v * wt; } }
        const int hd = 4 * hg2 + (q >> 2), t = q & 3;
        float* po = (float*)(ws + WS_PART) + ((((size_t)sb * 8 + split) * 8 + hd) * 4 + t) * 256 + c0;
#pragma unroll
        for (int j = 0; j < 4; ++j) *(f32x4*)(po + 4 * j) = acc[j];
        if (c0 == 0) { float* ml = (float*)(ws + WS_ML) + ((((size_t)sb * 8 + split) * 8 + hd) * 4 + t) * 2; ml[0] = mt; ml[1] = L; }
    }
    __syncthreads();
}
__device__ __forceinline__ void sample_combine(Frame& F, int sb) {
    unsigned char* ws = F.p->ws; const int tid = F.tid;
    {
        const int row = tid >> 4, c0 = (tid & 15) * 16, hh = row >> 2, t = row & 3;
        float ms[8], ls[8], mt = -1e30f;
#pragma unroll
        for (int s = 0; s < 8; ++s) { const float* ml = (const float*)(ws + WS_ML) + ((((size_t)sb * 8 + s) * 8 + hh) * 4 + t) * 2;
            ms[s] = ml[0]; ls[s] = ml[1]; mt = fmaxf(mt, ms[s]); }
        float L = 0.f; f32x4 acc[4];
#pragma unroll
        for (int j = 0; j < 4; ++j) acc[j] = (f32x4){0.f, 0.f, 0.f, 0.f};
#pragma unroll
        for (int s = 0; s < 8; ++s) { const float w = __builtin_amdgcn_exp2f(ms[s] - mt); L += w * ls[s];
            const float* po = (const float*)(ws + WS_PART) + ((((size_t)sb * 8 + s) * 8 + hh) * 4 + t) * 256 + c0;
#pragma unroll
            for (int j = 0; j < 4; ++j) { const f32x4 v = *(const f32x4*)(po + 4 * j); acc[j] = acc[j] + v * w; } }
        const float inv = 1.f / L;
        bf16_t* orow = (bf16_t*)(ws + WS_OL) + (size_t)(MP + sb * DECS + t) * 2048 + hh * 256 + c0;
#pragma unroll
        for (int j = 0; j < 2; ++j) { u32x4 w; w.x = cvt_pk_bf16(acc[2 * j][0] * inv, acc[2 * j][1] * inv); w.y = cvt_pk_bf16(acc[2 * j][2] * inv, acc[2 * j][3] * inv);
            w.z = cvt_pk_bf16(acc[2 * j + 1][0] * inv, acc[2 * j + 1][1] * inv); w.w = cvt_pk_bf16(acc[2 * j + 1][2] * inv, acc[2 * j + 1][3] * inv); *(u32x4*)(orow + 8 * j) = w; }
    }
}
__device__ __forceinline__ void phase(Frame& F) {
    const int slot = (F.c >> 3) % 3; int done = 0;
    if (slot == 0) { for (int S = F.c; S < DECB * 8; S += F.G) sample_unit(F, S >> 3, S & 7); done = 1; }
    int np = 0;
    for (int L = F.c; L < 512; L += F.G) {
        const int b = L % 8, j = L / 8;
        prompt_unit(F, b, j); prompt_unit(F, b, 127 - j); ++np;
        if (!done && slot == 1 && np == 1) { for (int S = F.c; S < DECB * 8; S += F.G) sample_unit(F, S >> 3, S & 7); done = 1; }
    }
    if (!done) for (int S = F.c; S < DECB * 8; S += F.G) sample_unit(F, S >> 3, S & 7);
}
}


__device__ __forceinline__ void unpack8(const u32x4 v, float (&o)[8]) {
#pragma unroll
    for (int c = 0; c < 4; ++c) { o[2 * c] = __builtin_bit_cast(float, v[c] << 16); o[2 * c + 1] = __builtin_bit_cast(float, v[c] & 0xffff0000u); }
}
template <int R>
__device__ __forceinline__ void rowpass_rows(const Params& P, const int (&mrow)[R], bool first, bool last, const float* wa, const float* wb, int nslab, int lane) {
    unsigned char* ws = P.ws;
    float v[R][2][8], hv[R][2][8];
#pragma unroll
    for (int r = 0; r < R; ++r) { const int m = mrow[r];
        if (m < MP) { const u32x4* mr = (const u32x4*)((const bf16_t*)(ws + WS_MIX) + (size_t)m * DM) + lane; unpack8(__builtin_nontemporal_load(mr), v[r][0]); unpack8(__builtin_nontemporal_load(mr + 64), v[r][1]); }
        else {
#pragma unroll
            for (int j = 0; j < 2; ++j)
#pragma unroll
                for (int i = 0; i < 8; ++i) v[r][j][i] = 0.f;
            for (int z = 0; z < nslab; ++z) { const f32x4* mr = (const f32x4*)((const float*)(ws + WS_SLAB) + ((size_t)z * 128 + (m - MP)) * DM) + 2 * lane;
#pragma unroll
                for (int j = 0; j < 2; ++j) { const f32x4 a = mr[128 * j], b = mr[128 * j + 1]; v[r][j][0] += a.x; v[r][j][1] += a.y; v[r][j][2] += a.z; v[r][j][3] += a.w; v[r][j][4] += b.x; v[r][j][5] += b.y; v[r][j][6] += b.z; v[r][j][7] += b.w; } } }
        if (first) { const f32x4* hr = (const f32x4*)(m < MP ? P.in[0] + (size_t)m * DM : P.in[1] + (size_t)(m - MP) * DM) + 2 * lane;
#pragma unroll
            for (int j = 0; j < 2; ++j) { const f32x4 a = __builtin_nontemporal_load(hr + 128 * j), b = __builtin_nontemporal_load(hr + 128 * j + 1); hv[r][j][0] = a.x; hv[r][j][1] = a.y; hv[r][j][2] = a.z; hv[r][j][3] = a.w; hv[r][j][4] = b.x; hv[r][j][5] = b.y; hv[r][j][6] = b.z; hv[r][j][7] = b.w; }
        } else { const u32x4* hr = (const u32x4*)((const bf16_t*)(ws + WS_HB) + (size_t)m * DM) + lane; unpack8(__builtin_nontemporal_load(hr), hv[r][0]); unpack8(__builtin_nontemporal_load(hr + 64), hv[r][1]); } }
    float s[R];
#pragma unroll
    for (int r = 0; r < R; ++r) { s[r] = 0.f;
#pragma unroll
        for (int j = 0; j < 2; ++j)
#pragma unroll
            for (int i = 0; i < 8; ++i) s[r] += v[r][j][i] * v[r][j][i]; }
#pragma unroll
    for (int o = 1; o < 64; o <<= 1)
#pragma unroll
        for (int r = 0; r < R; ++r) s[r] += __shfl_xor(s[r], o);
    float s2[R];
#pragma unroll
    for (int r = 0; r < R; ++r) { const float rs = rsqrtf(s[r] * (1.f / DM) + RMS_EPS); s2[r] = 0.f;
#pragma unroll
        for (int j = 0; j < 2; ++j) { const f32x4 g0 = ((const f32x4*)wa)[2 * lane + 128 * j], g1 = ((const f32x4*)wa)[2 * lane + 128 * j + 1];
            const float g[8] = {g0.x, g0.y, g0.z, g0.w, g1.x, g1.y, g1.z, g1.w};
#pragma unroll
            for (int i = 0; i < 8; ++i) { v[r][j][i] = hv[r][j][i] + v[r][j][i] * rs * g[i]; s2[r] += v[r][j][i] * v[r][j][i]; } }
        const int m = mrow[r];
        if (last) { f32x4* yr = (f32x4*)(P.out + O_Y + (size_t)m * DM) + 2 * lane;
#pragma unroll
            for (int j = 0; j < 2; ++j) { __builtin_nontemporal_store((f32x4){v[r][j][0], v[r][j][1], v[r][j][2], v[r][j][3]}, yr + 128 * j); __builtin_nontemporal_store((f32x4){v[r][j][4], v[r][j][5], v[r][j][6], v[r][j][7]}, yr + 128 * j + 1); }
        } else { u32x4* hb = (u32x4*)((bf16_t*)(ws + WS_HB) + (size_t)m * DM) + lane;
#pragma unroll
            for (int j = 0; j < 2; ++j) hb[64 * j] = (u32x4){cvt_pk_bf16(v[r][j][0], v[r][j][1]), cvt_pk_bf16(v[r][j][2], v[r][j][3]), cvt_pk_bf16(v[r][j][4], v[r][j][5]), cvt_pk_bf16(v[r][j][6], v[r][j][7])}; } }
    if (wb) {
#pragma unroll
        for (int o = 1; o < 64; o <<= 1)
#pragma unroll
            for (int r = 0; r < R; ++r) s2[r] += __shfl_xor(s2[r], o);
#pragma unroll
        for (int r = 0; r < R; ++r) { const float r2 = rsqrtf(s2[r] * (1.f / DM) + RMS_EPS);
            u32x4* ur = (u32x4*)((bf16_t*)(ws + WS_U) + (size_t)mrow[r] * DM) + lane;
#pragma unroll
            for (int j = 0; j < 2; ++j) { const f32x4 g0 = ((const f32x4*)wb)[2 * lane + 128 * j], g1 = ((const f32x4*)wb)[2 * lane + 128 * j + 1];
                ur[64 * j] = (u32x4){cvt_pk_bf16(v[r][j][0] * r2 * g0.x, v[r][j][1] * r2 * g0.y), cvt_pk_bf16(v[r][j][2] * r2 * g0.z, v[r][j][3] * r2 * g0.w), cvt_pk_bf16(v[r][j][4] * r2 * g1.x, v[r][j][5] * r2 * g1.y), cvt_pk_bf16(v[r][j][6] * r2 * g1.z, v[r][j][7] * r2 * g1.w)}; } } }
}
__device__ __forceinline__ void rowpass(Frame& F, bool first, bool last, const float* wa, const float* wb, int nslab) {
    const Params& P = *F.p; int lane = F.lane; asm volatile("" : "+v"(lane));
    const int gw = F.c * NWAVES + F.wave, NGW = F.G * NWAVES;
    for (int p = gw; p < MP / 4; p += NGW) { const int mr[4] = {4 * p, 4 * p + 1, 4 * p + 2, 4 * p + 3}; rowpass_rows<4>(P, mr, first, last, wa, wb, nslab, lane); }
    for (int m = MP + gw; m < MV; m += NGW) { const int mr[1] = {m}; rowpass_rows<1>(P, mr, first, last, wa, wb, nslab, lane); }
}


namespace dn {
constexpr int SP = 132;
constexpr int L_S = 0;
constexpr int L_KB = 3 * 64 * SP * 4;
constexpr int L_QB = L_KB + 64 * 272;
constexpr int L_G = L_QB + 64 * 272;
constexpr int LP = 68;
constexpr int L_LB = L_G + 512;
constexpr int L_ST = L_KB;
static_assert(L_LB + 32 * 80 <= 131072 + 8192 && 256 * 80 <= 2 * 64 * 272, "dn LDS map");
__device__ __forceinline__ float silu(float x) { return x * __builtin_amdgcn_rcpf(1.f + __expf(-x)); }
__device__ __forceinline__ void gated_norm_row(unsigned char* ws, const float* gout, size_t row, int h, int lane) {
    const unsigned ov = *(const unsigned*)((const bf16_t*)(ws + WS_DO) + row * 1024 + h * 128 + 2 * lane);
    const unsigned zv = *(const unsigned*)((const bf16_t*)(ws + WS_PROJ) + row * DN_NP + 3072 + h * 128 + 2 * lane);
    const float o0 = __builtin_bit_cast(float, ov << 16), o1 = __builtin_bit_cast(float, ov & 0xffff0000u);
    const float z0 = __builtin_bit_cast(float, zv << 16), z1 = __builtin_bit_cast(float, zv & 0xffff0000u);
    const float rs = rsqrtf(wave_sum(o0 * o0 + o1 * o1) * (1.f / 128.f) + RMS_EPS);
    const f32x2 g = *(const f32x2*)(gout + 2 * lane);
    *(unsigned*)((bf16_t*)(ws + WS_DOG) + row * 1024 + h * 128 + 2 * lane) = cvt_pk_bf16(o0 * rs * g.x * silu(z0), o1 * rs * g.y * silu(z1));
}

struct ConvPre { u32x4 x[11]; bf16_t gb, ga; };
template <int I0, int I1, bool GATES>
__device__ __forceinline__ void conv_load_part(ConvPre& R, const bf16_t* proj, int b, int n, int tid, int h) {
    const int cgp = tid % 48, tg = tid / 48, part = cgp >> 4, d0 = (cgp & 15) * 8, col = part * 1024 + h * 128 + d0;
#pragma unroll
    for (int i = I0; i < I1; ++i) { int tok = n * CHUNK + 8 * tg - 3 + i; u32x4 v = {0u, 0u, 0u, 0u};
        int cl = col; if (tid >= 384) { tok = n * CHUNK; cl = h * 128; }
        if (tok >= 0) v = __builtin_nontemporal_load((const u32x4*)(proj + ((size_t)b * SEQ + tok) * DN_NP + cl));
        R.x[i] = v; }
    if (GATES) { const bf16_t* pr = proj + ((size_t)b * SEQ + n * CHUNK + (tid & 63)) * DN_NP + 4096 + h; R.gb = pr[0]; R.ga = pr[8]; }
}
__device__ __forceinline__ void conv_load(ConvPre& R, const bf16_t* proj, int b, int n, int tid, int h) { conv_load_part<0, 11, true>(R, proj, b, n, tid, h); }
__device__ __forceinline__ void chunk_phase(Frame& F) {
    const Params& P = *F.p; unsigned char* ws = P.ws; OPAQUE_WS(ws); int tid = F.tid; asm volatile("" : "+v"(tid));
    const int lane = tid & 63, wave = __builtin_amdgcn_readfirstlane(tid >> 6);
    LAS float* S = (LAS float*)(F.lds + L_S); LAS float* GB = (LAS float*)(F.lds + L_G);
    const bf16_t* proj = (const bf16_t*)(ws + WS_PROJ);
    const int h = F.c & 7; const int nun = (256 - (F.c >> 3) + (F.G >> 3) - 1) / (F.G >> 3);
    if ((F.G & 7) != 0 || nun <= 0) return;
    constexpr int L_CW = 131072 + 8192 + 256;
    LAS float* CW = (LAS float*)(F.lds + L_CW);
    for (int i = tid; i < 4 * 384; i += NTHREADS) { const int j = i / 384, cc = i % 384; CW[i] = P.in[15][j * DN_QKV + (cc >> 7) * 1024 + h * 128 + (cc & 127)]; }
    __syncthreads();
    ConvPre pre;
    { const int idx = F.c >> 3; conv_load(pre, proj, idx >> 5, idx & 31, tid, h); }
    const int tid0 = tid;
    for (int k = 0; k < nun; ++k) {
        int tid = tid0; asm volatile("" : "+v"(tid));
        const int lane = tid & 63;
        const int cgp = tid % 48, tg = tid / 48, part = cgp >> 4, d0c = (cgp & 15) * 8, col = part * 1024 + h * 128 + d0c;
        const int idx = (F.c >> 3) + k * (F.G >> 3), b = idx >> 5, n = idx & 31;
        const int t0 = n * CHUNK; const size_t row0 = (size_t)b * SEQ + t0; const int unit = (b * 8 + h) * 32 + n;
        if (tid < 384) {
#pragma unroll
            for (int c2 = 0; c2 < 4; ++c2) {
                float x0[11], x1[11], w0[4], w1[4];
#pragma unroll
                for (int i = 0; i < 11; ++i) { x0[i] = __builtin_bit_cast(float, pre.x[i][c2] << 16); x1[i] = __builtin_bit_cast(float, pre.x[i][c2] & 0xffff0000u); }
#pragma unroll
                for (int j = 0; j < 4; ++j) { const f32x2 wv = *(const LAS f32x2*)(CW + j * 384 + part * 128 + d0c + 2 * c2); w0[j] = wv.x; w1[j] = wv.y; }
#pragma unroll
                for (int tt = 0; tt < 8; ++tt) { float a0 = 0.f, a1 = 0.f;
#pragma unroll
                    for (int j = 0; j < 4; ++j) { a0 += w0[j] * x0[tt + j]; a1 += w1[j] * x1[tt + j]; }
                    *(LAS f32x2*)(S + (part * 64 + 8 * tg + tt) * SP + d0c + 2 * c2) = (f32x2){silu(a0), silu(a1)}; }
                if (n == 31 && tg == 7) {
#pragma unroll
                    for (int r = 0; r < 3; ++r) *(f32x2*)(P.out + O_CP + ((size_t)b * 3 + r) * DN_QKV + col + 2 * c2) = (f32x2){x0[8 + r], x1[8 + r]}; }
            }
        }
        if (wave == 7) {
            const float braw = bf2f(pre.gb), araw = bf2f(pre.ga);
            const float beta = 1.f / (1.f + __expf(-braw));
            const float xs = araw + P.in[17][h]; const float sp = xs > 20.f ? xs : log1pf(__expf(xs));
            float g = -__expf(P.in[16][h]) * sp;
#pragma unroll
            for (int o = 1; o < 64; o <<= 1) { const float t = __shfl_up(g, o); if (lane >= o) g += t; }
            GB[lane] = beta; GB[64 + lane] = g;
        }
        LDS_BARRIER();
        const int nidx = k + 1 < nun ? idx + (F.G >> 3) : idx;
        conv_load_part<0, 4, false>(pre, proj, nidx >> 5, nidx & 31, tid, h);
        {   const int r = tid >> 2, qd = tid & 3; LAS float* rp = S + r * SP + 4 * qd;
            f32x4 a[8]; float ss = 0.f;
#pragma unroll
            for (int j = 0; j < 8; ++j) { a[j] = *(const LAS f32x4*)(rp + 16 * j); ss += (a[j].x * a[j].x + a[j].y * a[j].y) + (a[j].z * a[j].z + a[j].w * a[j].w); }
            ss += __shfl_xor(ss, 1); ss += __shfl_xor(ss, 2);
            float sc = rsqrtf(ss + L2_EPS); if (r < 64) sc *= 0.08838834764831845f;
#pragma unroll
            for (int j = 0; j < 8; ++j) *(LAS f32x4*)(rp + 16 * j) = a[j] * sc;
        }
        LDS_BARRIER();
        conv_load_part<4, 8, false>(pre, proj, nidx >> 5, nidx & 31, tid, h);
        const float gl = GB[64 + 63];
        {   const int t = tid >> 3, d0 = (tid & 7) * 16; const float eg = __expf(GB[64 + t]);
            const LAS float* qp = S + t * SP + d0; const LAS float* kp = S + (64 + t) * SP + d0;
            float q[16], kk[16];
#pragma unroll
            for (int j = 0; j < 4; ++j) { const f32x4 a = *(const LAS f32x4*)(qp + 4 * j), c = *(const LAS f32x4*)(kp + 4 * j); q[4 * j] = a.x; q[4 * j + 1] = a.y; q[4 * j + 2] = a.z; q[4 * j + 3] = a.w; kk[4 * j] = c.x; kk[4 * j + 1] = c.y; kk[4 * j + 2] = c.z; kk[4 * j + 3] = c.w; }
            u32x4 w0, w1;
            w0 = (u32x4){cvt_pk_bf16(q[0], q[1]), cvt_pk_bf16(q[2], q[3]), cvt_pk_bf16(q[4], q[5]), cvt_pk_bf16(q[6], q[7])}; w1 = (u32x4){cvt_pk_bf16(q[8], q[9]), cvt_pk_bf16(q[10], q[11]), cvt_pk_bf16(q[12], q[13]), cvt_pk_bf16(q[14], q[15])};
            *(LAS u32x4*)(F.lds + L_QB + t * 272 + d0 * 2) = w0; *(LAS u32x4*)(F.lds + L_QB + t * 272 + d0 * 2 + 16) = w1;
            w0 = (u32x4){cvt_pk_bf16(kk[0], kk[1]), cvt_pk_bf16(kk[2], kk[3]), cvt_pk_bf16(kk[4], kk[5]), cvt_pk_bf16(kk[6], kk[7])}; w1 = (u32x4){cvt_pk_bf16(kk[8], kk[9]), cvt_pk_bf16(kk[10], kk[11]), cvt_pk_bf16(kk[12], kk[13]), cvt_pk_bf16(kk[14], kk[15])};
            *(LAS u32x4*)(F.lds + L_KB + t * 272 + d0 * 2) = w0; *(LAS u32x4*)(F.lds + L_KB + t * 272 + d0 * 2 + 16) = w1;
            w0 = (u32x4){cvt_pk_bf16(q[0] * eg, q[1] * eg), cvt_pk_bf16(q[2] * eg, q[3] * eg), cvt_pk_bf16(q[4] * eg, q[5] * eg), cvt_pk_bf16(q[6] * eg, q[7] * eg)};
            w1 = (u32x4){cvt_pk_bf16(q[8] * eg, q[9] * eg), cvt_pk_bf16(q[10] * eg, q[11] * eg), cvt_pk_bf16(q[12] * eg, q[13] * eg), cvt_pk_bf16(q[14] * eg, q[15] * eg)};
            bf16_t* qd = (bf16_t*)(ws + WS_QD) + (row0 + t) * 1024 + h * 128 + d0; *(u32x4*)qd = w0; *(u32x4*)(qd + 8) = w1;
        }
        {   const int d = tid >> 2, tq = (tid & 3) * 16; float kd[16];
#pragma unroll
            for (int j = 0; j < 16; ++j) kd[j] = S[(64 + tq + j) * SP + d] * __expf(gl - GB[64 + tq + j]);
            bf16_t* o = (bf16_t*)(ws + WS_KDT) + ((size_t)unit * 128 + d) * 64 + tq;
            *(u32x4*)o = (u32x4){cvt_pk_bf16(kd[0], kd[1]), cvt_pk_bf16(kd[2], kd[3]), cvt_pk_bf16(kd[4], kd[5]), cvt_pk_bf16(kd[6], kd[7])};
            *(u32x4*)(o + 8) = (u32x4){cvt_pk_bf16(kd[8], kd[9]), cvt_pk_bf16(kd[10], kd[11]), cvt_pk_bf16(kd[12], kd[13]), cvt_pk_bf16(kd[14], kd[15])};
        }
        if (tid == 0) ((float*)(ws + WS_GL))[unit] = __expf(gl);
        LDS_BARRIER();
        conv_load_part<8, 11, true>(pre, proj, nidx >> 5, nidx & 31, tid, h);
        {   const int mat = wave >> 2, bi = wave & 3, g = lane >> 4, jl = lane & 15;
            LAS float* Lt = S;
            const LAS unsigned char* ab = F.lds + (mat ? L_QB : L_KB) + (16 * bi + jl) * 272 + 16 * g;
            bf16x8 af[4];
#pragma unroll
            for (int ks = 0; ks < 4; ++ks) af[ks] = *(const LAS bf16x8*)(ab + 64 * ks);
            float gi[4], bt[4];
#pragma unroll
            for (int r = 0; r < 4; ++r) { gi[r] = GB[64 + 16 * bi + 4 * g + r]; bt[r] = GB[16 * bi + 4 * g + r]; }
            for (int bj = 0; bj < 4; ++bj) {
                f32x4 acc = {0.f, 0.f, 0.f, 0.f};
                if (bj <= bi) {
                    const LAS unsigned char* bb = F.lds + L_KB + (16 * bj + jl) * 272 + 16 * g;
#pragma unroll
                    for (int ks = 0; ks < 4; ++ks) { const bf16x8 bf = *(const LAS bf16x8*)(bb + 64 * ks); acc = __builtin_amdgcn_mfma_f32_16x16x32_bf16(af[ks], bf, acc, 0, 0, 0); }
                }
                const int j = 16 * bj + jl; const float gj = GB[64 + j];
                if (mat == 0) { if (bj <= bi) { f32x4 lv;
#pragma unroll
                        for (int r = 0; r < 4; ++r) { const int i = 16 * bi + 4 * g + r; lv[r] = (i > j) ? bt[r] * acc[r] * __expf(gi[r] - gj) : 0.f; }
                        *(LAS f32x4*)(Lt + j * LP + 16 * bi + 4 * g) = lv;
                        if (bi >= 2 && bj < 2) {
#pragma unroll
                            for (int r = 0; r < 4; ++r) *(LAS bf16_t*)(F.lds + L_LB + (16 * (bi - 2) + 4 * g + r) * 80 + j * 2) = (bf16_t)f2bf(-lv[r]); } } }
                else {
#pragma unroll
                    for (int r = 0; r < 4; ++r) { const int i = 16 * bi + 4 * g + r; const float v = (i >= j) ? acc[r] * __expf(gi[r] - gj) : 0.f; ((bf16_t*)(ws + WS_QKM))[((size_t)unit * 64 + i) * 64 + j] = (bf16_t)f2bf(v); } }
            }
        }
        {   const int t = tid >> 3, d0 = (tid & 7) * 16; const float beta = GB[t], be = beta * __expf(GB[64 + t]);
            LAS float* kp = S + (64 + t) * SP + d0; LAS float* vp = S + (128 + t) * SP + d0;
#pragma unroll
            for (int j = 0; j < 4; ++j) { f32x4 a = *(LAS f32x4*)(kp + 4 * j); a = a * be; *(LAS f32x4*)(kp + 4 * j) = a; f32x4 c = *(LAS f32x4*)(vp + 4 * j); c = c * beta; *(LAS f32x4*)(vp + 4 * j) = c; }
        }
        LDS_BARRIER();
        const LAS float* Lt = S;
        if (wave == 0) {
            const int bi = lane >> 4, cc = lane & 15; float x[16];
#pragma unroll
            for (int i = 0; i < 16; ++i) x[i] = (i == cc) ? 1.f : 0.f;
#pragma unroll
            for (int j = 0; j < 15; ++j) { const float sj = x[j];
#pragma unroll
                for (int q4 = (j + 1) / 4; q4 < 4; ++q4) { const f32x4 l4 = *(const LAS f32x4*)(Lt + (16 * bi + j) * LP + 16 * bi + 4 * q4);
#pragma unroll
                    for (int jj = 0; jj < 4; ++jj) x[4 * q4 + jj] -= l4[jj] * sj; } }
#pragma unroll
            for (int i = 0; i < 16; ++i) *(LAS bf16_t*)(F.lds + L_ST + (16 * bi + i) * 32 + cc * 2) = (bf16_t)f2bf(x[i]);
        }
        LDS_BARRIER();
        {   const int g = lane >> 4, jl = lane & 15;
            bf16x8 At[4], Al[6];
#pragma unroll
            for (int bi = 0; bi < 4; ++bi) { const u32x2 t = *(const LAS u32x2*)(F.lds + L_ST + (16 * bi + jl) * 32 + 8 * g); At[bi] = __builtin_bit_cast(bf16x8, (u32x4){t.x, t.y, 0u, 0u}); }
#pragma unroll
            for (int bi = 1; bi < 4; ++bi)
#pragma unroll
                for (int bj = 0; bj < bi; ++bj) { const LAS float* lp = Lt + (16 * bj + 4 * g) * LP + 16 * bi + jl;
                    Al[bi * (bi - 1) / 2 + bj] = __builtin_bit_cast(bf16x8, (u32x4){cvt_pk_bf16(-lp[0], -lp[LP]), cvt_pk_bf16(-lp[2 * LP], -lp[3 * LP]), 0u, 0u}); }
#pragma unroll
            for (int q = 0; q < 2; ++q) { const int cc = 16 * (2 * wave + q) + jl;
                const LAS float* rp = S + (cc < 128 ? 128 * SP + cc : 64 * SP + (cc - 128)) + (4 * g) * SP;
                bf16_t* og = (bf16_t*)(ws + (cc < 128 ? WS_UU : WS_WW)) + (row0 + 4 * g) * 1024 + h * 128 + (cc & 127);
                f32x4 y[4]; bf16x8 sb[4];
#pragma unroll
                for (int bi = 0; bi < 4; ++bi) y[bi] = (f32x4){rp[(16 * bi) * SP], rp[(16 * bi + 1) * SP], rp[(16 * bi + 2) * SP], rp[(16 * bi + 3) * SP]};
#pragma unroll
                for (int bi = 0; bi < 4; ++bi) {
#pragma unroll
                    for (int bj = 0; bj < bi; ++bj) y[bi] = __builtin_amdgcn_mfma_f32_16x16x32_bf16(Al[bi * (bi - 1) / 2 + bj], sb[bj], y[bi], 0, 0, 0);
                    const bf16x8 yb = __builtin_bit_cast(bf16x8, (u32x4){cvt_pk_bf16(y[bi][0], y[bi][1]), cvt_pk_bf16(y[bi][2], y[bi][3]), 0u, 0u});
                    const f32x4 sv = __builtin_amdgcn_mfma_f32_16x16x32_bf16(At[bi], yb, (f32x4){0.f, 0.f, 0.f, 0.f}, 0, 0, 0);
                    const unsigned p0 = cvt_pk_bf16(sv[0], sv[1]), p1 = cvt_pk_bf16(sv[2], sv[3]);
                    sb[bi] = __builtin_bit_cast(bf16x8, (u32x4){p0, p1, 0u, 0u});
                    og[(size_t)(16 * bi) * 1024] = (bf16_t)p0; og[(size_t)(16 * bi + 1) * 1024] = (bf16_t)(p0 >> 16); og[(size_t)(16 * bi + 2) * 1024] = (bf16_t)p1; og[(size_t)(16 * bi + 3) * 1024] = (bf16_t)(p1 >> 16);
                }
            }
        }
        LDS_BARRIER();
    }
}
__device__ __forceinline__ void sample_item(Frame& F, int sb, int h) {
    const Params& P = *F.p; unsigned char* ws = P.ws; OPAQUE_WS(ws); int tid = F.tid; asm volatile("" : "+v"(tid));
    const int lane = tid & 63, wave = __builtin_amdgcn_readfirstlane(tid >> 6);
    LAS float* SQ = (LAS float*)F.lds;
    LAS float* GT = SQ + 3 * 4 * 128;
    LAS float* RED = GT + 16;
    const bf16_t* proj = (const bf16_t*)(ws + WS_PROJ) + (size_t)(MP + sb * DECS) * DN_NP;
    const int dg = tid >> 7, e = tid & 127;
    float St[32];
    const float* s0 = P.in[3] + (((size_t)sb * 8 + h) * 128 + 32 * dg) * 128 + e;
#pragma unroll
    for (int i = 0; i < 32; ++i) St[i] = __builtin_nontemporal_load(s0 + (size_t)i * 128);
    if (tid < 384) {
        const int part = tid >> 7, d = tid & 127, col = part * 1024 + h * 128 + d;
        float xs[7];
#pragma unroll
        for (int j = 0; j < 3; ++j) xs[j] = P.in[4][((size_t)sb * 3 + j) * DN_QKV + col];
#pragma unroll
        for (int t = 0; t < 4; ++t) xs[3 + t] = bf2f(proj[(size_t)t * DN_NP + col]);
        float cw[4];
#pragma unroll
        for (int j = 0; j < 4; ++j) cw[j] = P.in[15][j * DN_QKV + col];
#pragma unroll
        for (int t = 0; t < 4; ++t) { float a = 0.f;
#pragma unroll
            for (int j = 0; j < 4; ++j) a += cw[j] * xs[t + j];
            SQ[(part * 4 + t) * 128 + d] = silu(a); }
#pragma unroll
        for (int j = 0; j < 3; ++j) P.out[O_CS + ((size_t)sb * 3 + j) * DN_QKV + col] = xs[4 + j];
    }
    if (tid >= 384 && tid < 388) { const int t = tid - 384; const float braw = bf2f(proj[(size_t)t * DN_NP + 4096 + h]), araw = bf2f(proj[(size_t)t * DN_NP + 4104 + h]);
        const float xs = araw + P.in[17][h]; const float sp = xs > 20.f ? xs : log1pf(__expf(xs));
        GT[t] = -__expf(P.in[16][h]) * sp; GT[4 + t] = 1.f / (1.f + __expf(-braw)); }
    LDS_BARRIER();
    { LAS float* rp = SQ + wave * 128; const float a = rp[lane], c = rp[lane + 64];
      float sc = rsqrtf(wave_sum(a * a + c * c) + L2_EPS); if (wave < 4) sc *= 0.08838834764831845f;
      rp[lane] = a * sc; rp[lane + 64] = c * sc; }
    LDS_BARRIER();
    for (int t = 0; t < 4; ++t) {
        const float dec = __expf(GT[t]), beta = GT[4 + t];
        const LAS float* qp = SQ + t * 128 + 32 * dg; const LAS float* kp = SQ + (4 + t) * 128 + 32 * dg;
        float kv = 0.f;
#pragma unroll
        for (int i = 0; i < 32; ++i) { St[i] *= dec; kv += kp[i] * St[i]; }
        RED[dg * 128 + e] = kv;
        LDS_BARRIER();
        const float kvt = (RED[e] + RED[128 + e]) + (RED[256 + e] + RED[384 + e]);
        const float delta = (SQ[(8 + t) * 128 + e] - kvt) * beta;
        float ov = 0.f;
#pragma unroll
        for (int i = 0; i < 32; ++i) { St[i] += kp[i] * delta; ov += qp[i] * St[i]; }
        LDS_BARRIER();
        RED[dg * 128 + e] = ov;
        LDS_BARRIER();
        if (dg == 0) { const float o = (RED[e] + RED[128 + e]) + (RED[256 + e] + RED[384 + e]); ((bf16_t*)(ws + WS_DO))[(size_t)(MP + sb * DECS + t) * 1024 + h * 128 + e] = (bf16_t)f2bf(o); }
        LDS_BARRIER();
    }
    float* so = P.out + O_SS + (((size_t)sb * 8 + h) * 128 + 32 * dg) * 128 + e;
#pragma unroll
    for (int i = 0; i < 32; ++i) __builtin_nontemporal_store(St[i], so + (size_t)i * 128);
    asm volatile("s_waitcnt vmcnt(0)" ::: "memory"); __syncthreads();
    if (wave < 4) gated_norm_row(ws, P.in[18], (size_t)(MP + sb * DECS + wave), h, lane);
}

struct StepRegs { bf16x8 a1[4]; bf16x8 a3[2]; bf16x8 a4[2]; };
__device__ __forceinline__ void scan_load(StepRegs& R, const unsigned char* ws, int b, int h, int sl, int n, int w, int g, int jl) {
    const int unit = (b * 8 + h) * 32 + n; const size_t row0 = (size_t)b * SEQ + 64 * n; const int tb = w & 3;
    const bf16_t* A1 = (const bf16_t*)(ws + (w < 4 ? WS_WW : WS_QD)) + (row0 + 16 * tb + jl) * 1024 + h * 128 + 8 * g;
#pragma unroll
    for (int ks = 0; ks < 4; ++ks) R.a1[ks] = *(const bf16x8*)(A1 + 32 * ks);
    const bf16_t* A4 = (const bf16_t*)(ws + WS_KDT) + ((size_t)unit * 128 + 16 * w + jl) * 64 + 8 * g;
#pragma unroll
    for (int ks = 0; ks < 2; ++ks) R.a4[ks] = *(const bf16x8*)(A4 + 32 * ks);
    const bf16_t* X = w >= 4 ? (const bf16_t*)(ws + WS_QKM) + ((size_t)unit * 64 + 16 * tb + jl) * 64 + 8 * g
                             : (const bf16_t*)(ws + WS_UU) + (row0 + 16 * tb + jl) * 1024 + h * 128 + 32 * sl + 8 * g;
    R.a3[0] = *(const bf16x8*)X; R.a3[1] = *(const bf16x8*)(X + (w >= 4 ? 32 : 0));
}
__device__ __forceinline__ void scan_step(unsigned char* ws, LAS unsigned char* ST, LAS unsigned char* VT, const StepRegs& cur, f32x4 (&sacc)[2], int b, int h, int sl, int n, int w, int g, int jl) {
    const int tb = w & 3; const size_t row0 = (size_t)b * SEQ + 64 * n;
    f32x4 tacc[2] = {{0.f, 0.f, 0.f, 0.f}, {0.f, 0.f, 0.f, 0.f}};
#pragma unroll
    for (int cb = 0; cb < 2; ++cb)
#pragma unroll
        for (int ks = 0; ks < 4; ++ks) { const bf16x8 bf = *(const LAS bf16x8*)(ST + (16 * cb + jl) * 272 + (32 * ks + 8 * g) * 2); tacc[cb] = __builtin_amdgcn_mfma_f32_16x16x32_bf16(bf, cur.a1[ks], tacc[cb], 0, 0, 0); }
    if (w < 4) {
        float uf[8]; unpack8(__builtin_bit_cast(u32x4, cur.a3[0]), uf);
#pragma unroll
        for (int cb = 0; cb < 2; ++cb) {
            const unsigned p0 = cvt_pk_bf16(uf[4 * cb + 0] - tacc[cb][0], uf[4 * cb + 1] - tacc[cb][1]), p1 = cvt_pk_bf16(uf[4 * cb + 2] - tacc[cb][2], uf[4 * cb + 3] - tacc[cb][3]);
            LAS unsigned short* vp = (LAS unsigned short*)(VT + (16 * cb + 4 * g) * 144 + (16 * tb + jl) * 2);
            vp[0] = (unsigned short)p0; vp[72] = (unsigned short)(p0 >> 16); vp[144] = (unsigned short)p1; vp[216] = (unsigned short)(p1 >> 16); }
    }
    LDS_BARRIER();
    if (w >= 4) {
#pragma unroll
        for (int cb = 0; cb < 2; ++cb)
#pragma unroll
            for (int ks = 0; ks < 2; ++ks) { const bf16x8 bf = *(const LAS bf16x8*)(VT + (16 * cb + jl) * 144 + (32 * ks + 8 * g) * 2); tacc[cb] = __builtin_amdgcn_mfma_f32_16x16x32_bf16(bf, cur.a3[ks], tacc[cb], 0, 0, 0); }
        *(u32x4*)((bf16_t*)(ws + WS_DO) + (row0 + 16 * tb + jl) * 1024 + h * 128 + 32 * sl + 8 * g) =
            (u32x4){cvt_pk_bf16(tacc[0][0], tacc[0][1]), cvt_pk_bf16(tacc[0][2], tacc[0][3]), cvt_pk_bf16(tacc[1][0], tacc[1][1]), cvt_pk_bf16(tacc[1][2], tacc[1][3])};
    }
    const float gl = ((const LAS float*)(VT + 32 * 144))[n];
#pragma unroll
    for (int cb = 0; cb < 2; ++cb) { sacc[cb] = sacc[cb] * gl;
#pragma unroll
        for (int ks = 0; ks < 2; ++ks) { const bf16x8 bf = *(const LAS bf16x8*)(VT + (16 * cb + jl) * 144 + (32 * ks + 8 * g) * 2); sacc[cb] = __builtin_amdgcn_mfma_f32_16x16x32_bf16(cur.a4[ks], bf, sacc[cb], 0, 0, 0); }
        *(LAS u32x2*)(ST + (16 * cb + jl) * 272 + (16 * w + 4 * g) * 2) = (u32x2){cvt_pk_bf16(sacc[cb][0], sacc[cb][1]), cvt_pk_bf16(sacc[cb][2], sacc[cb][3])}; }
    LDS_BARRIER();
}
__device__ __forceinline__ void scan_item(Frame& F, int b, int h, int sl) {
    const Params& P = *F.p; unsigned char* ws = P.ws; OPAQUE_WS(ws); int tid = F.tid; asm volatile("" : "+v"(tid));
    const int lane = tid & 63, w = __builtin_amdgcn_readfirstlane(tid >> 6), g = lane >> 4, jl = lane & 15;
    LAS unsigned char* ST = F.lds;
    LAS unsigned char* VT = F.lds + 32 * 272;
    for (int i = tid; i < 32 * 272 / 4; i += NTHREADS) ((LAS unsigned*)ST)[i] = 0u;
    if (tid < 32) ((LAS float*)(VT + 32 * 144))[tid] = ((const float*)(ws + WS_GL))[(b * 8 + h) * 32 + tid];
    f32x4 sacc[2] = {{0.f, 0.f, 0.f, 0.f}, {0.f, 0.f, 0.f, 0.f}};
    StepRegs A, B, C;
    scan_load(A, ws, b, h, sl, 0, w, g, jl); scan_load(B, ws, b, h, sl, 1, w, g, jl);
    __syncthreads();
    for (int n = 0; n < 30; n += 3) {
        scan_load(C, ws, b, h, sl, n + 2, w, g, jl); __builtin_amdgcn_sched_barrier(0); scan_step(ws, ST, VT, A, sacc, b, h, sl, n, w, g, jl);
        scan_load(A, ws, b, h, sl, n + 3, w, g, jl); __builtin_amdgcn_sched_barrier(0); scan_step(ws, ST, VT, B, sacc, b, h, sl, n + 1, w, g, jl);
        scan_load(B, ws, b, h, sl, n + 4, w, g, jl); __builtin_amdgcn_sched_barrier(0); scan_step(ws, ST, VT, C, sacc, b, h, sl, n + 2, w, g, jl);
    }
    scan_step(ws, ST, VT, A, sacc, b, h, sl, 30, w, g, jl);
    scan_step(ws, ST, VT, B, sacc, b, h, sl, 31, w, g, jl);
    float* so = P.out + O_SP + (((size_t)b * 8 + h) * 128 + 16 * w + 4 * g) * 128 + 32 * sl + 8 * (jl >> 2) + (jl & 3);
#pragma unroll
    for (int cb = 0; cb < 2; ++cb)
#pragma unroll
        for (int r = 0; r < 4; ++r) __builtin_nontemporal_store(sacc[cb][r], so + (size_t)r * 128 + 4 * cb);
}
template <int NB>
__device__ __forceinline__ void gn_load_z(u32x4 (&zv)[NB], unsigned char* ws, size_t row0, int h, int lane) {
    const size_t rowb = row0 + (lane >> 4); const int c0 = (lane & 15) * 8;
#pragma unroll
    for (int i = 0; i < NB; ++i) zv[i] = __builtin_nontemporal_load((const u32x4*)((const bf16_t*)(ws + WS_PROJ) + (rowb + 32 * i) * DN_NP + 3072 + h * 128 + c0));
}
template <int NB>
__device__ __forceinline__ void gated_norm_batch(unsigned char* ws, const float* gout, size_t row0, int h, int lane, const u32x4 (&zv)[NB]) {
    const size_t rowb = row0 + (lane >> 4); const int c0 = (lane & 15) * 8;
    u32x4 ov[NB];
#pragma unroll
    for (int i = 0; i < NB; ++i) ov[i] = *(const u32x4*)((const bf16_t*)(ws + WS_DO) + (rowb + 32 * i) * 1024 + h * 128 + c0);
    const f32x4 g0 = *(const f32x4*)(gout + c0), g1 = *(const f32x4*)(gout + c0 + 4);
    const float g[8] = {g0.x, g0.y, g0.z, g0.w, g1.x, g1.y, g1.z, g1.w};
    __builtin_amdgcn_sched_barrier(0);
#pragma unroll
    for (int i = 0; i < NB; ++i) {
        float o[8], z[8]; unpack8(ov[i], o); unpack8(zv[i], z);
        float ss = 0.f;
#pragma unroll
        for (int k = 0; k < 8; ++k) ss += o[k] * o[k];
        ss += __shfl_xor(ss, 1); ss += __shfl_xor(ss, 2); ss += __shfl_xor(ss, 4); ss += __shfl_xor(ss, 8);
        const float rs = rsqrtf(ss * (1.f / 128.f) + RMS_EPS);
        float y[8];
#pragma unroll
        for (int k = 0; k < 8; ++k) y[k] = o[k] * rs * g[k] * silu(z[k]);
        *(u32x4*)((bf16_t*)(ws + WS_DOG) + (rowb + 32 * i) * 1024 + h * 128 + c0) = (u32x4){cvt_pk_bf16(y[0], y[1]), cvt_pk_bf16(y[2], y[3]), cvt_pk_bf16(y[4], y[5]), cvt_pk_bf16(y[6], y[7])};
    }
}
__device__ __forceinline__ void scan_tail(Frame& F, int b, int h, int sl) {
    unsigned char* ws = F.p->ws; unsigned* cnt = (unsigned*)(ws + WS_CTL) + CW_HAND + 64 * (16 + b * 8 + h);
    hand_signal(cnt);
    const int lane = F.lane; const size_t r0 = (size_t)b * SEQ + 512 * sl + 4 * F.wave;
    u32x4 z0[8], z1[8]; gn_load_z<8>(z0, ws, r0, h, lane); gn_load_z<8>(z1, ws, r0 + 256, h, lane);
    hand_wait(cnt, 4u);
    gated_norm_batch<8>(ws, F.p->in[18], r0, h, lane, z0); gated_norm_batch<8>(ws, F.p->in[18], r0 + 256, h, lane, z1);
}
}

__global__ void __launch_bounds__(NTHREADS, 2) fwd_kernel(Params prm) {
    extern __shared__ __attribute__((aligned(16))) unsigned char lds_raw[];
    Frame F; F.lds = (LAS unsigned char*)lds_raw; F.tid = threadIdx.x; F.lane = F.tid & 63; F.wave = __builtin_amdgcn_readfirstlane(F.tid >> 6);
    F.G = gridDim.x; F.c = blockIdx.x; F.p = &prm;
    unsigned char* ws = prm.ws;
    volatile LAS unsigned* MISC = (volatile LAS unsigned*)(F.lds + 131072 + 8192);
    if (F.tid < 16) MISC[F.tid] = 0u;
    __syncthreads();
    (void)xcd_barrier_post((unsigned*)(ws + WS_CTL) + 1024, MISC + 8);
#define GSYNC() do { XcdBarrier gb_; gb_.bar = (unsigned*)(ws + WS_CTL) + 1024; gb_.x = 0; gb_.st = MISC + 8; xcd_barrier(gb_); OPAQUE_WS(ws); } while (0)
    const float QSCALE = 0.07216878364870322f * 1.4426950408889634f;

    p0_prologue(F);
    GSYNC();
    {
        pg8::Gemm g{(const bf16_t*)(ws + WS_U), (const bf16_t*)(ws + WS_WT_IN0), 1024, 1024};
        pg8::PlainOrder S; S.init(MT / 256, NIN0P / 256, 16, F.G, F.c);
        pg8::EpiF32 E{(float*)(ws + WS_A0), NIN0P, nullptr};
        pg8::gemm_phase(F.lds, g, S, E);
    }
    {
        pg8::Gemm g1{(const bf16_t*)(ws + WS_WOT), (const bf16_t*)(ws + WS_BD_UV), 1024, 1024};
        pg8::PrepOrder S1{4, 8, F.G, F.c, 195, 0};
        pg8::EpiBf16 E1{(bf16_t*)(ws + WS_WT_UVO), 2048};
        pg8::gemm_phase(F.lds, g1, S1, E1);
        pg8::Gemm g2{(const bf16_t*)(ws + WS_BD_UK), (const bf16_t*)(ws + WS_UQN), 1024, 1024};
        pg8::PrepOrder S2{8, 2, F.G, F.c, 227, 1};
        pg8::EpiBf16 E2{(bf16_t*)(ws + WS_WT_Q), 512};
        pg8::gemm_phase(F.lds, g2, S2, E2);
    }
    GSYNC();
    m2_rows(F);
    GSYNC();
    {
        pg8::Gemm g{(const bf16_t*)(ws + WS_CQ), (const bf16_t*)(ws + WS_WT_Q), 384, 512};
        pg8::PlainOrder S; S.init(MT / 256, NQ / 256, 6, F.G, F.c);
        pg8::EpiQ E{(bf16_t*)(ws + WS_Q), (const f32x2*)(ws + WS_ROPE), QSCALE};
        pg8::gemm_phase(F.lds, g, S, E);
    }
    GSYNC();
    attn::phase(F);
    GSYNC();
    for (int sb = F.c; sb < DECB; sb += F.G) attn::sample_combine(F, sb);
    GSYNC();
    {
        pg8::Gemm g{(const bf16_t*)(ws + WS_OL), (const bf16_t*)(ws + WS_WT_UVO), 2048, 2048};
        pg8::SplitOrder S; S.init(MP / 256, 4, 32, F.G, F.c); S.pmx = MP / 256; S.nsplit = 8;
        pg8::EpiMix E{(bf16_t*)(ws + WS_MIX), DM, (float*)(ws + WS_SLAB)};
        pg8::gemm_phase(F.lds, g, S, E);
    }
    GSYNC();
    rowpass(F, true, false, F.p->in[6] + 1 * DM, F.p->in[6] + 2 * DM, 8);
    GSYNC();
#pragma unroll
    for (int l = 0; l < 2; ++l) {
        if (l == 1) {
            {
                pg8::Gemm g{(const bf16_t*)(ws + WS_U), (const bf16_t*)(ws + WS_WT_DIN), 1024, 1024};
                pg8::PlainOrder S; S.init(MT / 256, DN_NP / 256, 16, F.G, F.c);
                pg8::EpiBf16 E{(bf16_t*)(ws + WS_PROJ), DN_NP};
                pg8::gemm_phase(F.lds, g, S, E);
            }
            GSYNC();
            dn::chunk_phase(F);
            for (int L = F.c; L < DECB * 8; L += F.G) dn::sample_item(F, L >> 3, L & 7);
            GSYNC();
            for (int L = F.c; L < 256; L += F.G) { const int sl = (L >> 3) & 3, bh = (L & 7) + 8 * (L >> 5); dn::scan_item(F, bh >> 3, bh & 7, sl); }
            for (int L = F.c; L < 256; L += F.G) { const int sl = (L >> 3) & 3, bh = (L & 7) + 8 * (L >> 5); dn::scan_tail(F, bh >> 3, bh & 7, sl); }
            GSYNC();
            {
                pg8::Gemm g{(const bf16_t*)(ws + WS_DOG), (const bf16_t*)(ws + WS_WT_DO), 1024, 1024};
                pg8::SplitOrder S; S.init(MP / 256, 4, 16, F.G, F.c); S.pmx = MP / 256; S.nsplit = 4;
                pg8::EpiMix E{(bf16_t*)(ws + WS_MIX), DM, (float*)(ws + WS_SLAB)};
                pg8::gemm_phase(F.lds, g, S, E);
            }
            GSYNC();
            rowpass(F, false, false, F.p->in[6] + 5 * DM, F.p->in[6] + 6 * DM, 4);
            GSYNC();
        }
        {
            pg8::Gemm g{(const bf16_t*)(ws + WS_U), (const bf16_t*)(ws + WS_WT_F1) + (size_t)l * 5632 * 1024, 1024, 1024};
            pg8::PlainOrder S; S.init(MT / 256, 22, 16, F.G, F.c);
            pg8::EpiSwiglu E{(bf16_t*)(ws + WS_H), DFF};
            pg8::gemm_phase(F.lds, g, S, E);
        }
        GSYNC();
        {
            pg8::Gemm g{(const bf16_t*)(ws + WS_H), (const bf16_t*)(ws + WS_WT_F2) + (size_t)l * 1024 * DFF, DFF, DFF};
            pg8::SplitOrder S; S.init(MP / 256, 4, 44, F.G, F.c); S.pmx = MP / 256; S.nsplit = 11;
            pg8::EpiMix E{(bf16_t*)(ws + WS_MIX), DM, (float*)(ws + WS_SLAB)};
            pg8::gemm_phase(F.lds, g, S, E);
        }
        GSYNC();
        rowpass(F, false, l == 1, F.p->in[6] + (l * 4 + 3) * DM, l == 0 ? F.p->in[6] + 4 * DM : nullptr, 11);
        if (l == 0) GSYNC();
    }
}

extern "C" void kernel_launch(void* const* d_in, const int* in_sizes, int n_in, void* d_out, int out_size, void* d_ws, size_t ws_size, hipStream_t stream) {
    static int grid = 0;
    if (grid == 0) {
        int dev = 0, cus = 0, per_cu = 0;
        hipGetDevice(&dev);
        hipDeviceGetAttribute(&cus, hipDeviceAttributeMultiprocessorCount, dev);
        hipFuncSetAttribute((const void*)fwd_kernel, hipFuncAttributeMaxDynamicSharedMemorySize, LDS_BYTES);
        hipOccupancyMaxActiveBlocksPerMultiprocessor(&per_cu, (const void*)fwd_kernel, NTHREADS, LDS_BYTES);
        if (per_cu < 1) { fprintf(stderr, "kernel_launch: occupancy query reports %d blocks per CU\n", per_cu); per_cu = 1; }
        (void)hipGetLastError();
        grid = cus;
        if (n_in != 22 || (size_t)out_size != O_END || ws_size < WS_END) fprintf(stderr, "kernel_launch: unexpected sizes n_in %d out %d ws %zu\n", n_in, out_size, ws_size);
    }
    if (ws_size < WS_END || n_in != 22 || (size_t)out_size != O_END) return;
    hipMemsetAsync((char*)d_ws + WS_CTL, 0, CTL_BYTES, stream);
    Params p{};
    for (int i = 0; i < 22; ++i) p.in[i] = (const float*)d_in[i];
    p.page_table = (const int*)d_in[5]; p.out = (float*)d_out; p.ws = (unsigned char*)d_ws;
    void* args[] = {&p};
    hipError_t e = hipLaunchCooperativeKernel((const void*)fwd_kernel, dim3(grid), dim3(NTHREADS), args, LDS_BYTES, stream);
    if (e != hipSuccess) fprintf(stderr, "cooperative launch failed: %s (grid %d)\n", hipGetErrorString(e), grid);
}
```

```cpp
#include <hip/hip_runtime.h>
#include <hip/hip_cooperative_groups.h>
#include <cstdio>
#include <cstdint>
namespace cg = cooperative_groups;

#define LAS __attribute__((address_space(3)))
#define GAS __attribute__((address_space(1)))
typedef unsigned short bf16_t;
typedef short bf16x8 __attribute__((ext_vector_type(8)));
typedef short s16x4 __attribute__((ext_vector_type(4)));
typedef float f32x4 __attribute__((ext_vector_type(4)));
typedef float f32x2 __attribute__((ext_vector_type(2)));
typedef unsigned u32x4 __attribute__((ext_vector_type(4)));
typedef unsigned u32x2 __attribute__((ext_vector_type(2)));

constexpr int DM = 1024, BATCH = 8, SEQ = 2048, DECB = 32, DECS = 4, PAST = 16384, PAGE = 128;
constexpr int MP = BATCH * SEQ;
constexpr int MS = DECB * DECS;
constexpr int MV = MP + MS;
constexpr int MT = 16640;
constexpr int HEADS = 8, QK_NOPE = 128, QK_ROPE = 64, V_HEAD = 128, KV_LORA = 256, Q_LORA = 384, MLA_ROW = 320;
constexpr int NIN0 = Q_LORA + MLA_ROW;
constexpr int NIN0P = 768;
constexpr int NQ = HEADS * KV_LORA + HEADS * QK_ROPE;
constexpr int DN_HK = 1024, DN_QKV = 3072, DN_Z = 1024, DN_N = 4112, DN_NP = 4352, CONVW = 4, CHUNK = 64;
constexpr int DFF = 2816;
constexpr int NPAGES = PAST / PAGE;
constexpr float RMS_EPS = 1e-6f, L2_EPS = 1e-6f;
constexpr int NTHREADS = 512, NWAVES = 8;

constexpr size_t O_Y = 0;
constexpr size_t O_ROWS = (size_t)MV * DM;
constexpr size_t O_SP = O_ROWS + (size_t)MV * MLA_ROW;
constexpr size_t O_SS = O_SP + (size_t)BATCH * 8 * 128 * 128;
constexpr size_t O_CP = O_SS + (size_t)DECB * 8 * 128 * 128;
constexpr size_t O_CS = O_CP + (size_t)BATCH * 3 * DN_QKV;
constexpr size_t O_END = O_CS + (size_t)DECB * 3 * DN_QKV;

constexpr size_t MiB = 1u << 20;
constexpr size_t WS_CTL = 0;
constexpr size_t CTL_BYTES = 1 * MiB;
constexpr size_t WS_ROPE = 1 * MiB;
constexpr size_t WS_WT_IN0 = 2 * MiB;
constexpr size_t WS_WT_Q = 856 * MiB;
constexpr size_t WS_WT_UVO = 6 * MiB;
constexpr size_t WS_BD_UV = 10 * MiB;
constexpr size_t WS_WOT = 14 * MiB;
constexpr size_t WS_BD_UK = 16 * MiB;
constexpr size_t WS_UQN = 20 * MiB;
constexpr size_t WS_WT_F1 = 22 * MiB;
constexpr size_t WS_WT_F2 = 44 * MiB;
constexpr size_t WS_WT_DIN = 56 * MiB;
constexpr size_t WS_WT_DO = 65 * MiB;
constexpr size_t WS_U = 68 * MiB;
constexpr size_t WS_A0 = 102 * MiB;
constexpr size_t WS_CQ = 152 * MiB;
constexpr size_t WS_ROWSB = 166 * MiB;
constexpr size_t WS_Q = 178 * MiB;
constexpr size_t WS_OL = 260 * MiB;
constexpr size_t WS_MIX = 326 * MiB;
constexpr size_t WS_SLAB = 392 * MiB;
constexpr size_t WS_H = 400 * MiB;
constexpr size_t WS_PROJ = 490 * MiB;
constexpr size_t WS_PART = 632 * MiB;
constexpr size_t WS_ML = 641 * MiB;
constexpr size_t WS_DO = 642 * MiB;
constexpr size_t WS_DOG = 676 * MiB;
constexpr size_t WS_UU = 710 * MiB;
constexpr size_t WS_WW = 742 * MiB;
constexpr size_t WS_QD = 774 * MiB;
constexpr size_t WS_KDT = 806 * MiB;
constexpr size_t WS_QKM = 838 * MiB;
constexpr size_t WS_GL = 854 * MiB;
constexpr size_t WS_HB = 860 * MiB;
constexpr size_t WS_END = 894 * MiB;
constexpr int NSLAB_MAX = 16;

constexpr int CW_GEN = 64;
constexpr int CW_ATT = 8192;

__device__ __forceinline__ float bf2f(unsigned short b) { return __builtin_bit_cast(float, (unsigned)b << 16); }
typedef float f32x2_t __attribute__((ext_vector_type(2)));
typedef __bf16 bf16x2_t __attribute__((ext_vector_type(2)));
__device__ __forceinline__ unsigned cvt_pk_bf16(float lo, float hi) { f32x2_t v = {lo, hi}; bf16x2_t b = __builtin_convertvector(v, bf16x2_t); return __builtin_bit_cast(unsigned, b); }
__device__ __forceinline__ unsigned f2bf(float f) { return cvt_pk_bf16(f, 0.f) & 0xffffu; }
__device__ __forceinline__ unsigned pk2(float lo, float hi) { return cvt_pk_bf16(lo, hi); }
__device__ __forceinline__ float xsum16(float x) { float a = x, b = x; asm volatile("s_nop 1\n\tv_permlane16_swap_b32 %0, %1" : "+v"(a), "+v"(b)); return a + b; }
__device__ __forceinline__ float xsum32(float x) { float a = x, b = x; asm volatile("s_nop 1\n\tv_permlane32_swap_b32 %0, %1" : "+v"(a), "+v"(b)); return a + b; }
__device__ __forceinline__ float wave_sum(float v) {
#pragma unroll
    for (int o = 1; o < 16; o <<= 1) v += __shfl_xor(v, o);
    return xsum32(xsum16(v));
}
#define LDS_WAIT() asm volatile("s_waitcnt lgkmcnt(0)" ::: "memory")
#define VM_WAIT() asm volatile("s_waitcnt vmcnt(0)" ::: "memory")

typedef __attribute__((address_space(1))) unsigned char g_u8_t;
#define OPAQUE_WS(ws) do { g_u8_t* w1_ = (g_u8_t*)(ws); asm volatile("" : "+s"(w1_)); ws = (unsigned char*)w1_; } while (0)
namespace pg8 {
constexpr int BM = 256, BK = 64, HALF = 128, HTB = HALF * BK * 2, STAGE_BYTES = 8 * HTB, NXCD = 8, WGM = 8;
__host__ __device__ __forceinline__ int lds_byte(int r, int c) { const int st = (r >> 4) * 2 + (c >> 5), rr = r & 15, cc = c & 31, ob = rr * 64 + cc * 2; return st * 1024 + (ob ^ (((ob >> 9) & 1) << 5)); }
__host__ __device__ __forceinline__ void stage_rc(int b, int& R, int& C) { const int st = b / 1024, sb = b % 1024, swz = sb ^ (((sb >> 9) & 1) << 5); R = (st >> 1) * 16 + swz / 64; C = (st & 1) * 32 + (swz % 64) / 2; }
__host__ __device__ __forceinline__ int perm32(int rho) { const int n = rho >> 4, i = rho & 15; return 8 * (i >> 2) + 4 * n + (i & 3); }

struct Unit { int pm, pn, kt0, nkt, z; };
struct Gemm { const bf16_t* A; const bf16_t* Bt; int lda, ldb; };

struct MainOrder {
    int nM, nN, nwg, G, c, nkt;
    __device__ __forceinline__ void init(int nM_, int nN_, int nkt_, int G_, int c_) { nM = nM_; nN = nN_; nwg = nM * nN; G = G_; c = c_; nkt = nkt_; asm volatile("" : "+s"(c)); }
    __device__ __forceinline__ void main_map(int L, int& pm, int& pn) const {
        int wgid = L; { const int q = nwg / NXCD, r = nwg % NXCD, xcd = wgid % NXCD, off = wgid / NXCD; wgid = (xcd < r ? xcd * (q + 1) : r * (q + 1) + (xcd - r) * q) + off; }
        const int nig = WGM * nN, gid = wgid / nig, fm = gid * WGM, gsz = (nM - fm) < WGM ? (nM - fm) : WGM;
        pm = fm + ((wgid % nig) % gsz); pn = (wgid % nig) / gsz;
    }
};
struct SplitOrder : MainOrder {
    int pmx, nsplit;
    __device__ __forceinline__ bool next(int i, Unit& u) const {
        const int L = i * G + c; const bool is_main = L < nwg; const int e = L - nwg; const bool ok = is_main || e < nsplit * nN;
        int pm = 0, pn = 0; main_map(is_main ? L : 0, pm, pn);
        const int per = nkt / nsplit, z = e / nN;
        Unit r; r.pm = is_main ? pm : pmx; r.pn = is_main ? pn : e % nN; r.kt0 = is_main ? 0 : z * per; r.nkt = is_main ? nkt : per; r.z = is_main ? -1 : z;
        u = r; return ok;
    }
};
struct PlainOrder : MainOrder {
    __device__ __forceinline__ bool next(int i, Unit& u) const {
        const int L = i * G + c; const bool ok = L < nwg; int pm = 0, pn = 0; main_map(ok ? L : 0, pm, pn);
        Unit r; r.pm = pm; r.pn = pn; r.kt0 = 0; r.nkt = nkt; r.z = -1; u = r; return ok;
    }
};
struct PrepOrder {
    int nM, nN, G, c, c0, by_m;
    __device__ __forceinline__ bool next(int i, Unit& u) const {
        const int i0 = c < c0 ? (c0 - c + G - 1) / G : 0; const int L = (i + i0) * G + c - c0; const bool ok = L < nM * nN;
        const int pm = ok ? L / nN : 0, pn = ok ? L % nN : 0; const int h = by_m ? pm : pn;
        int four = 4; asm volatile("" : "+s"(four));
        Unit r; r.pm = pm; r.pn = pn; r.kt0 = 4 * (h >> 1); r.nkt = four; r.z = -1; u = r; return ok;
    }
};

struct EpiF32 {
    static constexpr bool PERM = false;
    float* C; int ldc; float* slab;
    __device__ __forceinline__ void operator()(const f32x4 (&acc)[2][2][4][2], const Unit& u, int wr, int wc, int fr, int fq) const {
        const bool split = u.z >= 0;
        float* base = (split ? slab + (size_t)u.z * 128 * ldc : C + (size_t)u.pm * BM * ldc) + (size_t)(wr * 64 + fr) * ldc + u.pn * BM + wc * 32 + 4 * fq;
#pragma unroll
        for (int ai = 0; ai < 2; ++ai) {
            if (ai == 1 && split) break;
#pragma unroll
            for (int m = 0; m < 4; ++m) { float* rowp = base + (size_t)(ai * HALF + m * 16) * ldc;
#pragma unroll
                for (int bj = 0; bj < 2; ++bj)
#pragma unroll
                    for (int n = 0; n < 2; ++n) *(f32x4*)(rowp + bj * HALF + n * 16) = acc[ai][bj][m][n]; }
        }
    }
};
struct EpiMix {
    static constexpr bool PERM = true;
    bf16_t* C; int ldc; float* slab;
    __device__ __forceinline__ void operator()(const f32x4 (&acc)[2][2][4][2], const Unit& u, int wr, int wc, int fr, int fq) const {
        const int col0 = u.pn * BM + wc * 32 + 8 * fq;
        if (u.z < 0) {
            const int row0 = u.pm * BM + wr * 64 + fr;
#pragma unroll
            for (int ai = 0; ai < 2; ++ai)
#pragma unroll
                for (int m = 0; m < 4; ++m) { bf16_t* rowp = C + (size_t)(row0 + ai * HALF + m * 16) * ldc + col0;
#pragma unroll
                    for (int bj = 0; bj < 2; ++bj) { const f32x4 v0 = acc[ai][bj][m][0], v1 = acc[ai][bj][m][1];
                        u32x4 w; w.x = cvt_pk_bf16(v0[0], v0[1]); w.y = cvt_pk_bf16(v0[2], v0[3]); w.z = cvt_pk_bf16(v1[0], v1[1]); w.w = cvt_pk_bf16(v1[2], v1[3]);
                        *(u32x4*)(rowp + bj * HALF) = w; } }
        } else {
            float* base = slab + (size_t)u.z * 128 * ldc + (size_t)(wr * 64 + fr) * ldc + col0;
#pragma unroll
            for (int m = 0; m < 4; ++m)
#pragma unroll
                for (int bj = 0; bj < 2; ++bj) { float* p = base + (size_t)(m * 16) * ldc + bj * HALF; *(f32x4*)p = acc[0][bj][m][0]; *(f32x4*)(p + 4) = acc[0][bj][m][1]; }
        }
    }
};
struct EpiBf16 {
    static constexpr bool PERM = true;
    bf16_t* C; int ldc;
    __device__ __forceinline__ void operator()(const f32x4 (&acc)[2][2][4][2], const Unit& u, int wr, int wc, int fr, int fq) const {
        const int row0 = u.pm * BM + wr * 64 + fr, col0 = u.pn * BM + wc * 32 + 8 * fq;
#pragma unroll
        for (int ai = 0; ai < 2; ++ai)
#pragma unroll
            for (int m = 0; m < 4; ++m) { bf16_t* rowp = C + (size_t)(row0 + ai * HALF + m * 16) * ldc + col0;
#pragma unroll
                for (int bj = 0; bj < 2; ++bj) { const f32x4 v0 = acc[ai][bj][m][0], v1 = acc[ai][bj][m][1];
                    u32x4 w; w.x = cvt_pk_bf16(v0[0], v0[1]); w.y = cvt_pk_bf16(v0[2], v0[3]); w.z = cvt_pk_bf16(v1[0], v1[1]); w.w = cvt_pk_bf16(v1[2], v1[3]);
                    *(u32x4*)(rowp + bj * HALF) = w; } }
    }
};
struct EpiSwiglu {
    static constexpr bool PERM = true;
    bf16_t* C; int ldc;
    __device__ __forceinline__ void operator()(const f32x4 (&acc)[2][2][4][2], const Unit& u, int wr, int wc, int fr, int fq) const {
        const int row0 = u.pm * BM + wr * 64 + fr, col0 = u.pn * HALF + wc * 32 + 8 * fq;
#pragma unroll
        for (int ai = 0; ai < 2; ++ai)
#pragma unroll
            for (int m = 0; m < 4; ++m) { float o[8];
#pragma unroll
                for (int n = 0; n < 2; ++n)
#pragma unroll
                    for (int j = 0; j < 4; ++j) { const float g = acc[ai][0][m][n][j], up = acc[ai][1][m][n][j]; o[4 * n + j] = g * __builtin_amdgcn_rcpf(1.f + __expf(-g)) * up; }
                u32x4 w; w.x = cvt_pk_bf16(o[0], o[1]); w.y = cvt_pk_bf16(o[2], o[3]); w.z = cvt_pk_bf16(o[4], o[5]); w.w = cvt_pk_bf16(o[6], o[7]);
                *(u32x4*)(C + (size_t)(row0 + ai * HALF + m * 16) * ldc + col0) = w; }
    }
};
struct EpiQ {
    static constexpr bool PERM = true;
    bf16_t* C; const f32x2* rope; float scale;
    __device__ __forceinline__ void operator()(const f32x4 (&acc)[2][2][4][2], const Unit& u, int wr, int wc, int fr, int fq) const {
        const int row0 = u.pm * BM + wr * 64 + fr, col0 = u.pn * BM + wc * 32 + 8 * fq;
        const bool rp = u.pn >= 8;
#pragma unroll
        for (int ai = 0; ai < 2; ++ai)
#pragma unroll
            for (int m = 0; m < 4; ++m) { const int row = row0 + ai * HALF + m * 16;
                int pidx = row < MP ? (row & (SEQ - 1)) : (SEQ + ((row - MP) & 3)); if (row >= MV) pidx = 0;
                bf16_t* rowp = C + (size_t)row * NQ + col0;
#pragma unroll
                for (int bj = 0; bj < 2; ++bj) { f32x4 v0 = acc[ai][bj][m][0], v1 = acc[ai][bj][m][1];
                    if (rp) { const int i0 = ((col0 + bj * HALF) & 63) >> 1; const f32x2* t = rope + pidx * 32 + i0;
                        const f32x2 c0 = t[0], c1 = t[1], c2 = t[2], c3 = t[3];
                        const f32x4 r0 = {v0[0] * c0.x - v0[1] * c0.y, v0[1] * c0.x + v0[0] * c0.y, v0[2] * c1.x - v0[3] * c1.y, v0[3] * c1.x + v0[2] * c1.y};
                        const f32x4 r1 = {v1[0] * c2.x - v1[1] * c2.y, v1[1] * c2.x + v1[0] * c2.y, v1[2] * c3.x - v1[3] * c3.y, v1[3] * c3.x + v1[2] * c3.y};
                        v0 = r0; v1 = r1; }
                    v0 = v0 * scale; v1 = v1 * scale;
                    if (rp) {
                        const int cc = col0 + bj * HALF - 2048, hh = cc >> 6, i0 = (cc & 63) >> 1; bf16_t* qp = C + (size_t)row * NQ + 2048 + hh * 64 + i0;
                        u32x2 a, b; a.x = cvt_pk_bf16(v0[0], v0[2]); a.y = cvt_pk_bf16(v1[0], v1[2]); b.x = cvt_pk_bf16(v0[1], v0[3]); b.y = cvt_pk_bf16(v1[1], v1[3]);
                        *(u32x2*)qp = a; *(u32x2*)(qp + 32) = b;
                    } else {
                    u32x4 w; w.x = cvt_pk_bf16(v0[0], v0[1]); w.y = cvt_pk_bf16(v0[2], v0[3]); w.z = cvt_pk_bf16(v1[0], v1[1]); w.w = cvt_pk_bf16(v1[2], v1[3]);
                    *(u32x4*)(rowp + bj * HALF) = w; } } }
    }
};

template <class Epi, class Sched>
__device__ __forceinline__ void gemm_phase(LAS unsigned char* lds, const Gemm g, const Sched& S, const Epi& E) {
    int tid = threadIdx.x; asm volatile("" : "+v"(tid));
    const int wid = __builtin_amdgcn_readfirstlane(tid >> 6), lane = tid & 63, wr = wid >> 2, wc = wid & 3, fr = lane & 15, fq = lane >> 4;
    unsigned voffA[2], voffB[2];
#pragma unroll
    for (int i = 0; i < 2; ++i) { int R, C; stage_rc(tid * 16 + i * 8192, R, C); const int Rb = Epi::PERM ? ((R & ~31) + perm32(R & 31)) : R;
        voffA[i] = (unsigned)(R * g.lda + C) * 2u; voffB[i] = (unsigned)(Rb * g.ldb + C) * 2u; }
    const size_t kstep = (size_t)(BK * 2);
    const size_t hstepA = (size_t)HALF * g.lda * 2, hstepB = (size_t)HALF * g.ldb * 2;
    const size_t tstepA = 2 * hstepA, tstepB = 2 * hstepB;
    const unsigned ldsw = (unsigned)wid * 1024u;
    const int aoff = lds_byte(wr * 64 + fr, fq * 8), boff = lds_byte(wc * 32 + fr, fq * 8);
#define PG8_SA(b, h) (((b) * 2 + (h)) * HTB)
#define PG8_SB(b, h) ((4 + (b) * 2 + (h)) * HTB)
#define PG8_STAGE(bufoff, gbase, voff) do { _Pragma("unroll") for (int _i = 0; _i < 2; ++_i) \
        __builtin_amdgcn_global_load_lds((const unsigned*)((const char*)(gbase) + (voff)[_i]), (LAS unsigned*)(lds + (bufoff) + ldsw + _i * 8192), 16, 0, 0); } while (0)
#define PG8_LDA(dst, b, h) do { _Pragma("unroll") for (int m = 0; m < 4; ++m) _Pragma("unroll") for (int k = 0; k < 2; ++k) dst[m][k] = *(const LAS bf16x8*)(lds + PG8_SA(b, h) + aoff + m * 2048 + k * 1024); } while (0)
#define PG8_LDB(dst, b, h) do { _Pragma("unroll") for (int n = 0; n < 2; ++n) _Pragma("unroll") for (int k = 0; k < 2; ++k) dst[n][k] = *(const LAS bf16x8*)(lds + PG8_SB(b, h) + boff + n * 2048 + k * 1024); } while (0)
#define PG8_MMA(ai, bj, At, Bt) do { __builtin_amdgcn_s_setprio(1); _Pragma("unroll") for (int m = 0; m < 4; ++m) _Pragma("unroll") for (int n = 0; n < 2; ++n) _Pragma("unroll") for (int k = 0; k < 2; ++k) \
        acc[ai][bj][m][n] = __builtin_amdgcn_mfma_f32_16x16x32_bf16(Bt[n][k], At[m][k], acc[ai][bj][m][n], 0, 0, 0); __builtin_amdgcn_s_setprio(0); } while (0)
#define PG8_WAIT_V(n) asm volatile("s_waitcnt vmcnt(" #n ")" ::: "memory")
#define PG8_WAIT_L(n) asm volatile("s_waitcnt lgkmcnt(" #n ")" ::: "memory")
#define PG8_BAR __builtin_amdgcn_s_barrier()
#define PG8_SCHED __builtin_amdgcn_sched_barrier(0)
    Unit cur, nxt; int ui = 0;
    if (!S.next(0, cur)) return;
    f32x4 acc[2][2][4][2];
#pragma unroll
    for (int a = 0; a < 2; ++a)
#pragma unroll
        for (int b = 0; b < 2; ++b)
#pragma unroll
            for (int m = 0; m < 4; ++m)
#pragma unroll
                for (int n = 0; n < 2; ++n) acc[a][b][m][n] = (f32x4){0.f, 0.f, 0.f, 0.f};
    bf16x8 At[4][2], B0[2][2], B1[2][2];
    const char* cA = (const char*)g.A + (size_t)cur.pm * tstepA + (size_t)cur.kt0 * kstep; const char* cB = (const char*)g.Bt + (size_t)cur.pn * tstepB + (size_t)cur.kt0 * kstep;
    PG8_STAGE(PG8_SB(0, 0), cB, voffB); PG8_STAGE(PG8_SB(0, 1), cB + hstepB, voffB); PG8_STAGE(PG8_SA(0, 0), cA, voffA); PG8_STAGE(PG8_SA(0, 1), cA + hstepA, voffA);
    if (wr == 1) PG8_BAR;
    PG8_WAIT_V(2); PG8_BAR;
    PG8_STAGE(PG8_SB(1, 0), cB + kstep, voffB); PG8_STAGE(PG8_SA(1, 0), cA + kstep, voffA); PG8_STAGE(PG8_SB(1, 1), cB + hstepB + kstep, voffB);
    PG8_WAIT_V(6); PG8_BAR;
    for (;;) {
        const bool has_next = S.next(ui + 1, nxt);
        const char* nA = has_next ? (const char*)g.A + (size_t)nxt.pm * tstepA + (size_t)nxt.kt0 * kstep : cA;
        const char* nB = has_next ? (const char*)g.Bt + (size_t)nxt.pn * tstepB + (size_t)nxt.kt0 * kstep : cB;
        const int nt = cur.nkt;
        for (int t = 0; t < nt; t += 2) {
            const bool last = (t == nt - 2);
            const char* a1 = cA + (size_t)(t + 1) * kstep;
            const char* a2 = last ? nA : cA + (size_t)(t + 2) * kstep; const char* b2 = last ? nB : cB + (size_t)(t + 2) * kstep;
            const char* a3 = a2 + kstep; const char* b3 = b2 + kstep;
            PG8_LDB(B0, 0, 0); PG8_LDB(B1, 0, 1); PG8_SCHED; PG8_LDA(At, 0, 0); PG8_STAGE(PG8_SA(1, 1), a1 + hstepA, voffA);
            PG8_WAIT_V(8); PG8_WAIT_L(0); PG8_BAR; PG8_MMA(0, 0, At, B0); PG8_MMA(0, 1, At, B1); PG8_BAR; PG8_SCHED;
            PG8_LDA(At, 0, 1); PG8_STAGE(PG8_SB(0, 0), b2, voffB); PG8_STAGE(PG8_SB(0, 1), b2 + hstepB, voffB); PG8_STAGE(PG8_SA(0, 0), a2, voffA);
            PG8_WAIT_V(8); PG8_WAIT_L(0); PG8_BAR; PG8_MMA(1, 0, At, B0); PG8_MMA(1, 1, At, B1); PG8_BAR; PG8_SCHED;
            PG8_LDB(B0, 1, 0); PG8_LDB(B1, 1, 1); PG8_SCHED; PG8_LDA(At, 1, 0); PG8_STAGE(PG8_SA(0, 1), a2 + hstepA, voffA);
            PG8_WAIT_V(8); PG8_WAIT_L(0); PG8_BAR; PG8_MMA(0, 0, At, B0); PG8_MMA(0, 1, At, B1); PG8_BAR; PG8_SCHED;
            PG8_LDA(At, 1, 1); PG8_STAGE(PG8_SB(1, 0), b3, voffB); PG8_STAGE(PG8_SB(1, 1), b3 + hstepB, voffB); PG8_STAGE(PG8_SA(1, 0), a3, voffA);
            PG8_WAIT_V(8); PG8_WAIT_L(0); PG8_BAR; PG8_MMA(1, 0, At, B0); PG8_MMA(1, 1, At, B1); PG8_BAR; PG8_SCHED;
        }
        if (wr == 0) PG8_BAR;
        E(acc, cur, wr, wc, fr, fq);
        if (!has_next) break;
#pragma unroll
        for (int a = 0; a < 2; ++a)
#pragma unroll
            for (int b = 0; b < 2; ++b)
#pragma unroll
                for (int m = 0; m < 4; ++m)
#pragma unroll
                    for (int n = 0; n < 2; ++n) acc[a][b][m][n] = (f32x4){0.f, 0.f, 0.f, 0.f};
        cur = nxt; cA = nA; cB = nB; ++ui;
        if (wr == 1) PG8_BAR;
    }
    PG8_WAIT_V(0);
    PG8_BAR;
#undef PG8_SA
#undef PG8_SB
#undef PG8_STAGE
#undef PG8_LDA
#undef PG8_LDB
#undef PG8_MMA
#undef PG8_WAIT_V
#undef PG8_WAIT_L
#undef PG8_BAR
#undef PG8_SCHED
}
}


#define XB_TMO      128
#define XB_XCNT(j)  (256  + 64 * (j))
#define XB_XSUB(j)  (1280 + 64 * (j))
#define XB_XGEN(j)  (2304 + 64 * (j))
#define XB_TOP      3328
#define XB_TOPGEN   3392
#define XCD_BAR_WORDS 3456
#define XB_SPIN_CAP (1u << 22)
__device__ __forceinline__ unsigned xb_ld(unsigned* p)              { return __hip_atomic_load(p, __ATOMIC_RELAXED, __HIP_MEMORY_SCOPE_AGENT); }
__device__ __forceinline__ unsigned xb_add(unsigned* p, unsigned v) { return __hip_atomic_fetch_add(p, v, __ATOMIC_RELAXED, __HIP_MEMORY_SCOPE_AGENT); }
__device__ __forceinline__ unsigned xb_xcc_id() { return (unsigned)__builtin_amdgcn_s_getreg((3 << 11) | 20) & 0xFu; }
#define XB_SPIN(cond, bar) do { unsigned _sp = 0; while (cond) { __builtin_amdgcn_s_sleep(1); \
    if ((++_sp & 255u) == 0u) { if (xb_ld(&(bar)[XB_TMO])) break; if (_sp > XB_SPIN_CAP) { atomicAdd(&(bar)[XB_TMO], 1u); break; } } } } while (0)
struct XcdBarrier { unsigned* bar; unsigned x; volatile LAS unsigned* st; };
__device__ __forceinline__ XcdBarrier xcd_barrier_post(unsigned* bar, volatile LAS unsigned* st) {
    XcdBarrier b; b.bar = bar; b.x = xb_xcc_id(); b.st = st;
    if (threadIdx.x == 0) (void)xb_add(&bar[XB_XCNT(b.x)], 1u);
    return b;
}
__device__ __forceinline__ void xcd_barrier_complete(unsigned* bar, unsigned x, unsigned& nloc, unsigned& nx) {
    const unsigned G = gridDim.x * gridDim.y * gridDim.z;
    unsigned sum, cnt, mine, sp = 0u;
    for (;;) {
        sum = 0u; cnt = 0u; mine = 0u;
#pragma unroll
        for (unsigned j = 0; j < 16; ++j) { const unsigned c = xb_ld(&bar[XB_XCNT(j)]); sum += c; cnt += (c > 0u) ? 1u : 0u; mine = (j == x) ? c : mine; }
        if (sum == G) break;
        __builtin_amdgcn_s_sleep(1);
        if ((++sp & 255u) == 0u) { if (xb_ld(&bar[XB_TMO])) break; if (sp > XB_SPIN_CAP) { atomicAdd(&bar[XB_TMO], 1u); break; } }
    }
    nloc = mine > 0u ? mine : 1u; nx = cnt > 0u ? cnt : 1u;
}
__device__ __forceinline__ void xcd_barrier(const XcdBarrier& b0) {
    XcdBarrier b; b.bar = b0.bar; b.st = b0.st; b.x = (unsigned)__builtin_amdgcn_readfirstlane((int)xb_xcc_id());
    asm volatile("s_waitcnt vmcnt(0)" ::: "memory");
    __syncthreads();
    if (threadIdx.x == 0) {
        unsigned* bar = b.bar;
        __builtin_amdgcn_s_waitcnt(0);
        unsigned nloc = b.st[0], nx = b.st[1];
        if (nloc == 0u) { xcd_barrier_complete(bar, b.x, nloc, nx); b.st[0] = nloc; b.st[1] = nx; }
        const unsigned old = xb_add(&bar[XB_XSUB(b.x)], 1u);
        const unsigned gen = old / nloc;
        if (old + 1u == (gen + 1u) * nloc) {
            __builtin_amdgcn_fence(__ATOMIC_RELEASE, "agent");
            asm volatile("s_waitcnt vmcnt(0)" ::: "memory");
            const unsigned og = xb_add(&bar[XB_TOP], 1u);
            const unsigned tg = og / nx;
            if (og + 1u == (tg + 1u) * nx) xb_add(&bar[XB_TOPGEN], 1u);
            else XB_SPIN(xb_ld(&bar[XB_TOPGEN]) == tg, bar);
            __builtin_amdgcn_fence(__ATOMIC_ACQUIRE, "agent");
            xb_add(&bar[XB_XGEN(b.x)], 1u);
            asm volatile("s_waitcnt vmcnt(0)" ::: "memory");
        } else {
            XB_SPIN(xb_ld(&bar[XB_XGEN(b.x)]) == gen, bar);
            __builtin_amdgcn_fence(__ATOMIC_ACQUIRE, "agent");
            asm volatile("s_waitcnt vmcnt(0)" ::: "memory");
        }
    }
    __syncthreads();
}

constexpr int CW_HAND = 32768;
__device__ __forceinline__ void hand_signal(unsigned* cnt) {
    asm volatile("s_waitcnt vmcnt(0)" ::: "memory");
    __syncthreads();
    if (threadIdx.x == 0) { __builtin_amdgcn_fence(__ATOMIC_RELEASE, "agent"); asm volatile("s_waitcnt vmcnt(0)" ::: "memory");
        __hip_atomic_fetch_add(cnt, 1u, __ATOMIC_RELAXED, __HIP_MEMORY_SCOPE_AGENT); }
}
__device__ __forceinline__ void hand_wait(unsigned* cnt, unsigned need) {
    if (threadIdx.x == 0) { unsigned sp = 0;
        while (__hip_atomic_load(cnt, __ATOMIC_RELAXED, __HIP_MEMORY_SCOPE_AGENT) < need) { __builtin_amdgcn_s_sleep(2); if (++sp > (1u << 24)) break; }
        __builtin_amdgcn_fence(__ATOMIC_ACQUIRE, "agent"); asm volatile("s_waitcnt vmcnt(0)" ::: "memory"); }
    __syncthreads();
}

constexpr int LDS_BYTES = 147456;
struct Params {
    const float* in[22]; const int* page_table; float* out; unsigned char* ws; int pad0, pad1;
};
struct Frame {
    LAS unsigned char* lds;
    int tid, lane, wave, G, c;
    const Params* p;
};

__device__ __forceinline__ void transpose_item(const float* W, int ldw, int k0, int n_src0, int n_valid, bf16_t* WT, int ldd, int row_base, int row_stride, LAS float* scr, int lane) {
    const int n4 = (lane & 7) * 4;
    f32x4 v[8];
#pragma unroll
    for (int i = 0; i < 8; ++i) { const int kk = 8 * i + (lane >> 3); v[i] = (n_src0 + n4 < n_valid) ? __builtin_nontemporal_load((const f32x4*)(W + (size_t)(k0 + kk) * ldw + n_src0 + n4)) : (f32x4){0.f, 0.f, 0.f, 0.f}; }
#pragma unroll
    for (int i = 0; i < 8; ++i) { LAS float* d = scr + (8 * i + (lane >> 3)) * 33 + n4; d[0] = v[i].x; d[1] = v[i].y; d[2] = v[i].z; d[3] = v[i].w; }
    LDS_WAIT(); asm volatile("" ::: "memory");
    const int c = lane & 7;
#pragma unroll
    for (int j = 0; j < 4; ++j) { const int n = (lane >> 3) + 8 * j; const LAS float* s = scr + (8 * c) * 33 + n;
        u32x4 o; o.x = pk2(s[0 * 33], s[1 * 33]); o.y = pk2(s[2 * 33], s[3 * 33]); o.z = pk2(s[4 * 33], s[5 * 33]); o.w = pk2(s[6 * 33], s[7 * 33]);
        if (n_src0 + n < n_valid) *(u32x4*)(WT + (size_t)(row_base + n * row_stride) * ldd + k0 + 8 * c) = o; }
    LDS_WAIT(); asm volatile("" ::: "memory");
}
__device__ __forceinline__ void rms_row_to_bf16(const float* xrow, const float* w, bf16_t* orow, int lane) {
    const f32x4* xr = (const f32x4*)xrow + lane; const f32x4* wr = (const f32x4*)w + lane;
    f32x4 v[4]; float s = 0.f;
#pragma unroll
    for (int j = 0; j < 4; ++j) { v[j] = xr[64 * j]; s += (v[j].x * v[j].x + v[j].y * v[j].y) + (v[j].z * v[j].z + v[j].w * v[j].w); }
    const float rs = rsqrtf(wave_sum(s) * (1.f / DM) + RMS_EPS);
    u32x2* o8 = (u32x2*)orow + lane;
#pragma unroll
    for (int j = 0; j < 4; ++j) { const f32x4 g = wr[64 * j]; u32x2 o; o.x = pk2(v[j].x * rs * g.x, v[j].y * rs * g.y); o.y = pk2(v[j].z * rs * g.z, v[j].w * rs * g.w); o8[64 * j] = o; }
}

__device__ __forceinline__ void p0_prologue(Frame& F) {
    const Params& P = *F.p;
    unsigned char* ws = P.ws;
    LAS float* scr = (LAS float*)(F.lds + F.wave * 16384);
    const int gw = F.c * NWAVES + F.wave, NGW = F.G * NWAVES;
    const int gt = F.c * NTHREADS + F.tid, NGT = F.G * NTHREADS;
    constexpr int I_IN0 = 16 * 22, I_ROPE = 6 * 16, I_WO = 16 * 32, I_F1 = 16 * 176, I_F2 = 44 * 32, I_DIN = 16 * 129, I_DO = 16 * 32;
    constexpr int NITEMS = I_IN0 + I_ROPE + I_WO + 2 * I_F1 + 2 * I_F2 + I_DIN + I_DO;
    for (int it = gw; it < NITEMS; it += NGW) {
        int r = it;
        if (r < I_IN0) { const int kb = r / 22, nb = r % 22; transpose_item(P.in[7], NIN0, 64 * kb, 32 * nb, NIN0, (bf16_t*)(ws + WS_WT_IN0), 1024, 32 * nb, 1, scr, F.lane); continue; } r -= I_IN0;
        if (r < I_ROPE) { const int kb = r / 16, hs = r % 16, h = hs >> 1, s = hs & 1;
            transpose_item(P.in[10], 1536, 64 * kb, h * 192 + 128 + 32 * s, 1536, (bf16_t*)(ws + WS_WT_Q), 512, 2048 + h * 64 + s, 2, scr, F.lane); continue; } r -= I_ROPE;
        if (r < I_WO) { const int kb = r / 32, nb = r % 32; transpose_item(P.in[13], 1024, 64 * kb, 32 * nb, 1024, (bf16_t*)(ws + WS_WOT), 1024, 32 * nb, 1, scr, F.lane); continue; } r -= I_WO;
        if (r < 2 * I_F1) { const int l = r / I_F1, q = r % I_F1, kb = q / 176, nb = q % 176; const int n0 = 32 * nb; const int nn = n0 < DFF ? n0 : n0 - DFF;
            const int row = 256 * (nn / 128) + (n0 < DFF ? 0 : 128) + (nn % 128);
            transpose_item(P.in[20] + (size_t)l * 1024 * 5632, 5632, 64 * kb, n0, 5632, (bf16_t*)(ws + WS_WT_F1) + (size_t)l * 5632 * 1024, 1024, row, 1, scr, F.lane); continue; } r -= 2 * I_F1;
        if (r < 2 * I_F2) { const int l = r / I_F2, q = r % I_F2, kb = q / 32, nb = q % 32;
            transpose_item(P.in[21] + (size_t)l * DFF * 1024, 1024, 64 * kb, 32 * nb, 1024, (bf16_t*)(ws + WS_WT_F2) + (size_t)l * 1024 * DFF, DFF, 32 * nb, 1, scr, F.lane); continue; } r -= 2 * I_F2;
        if (r < I_DIN) { const int kb = r / 129, nb = r % 129; transpose_item(P.in[14], DN_N, 64 * kb, 32 * nb, DN_N, (bf16_t*)(ws + WS_WT_DIN), 1024, 32 * nb, 1, scr, F.lane); continue; } r -= I_DIN;
        { const int kb = r / 32, nb = r % 32; transpose_item(P.in[19], 1024, 64 * kb, 32 * nb, 1024, (bf16_t*)(ws + WS_WT_DO), 1024, 32 * nb, 1, scr, F.lane); }
    }
    {
        constexpr int N_BD = 2048 * 128, N_UQ = 512 * 128, N_PADIN = 64 * 128, N_PADD = (DN_NP - DN_N) * 128;
        for (int it = gt; it < 2 * N_BD + N_UQ + N_PADIN + N_PADD; it += NGT) {
            int r = it; u32x4 o = {0u, 0u, 0u, 0u}; bf16_t* dst;
            if (r < 2 * N_BD) { const int which = r / N_BD, q = r % N_BD, row = q >> 7, c8 = (q & 127) * 8, h = row >> 8, rr = row & 255;
                const float* src = (which ? P.in[11] : P.in[12]) + ((size_t)h * 256 + rr) * 128;
                if ((c8 >> 7) == h) { const f32x4 a = *(const f32x4*)(src + (c8 & 127)), b = *(const f32x4*)(src + (c8 & 127) + 4); o.x = pk2(a.x, a.y); o.y = pk2(a.z, a.w); o.z = pk2(b.x, b.y); o.w = pk2(b.z, b.w); }
                dst = (bf16_t*)(ws + (which ? WS_BD_UK : WS_BD_UV)) + (size_t)row * 1024 + c8;
            } else if ((r -= 2 * N_BD) < N_UQ) { const int row = r >> 7, c8 = (r & 127) * 8, h = c8 >> 7, n = c8 & 127;
                if (row < 384) { const float* src = P.in[10] + (size_t)row * 1536 + h * 192 + n; const f32x4 a = *(const f32x4*)src, b = *(const f32x4*)(src + 4); o.x = pk2(a.x, a.y); o.y = pk2(a.z, a.w); o.z = pk2(b.x, b.y); o.w = pk2(b.z, b.w); }
                dst = (bf16_t*)(ws + WS_UQN) + (size_t)row * 1024 + c8;
            } else if ((r -= N_UQ) < N_PADIN) { dst = (bf16_t*)(ws + WS_WT_IN0) + (size_t)(NIN0 + (r >> 7)) * 1024 + (r & 127) * 8;
            } else { r -= N_PADIN; dst = (bf16_t*)(ws + WS_WT_DIN) + (size_t)(DN_N + (r >> 7)) * 1024 + (r & 127) * 8; }
            *(u32x4*)dst = o;
        }
    }
    for (int it = gt; it < 2052 * 32; it += NGT) { const int pi = it >> 5, i = it & 31; const float pos = (float)(pi < SEQ ? pi : PAST + (pi - SEQ));
        const float freq = exp2f(-(float)i * (13.287712379549449f / 32.0f)); const float ang = pos * freq;
        ((f32x2*)(ws + WS_ROPE))[it] = (f32x2){cosf(ang), sinf(ang)}; }
    for (int m = gw; m < MT; m += NGW) {
        bf16_t* orow = (bf16_t*)(ws + WS_U) + (size_t)m * DM;
        if (m < MV) { const float* xrow = m < MP ? P.in[0] + (size_t)m * DM : P.in[1] + (size_t)(m - MP) * DM; rms_row_to_bf16(xrow, P.in[6], orow, F.lane); }
        else { u32x4 z = {0u, 0u, 0u, 0u}; ((u32x4*)orow)[F.lane] = z; ((u32x4*)orow)[F.lane + 64] = z; }
    }
}

__device__ __forceinline__ void m2_rows(Frame& F) {
    const Params& P = *F.p; unsigned char* ws = P.ws; OPAQUE_WS(ws);
    const int gw = F.c * NWAVES + F.wave, NGW = F.G * NWAVES, lane = F.lane;
    const float* gq = P.in[8]; const float* gkv = P.in[9];
    const f32x2* rope = (const f32x2*)(ws + WS_ROPE);
    for (int m = gw; m < MV; m += NGW) {
        const float* a = (const float*)(ws + WS_A0) + (size_t)m * NIN0P;
        float v[11];
#pragma unroll
        for (int j = 0; j < 11; ++j) v[j] = __builtin_nontemporal_load(a + lane + 64 * j);
        float sq = 0.f, sk = 0.f;
#pragma unroll
        for (int j = 0; j < 6; ++j) sq += v[j] * v[j];
#pragma unroll
        for (int j = 6; j < 10; ++j) sk += v[j] * v[j];
        const float rq = rsqrtf(wave_sum(sq) * (1.f / Q_LORA) + RMS_EPS), rk = rsqrtf(wave_sum(sk) * (1.f / KV_LORA) + RMS_EPS);
        bf16_t* cq = (bf16_t*)(ws + WS_CQ) + (size_t)m * Q_LORA;
#pragma unroll
        for (int j = 0; j < 6; ++j) cq[lane + 64 * j] = (bf16_t)f2bf(v[j] * rq * gq[lane + 64 * j]);
        float* orow = P.out + O_ROWS + (size_t)m * MLA_ROW; bf16_t* rb = (bf16_t*)(ws + WS_ROWSB) + (size_t)m * MLA_ROW;
#pragma unroll
        for (int j = 0; j < 4; ++j) { const float y = v[6 + j] * rk * gkv[lane + 64 * j]; __builtin_nontemporal_store(y, orow + lane + 64 * j); rb[lane + 64 * j] = (bf16_t)f2bf(y); }
        const int pidx = m < MP ? (m & (SEQ - 1)) : (SEQ + ((m - MP) & 3));
        const int i = lane & 31; const f32x2 cs = rope[pidx * 32 + i];
        const float other = __shfl_xor(v[10], 32);
        const float y = lane < 32 ? v[10] * cs.x - other * cs.y : v[10] * cs.x + other * cs.y;
        __builtin_nontemporal_store(y, orow + 256 + lane); rb[256 + lane] = (bf16_t)f2bf(y);
    }
}


#define LDS_BARRIER() do { asm volatile("s_waitcnt lgkmcnt(0)" ::: "memory"); __builtin_amdgcn_s_barrier(); asm volatile("" ::: "memory"); } while (0)
namespace attn {
typedef short v4i16_t __attribute__((ext_vector_type(4)));
constexpr int TILE_BYTES = 64 * 640;
__device__ __forceinline__ int koff(int row, int ch) { return 5120 * (row >> 3) + 512 * (ch >> 2) + 64 * (row & 7) + 16 * ((ch & 3) ^ ((row >> 2) & 3)); }

__device__ __forceinline__ float hmax16(float x) { float a = x, b = x; asm volatile("s_nop 1\n\tv_permlane16_swap_b32 %0, %1" : "+v"(a), "+v"(b)); return fmaxf(a, b); }
__device__ __forceinline__ float hmax32(float x) { float a = x, b = x; asm volatile("s_nop 1\n\tv_permlane32_swap_b32 %0, %1" : "+v"(a), "+v"(b)); return fmaxf(a, b); }
struct State { f32x4 o[16]; float m, l; };
struct Addr { int kb0, kb1, tb00, tb01, tb10, tb11; };
__device__ __forceinline__ Addr make_addr(int lane) {
    const int g = lane >> 4, rho = lane & 15, q4 = rho >> 2, p4 = lane & 3; Addr a;
    a.kb0 = 5120 * q4 + 64 * (rho & 3) + 16 * (g ^ (2 * (q4 & 1)));  a.kb1 = a.kb0 ^ 16;
    const int t0 = 5120 * g + 64 * q4 + 8 * (p4 & 1) + 32 * (g & 1) + 16 * (p4 >> 1);
    a.tb00 = t0; a.tb01 = t0 ^ 16; a.tb10 = t0 ^ 32; a.tb11 = t0 ^ 48;
    return a;
}
__device__ __forceinline__ void pv_load(bf16x8 (&vf)[8], const LAS unsigned char* buf, const Addr& A, int i) {
#pragma unroll
    for (int c = 0; c < 4; ++c) { const int cb = 4 * i + c;
        const LAS unsigned char* v0 = buf + ((cb & 1) ? A.tb10 : A.tb00) + 512 * (cb >> 1);
        const LAS unsigned char* v1 = buf + ((cb & 1) ? A.tb11 : A.tb01) + 512 * (cb >> 1) + 256;
#pragma unroll
        for (int ks = 0; ks < 2; ++ks) {
            const v4i16_t t0 = __builtin_amdgcn_ds_read_tr16_b64_v4i16((LAS v4i16_t*)(v0 + 20480 * ks));
            const v4i16_t t1 = __builtin_amdgcn_ds_read_tr16_b64_v4i16((LAS v4i16_t*)(v1 + 20480 * ks));
            vf[2 * c + ks] = __builtin_shufflevector(t0, t1, 0, 1, 2, 3, 4, 5, 6, 7); } }
}
__device__ __forceinline__ void pv_mma(State& st, const bf16x8 (&vf)[8], const bf16x8 (&pf)[2], int i) {
#pragma unroll
    for (int c = 0; c < 4; ++c)
#pragma unroll
        for (int ks = 0; ks < 2; ++ks) st.o[4 * i + c] = __builtin_amdgcn_mfma_f32_16x16x32_bf16(vf[2 * c + ks], pf[ks], st.o[4 * i + c], 0, 0, 0);
}
__device__ __forceinline__ void tile_scores(const LAS unsigned char* buf, const Addr& A, const bf16x8 (&qf)[10], State& st, int limit, bool need_mask, int lane, bf16x8 (&pf)[2], bf16x8 (&vf0)[8]) {
    const int g = lane >> 4;
    f32x4 sacc[4];
    __builtin_amdgcn_s_setprio(1);
    bf16x8 kf[2][5];
#pragma unroll
    for (int b = 0; b < 4; ++b) sacc[b] = (f32x4){0.f, 0.f, 0.f, 0.f};
#pragma unroll
    for (int j = 0; j < 5; ++j) kf[0][j] = *(const LAS bf16x8*)(buf + A.kb0 + 512 * j);
#pragma unroll
    for (int i = 0; i < 8; ++i) {
        if (i + 1 < 8) { const int b1 = (i + 1) >> 1; const LAS unsigned char* kp = buf + ((b1 & 1) ? A.kb1 : A.kb0) + 20480 * (b1 >> 1) + 256 * (b1 & 1) + 2560 * ((i + 1) & 1);
#pragma unroll
            for (int j = 0; j < 5; ++j) kf[(i + 1) & 1][j] = *(const LAS bf16x8*)(kp + 512 * j); }
        __builtin_amdgcn_sched_barrier(0);
#pragma unroll
        for (int j = 0; j < 5; ++j) sacc[i >> 1] = __builtin_amdgcn_mfma_f32_16x16x32_bf16(kf[i & 1][j], qf[5 * (i & 1) + j], sacc[i >> 1], 0, 0, 0);
        __builtin_amdgcn_sched_barrier(0);
    }
    __builtin_amdgcn_s_setprio(0);
    if (need_mask) {
#pragma unroll
        for (int b = 0; b < 4; ++b)
#pragma unroll
            for (int r = 0; r < 4; ++r) { const int key = 32 * (b >> 1) + 8 * g + 4 * (b & 1) + r; sacc[b][r] = key > limit ? -1e30f : sacc[b][r]; }
    }
    float mx = fmaxf(fmaxf(fmaxf(sacc[0][0], sacc[0][1]), fmaxf(sacc[0][2], sacc[0][3])), fmaxf(fmaxf(sacc[1][0], sacc[1][1]), fmaxf(sacc[1][2], sacc[1][3])));
    mx = fmaxf(mx, fmaxf(fmaxf(fmaxf(sacc[2][0], sacc[2][1]), fmaxf(sacc[2][2], sacc[2][3])), fmaxf(fmaxf(sacc[3][0], sacc[3][1]), fmaxf(sacc[3][2], sacc[3][3]))));
    mx = hmax16(mx); mx = hmax32(mx);
    __builtin_amdgcn_sched_barrier(0);
    pv_load(vf0, buf, A, 0);
    __builtin_amdgcn_sched_barrier(0);
    if (!__all(mx - st.m <= 6.0f)) {
        const float mnew = fmaxf(st.m, mx), alpha = __builtin_amdgcn_exp2f(st.m - mnew); st.m = mnew;
        st.l *= alpha;
#pragma unroll
        for (int cb = 0; cb < 16; ++cb) st.o[cb] = st.o[cb] * alpha;
    }
    float ps = 0.f;
#pragma unroll
    for (int b = 0; b < 4; ++b)
#pragma unroll
        for (int r = 0; r < 4; ++r) { const float p = __builtin_amdgcn_exp2f(sacc[b][r] - st.m); sacc[b][r] = p; ps += p; }
    st.l += ps;
#pragma unroll
    for (int ks = 0; ks < 2; ++ks) { u32x4 w; w.x = cvt_pk_bf16(sacc[2 * ks][0], sacc[2 * ks][1]); w.y = cvt_pk_bf16(sacc[2 * ks][2], sacc[2 * ks][3]);
        w.z = cvt_pk_bf16(sacc[2 * ks + 1][0], sacc[2 * ks + 1][1]); w.w = cvt_pk_bf16(sacc[2 * ks + 1][2], sacc[2 * ks + 1][3]); pf[ks] = __builtin_bit_cast(bf16x8, w); }
}
__device__ __forceinline__ void tile_pv(const LAS unsigned char* buf, const Addr& A, State& st, const bf16x8 (&pf)[2], bf16x8 (&vf0)[8]) {
    bf16x8 vf1[8];
    __builtin_amdgcn_s_setprio(1);
    pv_load(vf1, buf, A, 1); __builtin_amdgcn_sched_barrier(0); pv_mma(st, vf0, pf, 0); __builtin_amdgcn_sched_barrier(0);
    pv_load(vf0, buf, A, 2); __builtin_amdgcn_sched_barrier(0); pv_mma(st, vf1, pf, 1); __builtin_amdgcn_sched_barrier(0);
    pv_load(vf1, buf, A, 3); __builtin_amdgcn_sched_barrier(0); pv_mma(st, vf0, pf, 2); __builtin_amdgcn_sched_barrier(0);
    pv_mma(st, vf1, pf, 3);
    __builtin_amdgcn_s_setprio(0);
}
__device__ __forceinline__ void load_q(bf16x8 (&qf)[10], const bf16_t* Q, int row, int h, int g) {
    const bf16_t* qr = Q + (size_t)row * NQ;
#pragma unroll
    for (int s = 0; s < 8; ++s) qf[s] = __builtin_nontemporal_load((const bf16x8*)(qr + h * 256 + 32 * s + 8 * g));
#pragma unroll
    for (int s = 0; s < 2; ++s) qf[8 + s] = __builtin_nontemporal_load((const bf16x8*)(qr + 2048 + h * 64 + 32 * s + 8 * g));
}
__device__ __forceinline__ void state_init(State& st) {
#pragma unroll
    for (int cb = 0; cb < 16; ++cb) st.o[cb] = (f32x4){0.f, 0.f, 0.f, 0.f};
    st.m = -1e30f; st.l = 0.f;
}
__device__ __forceinline__ int stage_lds_off(int tid) { const int row = tid >> 3; return 5120 * (row >> 3) + 64 * (row & 7) + 512 * ((tid & 7) >> 2) + 16 * ((tid & 3) ^ ((row >> 2) & 3)); }
__device__ __forceinline__ void prompt_unit(Frame& F, int b, int qb) {
    unsigned char* ws = F.p->ws; OPAQUE_WS(ws); int tid = F.tid; asm volatile("" : "+v"(tid));
    const int lane = tid & 63, h = F.wave, g = lane >> 4, qi = lane & 15;
    const int p0 = 16 * qb, nt = (p0 + 15) / 64 + 1;
    const unsigned char* rows = (const unsigned char*)((const bf16_t*)(ws + WS_ROWSB) + (size_t)b * SEQ * MLA_ROW) + (tid >> 3) * 640 + (tid & 7) * 16;
    const int soff = stage_lds_off(tid);
    bf16x8 qf[10]; load_q(qf, (const bf16_t*)(ws + WS_Q), b * SEQ + p0 + qi, h, g);
    State st; state_init(st); const Addr AD = make_addr(lane);
    u32x4 pre[3];
#pragma unroll
    for (int j = 0; j < 5; ++j) *(LAS u32x4*)(F.lds + soff + 1024 * j) = *(const u32x4*)(rows + 128 * j);
    LDS_BARRIER();
    for (int kt = 0; kt < nt; ++kt) {
        const LAS unsigned char* buf = F.lds + (kt & 1) * TILE_BYTES; LAS unsigned char* nbuf = F.lds + ((kt + 1) & 1) * TILE_BYTES + soff;
        const bool more = kt + 1 < nt; const unsigned char* src = rows + (size_t)(more ? kt + 1 : kt) * (64 * 640);
        bf16x8 pf[2], vf0[8];
#pragma unroll
        for (int j = 0; j < 3; ++j) pre[j] = *(const u32x4*)(src + 128 * j);
        __builtin_amdgcn_sched_barrier(0);
        tile_scores(buf, AD, qf, st, p0 + qi - 64 * kt, 64 * kt + 63 > p0, lane, pf, vf0);
        if (more) {
#pragma unroll
            for (int j = 0; j < 3; ++j) *(LAS u32x4*)(nbuf + 1024 * j) = pre[j];
        }
#pragma unroll
        for (int j = 0; j < 2; ++j) pre[j] = *(const u32x4*)(src + 128 * (3 + j));
        __builtin_amdgcn_sched_barrier(0);
        tile_pv(buf, AD, st, pf, vf0);
        if (more) {
#pragma unroll
            for (int j = 0; j < 2; ++j) *(LAS u32x4*)(nbuf + 1024 * (3 + j)) = pre[j];
        }
        LDS_BARRIER();
    }
    float l = st.l; l += __shfl_xor(l, 16); l += __shfl_xor(l, 32);
    const float inv = 1.f / l;
    bf16_t* orow = (bf16_t*)(ws + WS_OL) + (size_t)(b * SEQ + p0 + qi) * 2048 + h * 256 + 4 * g;
#pragma unroll
    for (int cb = 0; cb < 16; ++cb) { u32x2 w; w.x = cvt_pk_bf16(st.o[cb][0] * inv, st.o[cb][1] * inv); w.y = cvt_pk_bf16(st.o[cb][2] * inv, st.o[cb][3] * inv); *(u32x2*)(orow + 16 * cb) = w; }
}
__device__ __forceinline__ void cache_load10(f32x4 (&pre)[10], const float* src) {
#pragma unroll
    for (int k = 0; k < 10; ++k) pre[k] = __builtin_nontemporal_load((const f32x4*)(src + 32 * k));
}
__device__ __forceinline__ void cache_store10(const f32x4 (&pre)[10], LAS unsigned char* dst) {
#pragma unroll
    for (int k = 0; k < 10; ++k) { u32x2 w; w.x = cvt_pk_bf16(pre[k][0], pre[k][1]); w.y = cvt_pk_bf16(pre[k][2], pre[k][3]); *(LAS u32x2*)(dst + 512 * k) = w; }
}
template <int J0, int J1>
__device__ __forceinline__ void load_cache_part(f32x4 (&pre)[10], const float* src) {
#pragma unroll
    for (int j = J0; j < J1; ++j) { pre[2 * (j - J0)] = *(const f32x4*)(src + 64 * j); pre[2 * (j - J0) + 1] = *(const f32x4*)(src + 64 * j + 4); }
}
template <int J0, int J1>
__device__ __forceinline__ void store_cache_part(const f32x4 (&pre)[10], LAS unsigned char* dst) {
#pragma unroll
    for (int j = J0; j < J1; ++j) { const int k = 2 * (j - J0); u32x4 w; w.x = cvt_pk_bf16(pre[k][0], pre[k][1]); w.y = cvt_pk_bf16(pre[k][2], pre[k][3]);
        w.z = cvt_pk_bf16(pre[k + 1][0], pre[k + 1][1]); w.w = cvt_pk_bf16(pre[k + 1][2], pre[k + 1][3]); *(LAS u32x4*)(dst + 1024 * j) = w; }
}
__device__ __forceinline__ const float* cache_tile_src(const float* cache, int pgv, int kt) {
    const int page = __builtin_amdgcn_readlane(pgv, kt >> 1);
    return cache + ((size_t)page * PAGE + (kt & 1) * 64) * MLA_ROW;
}
__device__ __forceinline__ void samp_tile(const LAS unsigned char* buf, const Addr& A, const bf16x8 (&qf)[10], State& st, int kb, int limit, bool need_mask, int lane) {
    const int g = lane >> 4;
    f32x4 sacc = {0.f, 0.f, 0.f, 0.f};
    const LAS unsigned char* kp = buf + ((kb & 1) ? A.kb1 : A.kb0) + 20480 * (kb >> 1) + 256 * (kb & 1);
#pragma unroll
    for (int s = 0; s < 10; ++s) { const bf16x8 kf = *(const LAS bf16x8*)(kp + 512 * s); sacc = __builtin_amdgcn_mfma_f32_16x16x32_bf16(kf, qf[s], sacc, 0, 0, 0); }
    if (need_mask) {
#pragma unroll
        for (int r = 0; r < 4; ++r) { const int key = 32 * (kb >> 1) + 8 * g + 4 * (kb & 1) + r; sacc[r] = key > limit ? -1e30f : sacc[r]; }
    }
    float mx = fmaxf(fmaxf(sacc[0], sacc[1]), fmaxf(sacc[2], sacc[3]));
    mx = hmax16(mx); mx = hmax32(mx);
    if (!__all(mx - st.m <= 6.0f)) {
        const float mnew = fmaxf(st.m, mx), alpha = __builtin_amdgcn_exp2f(st.m - mnew); st.m = mnew; st.l *= alpha;
#pragma unroll
        for (int cb = 0; cb < 16; ++cb) st.o[cb] = st.o[cb] * alpha;
    }
    float p[4];
#pragma unroll
    for (int r = 0; r < 4; ++r) p[r] = __builtin_amdgcn_exp2f(sacc[r] - st.m);
    st.l += (p[0] + p[1]) + (p[2] + p[3]);
    const unsigned w0 = cvt_pk_bf16(p[0], p[1]), w1 = cvt_pk_bf16(p[2], p[3]);
    const u32x4 pw = (kb & 1) ? (u32x4){0u, 0u, w0, w1} : (u32x4){w0, w1, 0u, 0u};
    const bf16x8 pf = __builtin_bit_cast(bf16x8, pw);
#pragma unroll
    for (int cb = 0; cb < 16; ++cb) {
        const LAS unsigned char* vp = buf + ((cb & 1) ? ((kb & 1) ? A.tb11 : A.tb10) : ((kb & 1) ? A.tb01 : A.tb00)) + 512 * (cb >> 1) + 256 * (kb & 1) + 20480 * (kb >> 1);
        const v4i16_t t0 = __builtin_amdgcn_ds_read_tr16_b64_v4i16((LAS v4i16_t*)vp);
        const bf16x8 vf = __builtin_shufflevector(t0, t0, 0, 1, 2, 3, 4, 5, 6, 7);
        st.o[cb] = __builtin_amdgcn_mfma_f32_16x16x32_bf16(vf, pf, st.o[cb], 0, 0, 0);
    }
}
__device__ __forceinline__ void sample_unit(Frame& F, int sb, int split) {
    unsigned char* ws = F.p->ws; OPAQUE_WS(ws); int tid = F.tid; asm volatile("" : "+v"(tid));
    const int lane = tid & 63, w = F.wave, g = lane >> 4, qi = lane & 15;
    const float* cache = F.p->in[2]; const int* pt = F.p->page_table;
    const int hg = w & 1, kb = w >> 1, head = 4 * hg + (qi >> 2), tq = qi & 3;
    bf16x8 qf[10]; load_q(qf, (const bf16_t*)(ws + WS_Q), MP + sb * DECS + tq, head, g);
    State st; state_init(st); const Addr AD = make_addr(lane);
    f32x4 pre[10];
    const int soff = stage_lds_off(tid);
    const int crow = tid >> 3, cq = tid & 7, goff = crow * MLA_ROW + 4 * cq, coff = 5120 * (crow >> 3) + 64 * (crow & 7) + 16 * ((cq >> 1) ^ ((crow >> 2) & 3)) + 8 * (cq & 1);
    const int pgv = pt[sb * NPAGES + 16 * split + (lane & 15)];
    { const float* src = cache_tile_src(cache, pgv, 0) + goff;
      cache_load10(pre, src); cache_store10(pre, F.lds + coff);
      cache_load10(pre, cache_tile_src(cache, pgv, 1) + goff); }
    __builtin_amdgcn_sched_barrier(0);
    LDS_BARRIER();
    constexpr int NT = 32;
    for (int kt = 0; kt < NT; ++kt) {
        const LAS unsigned char* buf = F.lds + (kt & 1) * TILE_BYTES; LAS unsigned char* nbuf = F.lds + ((kt + 1) & 1) * TILE_BYTES + coff;
        samp_tile(buf, AD, qf, st, kb, 63, false, lane);
        __builtin_amdgcn_sched_barrier(0);
        if (kt + 1 < NT) cache_store10(pre, nbuf);
        if (kt + 2 < NT) cache_load10(pre, cache_tile_src(cache, pgv, kt + 2) + goff);
        __builtin_amdgcn_sched_barrier(0);
        LDS_BARRIER();
    }
    if (split == 7) {
        const bf16_t* rows = (const bf16_t*)(ws + WS_ROWSB) + (size_t)(MP + sb * DECS) * MLA_ROW;
        unsigned zr = 0u; asm volatile("" : "+v"(zr));
#pragma unroll
        for (int j = 0; j < 5; ++j) { const int row = tid >> 3; u32x4 wv = {zr, zr, zr, zr}; if (row < 4) wv = *(const u32x4*)(rows + (size_t)row * MLA_ROW + ((tid & 7) + 8 * j) * 8); *(LAS u32x4*)(F.lds + soff + 1024 * j) = wv; }
        __syncthreads();
        if (kb == 0) samp_tile(F.lds, AD, qf, st, 0, tq, true, lane);
        __syncthreads();
    }
    float l = st.l; l += __shfl_xor(l, 16); l += __shfl_xor(l, 32);
    LAS float* OB = (LAS float*)F.lds; LAS float* MLB = (LAS float*)(F.lds + 131072);
#pragma unroll
    for (int cb = 0; cb < 16; ++cb) *(LAS f32x4*)(OB + (w * 16 + qi) * 256 + 16 * cb + 4 * g) = st.o[cb];
    if (g == 0) { MLB[(w * 16 + qi) * 2] = st.m; MLB[(w * 16 + qi) * 2 + 1] = l; }
    __syncthreads();
    {   const int hg2 = tid >> 8, q = (tid >> 4) & 15, c0 = (tid & 15) * 16;
        float ms[4], ls[4], mt = -1e30f;
#pragma unroll
        for (int k = 0; k < 4; ++k) { const int ww = 2 * k + hg2; ms[k] = MLB[(ww * 16 + q) * 2]; ls[k] = MLB[(ww * 16 + q) * 2 + 1]; mt = fmaxf(mt, ms[k]); }
        float L = 0.f; f32x4 acc[4];
#pragma unroll
        for (int j = 0; j < 4; ++j) acc[j] = (f32x4){0.f, 0.f, 0.f, 0.f};
#pragma unroll
        for (int k = 0; k < 4; ++k) { const int ww = 2 * k + hg2; const float wt = __builtin_amdgcn_exp2f(ms[k] - mt); L += wt * ls[k];
#pragma unroll
            for (int j = 0; j < 4; ++j) { const f32x4 v = *(const LAS f32x4*)(OB + (ww * 16 + q) * 256 + c0 + 4 * j); acc[j] = acc[j] + v * wt; } }
        const int hd = 4 * hg2 + (q >> 2), t = q & 3;
        float* po = (float*)(ws + WS_PART) + ((((size_t)sb * 8 + split) * 8 + hd) * 4 + t) * 256 + c0;
#pragma unroll
        for (int j = 0; j < 4; ++j) *(f32x4*)(po + 4 * j) = acc[j];
        if (c0 == 0) { float* ml = (float*)(ws + WS_ML) + ((((size_t)sb * 8 + split) * 8 + hd) * 4 + t) * 2; ml[0] = mt; ml[1] = L; }
    }
    __syncthreads();
}
__device__ __forceinline__ void sample_combine(Frame& F, int sb) {
    unsigned char* ws = F.p->ws; const int tid = F.tid;
    {
        const int row = tid >> 4, c0 = (tid & 15) * 16, hh = row >> 2, t = row & 3;
        float ms[8], ls[8], mt = -1e30f;
#pragma unroll
        for (int s = 0; s < 8; ++s) { const float* ml = (const float*)(ws + WS_ML) + ((((size_t)sb * 8 + s) * 8 + hh) * 4 + t) * 2;
            ms[s] = ml[0]; ls[s] = ml[1]; mt = fmaxf(mt, ms[s]); }
        float L = 0.f; f32x4 acc[4];
#pragma unroll
        for (int j = 0; j < 4; ++j) acc[j] = (f32x4){0.f, 0.f, 0.f, 0.f};
#pragma unroll
        for (int s = 0; s < 8; ++s) { const float w = __builtin_amdgcn_exp2f(ms[s] - mt); L += w * ls[s];
            const float* po = (const float*)(ws + WS_PART) + ((((size_t)sb * 8 + s) * 8 + hh) * 4 + t) * 256 + c0;
#pragma unroll
            for (int j = 0; j < 4; ++j) { const f32x4 v = *(const f32x4*)(po + 4 * j); acc[j] = acc[j] + v * w; } }
        const float inv = 1.f / L;
        bf16_t* orow = (bf16_t*)(ws + WS_OL) + (size_t)(MP + sb * DECS + t) * 2048 + hh * 256 + c0;
#pragma unroll
        for (int j = 0; j < 2; ++j) { u32x4 w; w.x = cvt_pk_bf16(acc[2 * j][0] * inv, acc[2 * j][1] * inv); w.y = cvt_pk_bf16(acc[2 * j][2] * inv, acc[2 * j][3] * inv);
            w.z = cvt_pk_bf16(acc[2 * j + 1][0] * inv, acc[2 * j + 1][1] * inv); w.w = cvt_pk_bf16(acc[2 * j + 1][2] * inv, acc[2 * j + 1][3] * inv); *(u32x4*)(orow + 8 * j) = w; }
    }
}
__device__ __forceinline__ void phase(Frame& F) {
    const int slot = (F.c >> 3) % 3; int done = 0;
    if (slot == 0) { for (int S = F.c; S < DECB * 8; S += F.G) sample_unit(F, S >> 3, S & 7); done = 1; }
    int np = 0;
    for (int L = F.c; L < 512; L += F.G) {
        const int b = L % 8, j = L / 8;
        prompt_unit(F, b, j); prompt_unit(F, b, 127 - j); ++np;
        if (!done && slot == 1 && np == 1) { for (int S = F.c; S < DECB * 8; S += F.G) sample_unit(F, S >> 3, S & 7); done = 1; }
    }
    if (!done) for (int S = F.c; S < DECB * 8; S += F.G) sample_unit(F, S >> 3, S & 7);
}
}


__device__ __forceinline__ void unpack8(const u32x4 v, float (&o)[8]) {
#pragma unroll
    for (int c = 0; c < 4; ++c) { o[2 * c] = __builtin_bit_cast(float, v[c] << 16); o[2 * c + 1] = __builtin_bit_cast(float, v[c] & 0xffff0000u); }
}
template <int R>
__device__ __forceinline__ void rowpass_rows(const Params& P, const int (&mrow)[R], bool first, bool last, const float* wa, const float* wb, int nslab, int lane) {
    unsigned char* ws = P.ws;
    float v[R][2][8], hv[R][2][8];
#pragma unroll
    for (int r = 0; r < R; ++r) { const int m = mrow[r];
        if (m < MP) { const u32x4* mr = (const u32x4*)((const bf16_t*)(ws + WS_MIX) + (size_t)m * DM) + lane; unpack8(__builtin_nontemporal_load(mr), v[r][0]); unpack8(__builtin_nontemporal_load(mr + 64), v[r][1]); }
        else {
#pragma unroll
            for (int j = 0; j < 2; ++j)
#pragma unroll
                for (int i = 0; i < 8; ++i) v[r][j][i] = 0.f;
            for (int z = 0; z < nslab; ++z) { const f32x4* mr = (const f32x4*)((const float*)(ws + WS_SLAB) + ((size_t)z * 128 + (m - MP)) * DM) + 2 * lane;
#pragma unroll
                for (int j = 0; j < 2; ++j) { const f32x4 a = mr[128 * j], b = mr[128 * j + 1]; v[r][j][0] += a.x; v[r][j][1] += a.y; v[r][j][2] += a.z; v[r][j][3] += a.w; v[r][j][4] += b.x; v[r][j][5] += b.y; v[r][j][6] += b.z; v[r][j][7] += b.w; } } }
        if (first) { const f32x4* hr = (const f32x4*)(m < MP ? P.in[0] + (size_t)m * DM : P.in[1] + (size_t)(m - MP) * DM) + 2 * lane;
#pragma unroll
            for (int j = 0; j < 2; ++j) { const f32x4 a = __builtin_nontemporal_load(hr + 128 * j), b = __builtin_nontemporal_load(hr + 128 * j + 1); hv[r][j][0] = a.x; hv[r][j][1] = a.y; hv[r][j][2] = a.z; hv[r][j][3] = a.w; hv[r][j][4] = b.x; hv[r][j][5] = b.y; hv[r][j][6] = b.z; hv[r][j][7] = b.w; }
        } else { const u32x4* hr = (const u32x4*)((const bf16_t*)(ws + WS_HB) + (size_t)m * DM) + lane; unpack8(__builtin_nontemporal_load(hr), hv[r][0]); unpack8(__builtin_nontemporal_load(hr + 64), hv[r][1]); } }
    float s[R];
#pragma unroll
    for (int r = 0; r < R; ++r) { s[r] = 0.f;
#pragma unroll
        for (int j = 0; j < 2; ++j)
#pragma unroll
            for (int i = 0; i < 8; ++i) s[r] += v[r][j][i] * v[r][j][i]; }
#pragma unroll
    for (int o = 1; o < 16; o <<= 1)
#pragma unroll
        for (int r = 0; r < R; ++r) s[r] += __shfl_xor(s[r], o);
#pragma unroll
    for (int r = 0; r < R; ++r) s[r] = xsum32(xsum16(s[r]));
    float s2[R];
#pragma unroll
    for (int r = 0; r < R; ++r) { const float rs = rsqrtf(s[r] * (1.f / DM) + RMS_EPS); s2[r] = 0.f;
#pragma unroll
        for (int j = 0; j < 2; ++j) { const f32x4 g0 = ((const f32x4*)wa)[2 * lane + 128 * j], g1 = ((const f32x4*)wa)[2 * lane + 128 * j + 1];
            const float g[8] = {g0.x, g0.y, g0.z, g0.w, g1.x, g1.y, g1.z, g1.w};
#pragma unroll
            for (int i = 0; i < 8; ++i) { v[r][j][i] = hv[r][j][i] + v[r][j][i] * rs * g[i]; s2[r] += v[r][j][i] * v[r][j][i]; } }
        const int m = mrow[r];
        if (last) { f32x4* yr = (f32x4*)(P.out + O_Y + (size_t)m * DM) + 2 * lane;
#pragma unroll
            for (int j = 0; j < 2; ++j) { __builtin_nontemporal_store((f32x4){v[r][j][0], v[r][j][1], v[r][j][2], v[r][j][3]}, yr + 128 * j); __builtin_nontemporal_store((f32x4){v[r][j][4], v[r][j][5], v[r][j][6], v[r][j][7]}, yr + 128 * j + 1); }
        } else { u32x4* hb = (u32x4*)((bf16_t*)(ws + WS_HB) + (size_t)m * DM) + lane;
#pragma unroll
            for (int j = 0; j < 2; ++j) hb[64 * j] = (u32x4){cvt_pk_bf16(v[r][j][0], v[r][j][1]), cvt_pk_bf16(v[r][j][2], v[r][j][3]), cvt_pk_bf16(v[r][j][4], v[r][j][5]), cvt_pk_bf16(v[r][j][6], v[r][j][7])}; } }
    if (wb) {
#pragma unroll
        for (int o = 1; o < 16; o <<= 1)
#pragma unroll
            for (int r = 0; r < R; ++r) s2[r] += __shfl_xor(s2[r], o);
#pragma unroll
        for (int r = 0; r < R; ++r) s2[r] = xsum32(xsum16(s2[r]));
#pragma unroll
        for (int r = 0; r < R; ++r) { const float r2 = rsqrtf(s2[r] * (1.f / DM) + RMS_EPS);
            u32x4* ur = (u32x4*)((bf16_t*)(ws + WS_U) + (size_t)mrow[r] * DM) + lane;
#pragma unroll
            for (int j = 0; j < 2; ++j) { const f32x4 g0 = ((const f32x4*)wb)[2 * lane + 128 * j], g1 = ((const f32x4*)wb)[2 * lane + 128 * j + 1];
                ur[64 * j] = (u32x4){cvt_pk_bf16(v[r][j][0] * r2 * g0.x, v[r][j][1] * r2 * g0.y), cvt_pk_bf16(v[r][j][2] * r2 * g0.z, v[r][j][3] * r2 * g0.w), cvt_pk_bf16(v[r][j][4] * r2 * g1.x, v[r][j][5] * r2 * g1.y), cvt_pk_bf16(v[r][j][6] * r2 * g1.z, v[r][j][7] * r2 * g1.w)}; } } }
}
__device__ __forceinline__ void rowpass(Frame& F, bool first, bool last, const float* wa, const float* wb, int nslab) {
    const Params& P = *F.p; int lane = F.lane; asm volatile("" : "+v"(lane));
    const int gw = F.c * NWAVES + F.wave, NGW = F.G * NWAVES;
    for (int p = gw; p < MP / 4; p += NGW) { const int mr[4] = {4 * p, 4 * p + 1, 4 * p + 2, 4 * p + 3}; rowpass_rows<4>(P, mr, first, last, wa, wb, nslab, lane); }
    for (int m = MP + gw; m < MV; m += NGW) { const int mr[1] = {m}; rowpass_rows<1>(P, mr, first, last, wa, wb, nslab, lane); }
}


namespace dn {
constexpr int SP = 132;
constexpr int L_S = 0;
constexpr int L_KB = 3 * 64 * SP * 4;
constexpr int L_QB = L_KB + 64 * 272;
constexpr int L_G = L_QB + 64 * 272;
constexpr int LP = 68;
constexpr int L_LB = L_G + 512;
constexpr int L_ST = L_KB;
static_assert(L_LB + 32 * 80 <= 131072 + 8192 && 256 * 80 <= 2 * 64 * 272, "dn LDS map");
__device__ __forceinline__ float silu(float x) { return x * __builtin_amdgcn_rcpf(1.f + __expf(-x)); }
__device__ __forceinline__ void gated_norm_row(unsigned char* ws, const float* gout, size_t row, int h, int lane) {
    const unsigned ov = *(const unsigned*)((const bf16_t*)(ws + WS_DO) + row * 1024 + h * 128 + 2 * lane);
    const unsigned zv = *(const unsigned*)((const bf16_t*)(ws + WS_PROJ) + row * DN_NP + 3072 + h * 128 + 2 * lane);
    const float o0 = __builtin_bit_cast(float, ov << 16), o1 = __builtin_bit_cast(float, ov & 0xffff0000u);
    const float z0 = __builtin_bit_cast(float, zv << 16), z1 = __builtin_bit_cast(float, zv & 0xffff0000u);
    const float rs = rsqrtf(wave_sum(o0 * o0 + o1 * o1) * (1.f / 128.f) + RMS_EPS);
    const f32x2 g = *(const f32x2*)(gout + 2 * lane);
    *(unsigned*)((bf16_t*)(ws + WS_DOG) + row * 1024 + h * 128 + 2 * lane) = cvt_pk_bf16(o0 * rs * g.x * silu(z0), o1 * rs * g.y * silu(z1));
}

struct ConvPre { u32x4 x[11]; bf16_t gb, ga; };
template <int I0, int I1, bool GATES>
__device__ __forceinline__ void conv_load_part(ConvPre& R, const bf16_t* proj, int b, int n, int tid, int h) {
    const int cgp = tid % 48, tg = tid / 48, part = cgp >> 4, d0 = (cgp & 15) * 8, col = part * 1024 + h * 128 + d0;
#pragma unroll
    for (int i = I0; i < I1; ++i) { int tok = n * CHUNK + 8 * tg - 3 + i; u32x4 v = {0u, 0u, 0u, 0u};
        int cl = col; if (tid >= 384) { tok = n * CHUNK; cl = h * 128; }
        if (tok >= 0) v = __builtin_nontemporal_load((const u32x4*)(proj + ((size_t)b * SEQ + tok) * DN_NP + cl));
        R.x[i] = v; }
    if (GATES) { const bf16_t* pr = proj + ((size_t)b * SEQ + n * CHUNK + (tid & 63)) * DN_NP + 4096 + h; R.gb = pr[0]; R.ga = pr[8]; }
}
__device__ __forceinline__ void conv_load(ConvPre& R, const bf16_t* proj, int b, int n, int tid, int h) { conv_load_part<0, 11, true>(R, proj, b, n, tid, h); }
__device__ __forceinline__ void chunk_phase(Frame& F) {
    const Params& P = *F.p; unsigned char* ws = P.ws; OPAQUE_WS(ws); int tid = F.tid; asm volatile("" : "+v"(tid));
    const int lane = tid & 63, wave = __builtin_amdgcn_readfirstlane(tid >> 6);
    LAS float* S = (LAS float*)(F.lds + L_S); LAS float* GB = (LAS float*)(F.lds + L_G);
    const bf16_t* proj = (const bf16_t*)(ws + WS_PROJ);
    const int h = F.c & 7; const int nun = (256 - (F.c >> 3) + (F.G >> 3) - 1) / (F.G >> 3);
    if ((F.G & 7) != 0 || nun <= 0) return;
    constexpr int L_CW = 131072 + 8192 + 256;
    LAS float* CW = (LAS float*)(F.lds + L_CW);
    for (int i = tid; i < 4 * 384; i += NTHREADS) { const int j = i / 384, cc = i % 384; CW[i] = P.in[15][j * DN_QKV + (cc >> 7) * 1024 + h * 128 + (cc & 127)]; }
    __syncthreads();
    ConvPre pre;
    { const int idx = F.c >> 3; conv_load(pre, proj, idx >> 5, idx & 31, tid, h); }
    const int tid0 = tid;
    for (int k = 0; k < nun; ++k) {
        int tid = tid0; asm volatile("" : "+v"(tid));
        const int lane = tid & 63;
        const int cgp = tid % 48, tg = tid / 48, part = cgp >> 4, d0c = (cgp & 15) * 8, col = part * 1024 + h * 128 + d0c;
        const int idx = (F.c >> 3) + k * (F.G >> 3), b = idx >> 5, n = idx & 31;
        const int t0 = n * CHUNK; const size_t row0 = (size_t)b * SEQ + t0; const int unit = (b * 8 + h) * 32 + n;
        if (tid < 384) {
#pragma unroll
            for (int c2 = 0; c2 < 4; ++c2) {
                float x0[11], x1[11], w0[4], w1[4];
#pragma unroll
                for (int i = 0; i < 11; ++i) { x0[i] = __builtin_bit_cast(float, pre.x[i][c2] << 16); x1[i] = __builtin_bit_cast(float, pre.x[i][c2] & 0xffff0000u); }
#pragma unroll
                for (int j = 0; j < 4; ++j) { const f32x2 wv = *(const LAS f32x2*)(CW + j * 384 + part * 128 + d0c + 2 * c2); w0[j] = wv.x; w1[j] = wv.y; }
#pragma unroll
                for (int tt = 0; tt < 8; ++tt) { float a0 = 0.f, a1 = 0.f;
#pragma unroll
                    for (int j = 0; j < 4; ++j) { a0 += w0[j] * x0[tt + j]; a1 += w1[j] * x1[tt + j]; }
                    *(LAS f32x2*)(S + (part * 64 + 8 * tg + tt) * SP + d0c + 2 * c2) = (f32x2){silu(a0), silu(a1)}; }
                if (n == 31 && tg == 7) {
#pragma unroll
                    for (int r = 0; r < 3; ++r) *(f32x2*)(P.out + O_CP + ((size_t)b * 3 + r) * DN_QKV + col + 2 * c2) = (f32x2){x0[8 + r], x1[8 + r]}; }
            }
        }
        if (wave == 7) {
            const float braw = bf2f(pre.gb), araw = bf2f(pre.ga);
            const float beta = 1.f / (1.f + __expf(-braw));
            const float xs = araw + P.in[17][h]; const float sp = xs > 20.f ? xs : log1pf(__expf(xs));
            float g = -__expf(P.in[16][h]) * sp;
#pragma unroll
            for (int o = 1; o < 64; o <<= 1) { const float t = __shfl_up(g, o); if (lane >= o) g += t; }
            GB[lane] = beta; GB[64 + lane] = g;
        }
        LDS_BARRIER();
        const int nidx = k + 1 < nun ? idx + (F.G >> 3) : idx;
        conv_load_part<0, 4, false>(pre, proj, nidx >> 5, nidx & 31, tid, h);
        {   const int r = tid >> 2, qd = tid & 3; LAS float* rp = S + r * SP + 4 * qd;
            f32x4 a[8]; float ss = 0.f;
#pragma unroll
            for (int j = 0; j < 8; ++j) { a[j] = *(const LAS f32x4*)(rp + 16 * j); ss += (a[j].x * a[j].x + a[j].y * a[j].y) + (a[j].z * a[j].z + a[j].w * a[j].w); }
            ss += __shfl_xor(ss, 1); ss += __shfl_xor(ss, 2);
            float sc = rsqrtf(ss + L2_EPS); if (r < 64) sc *= 0.08838834764831845f;
#pragma unroll
            for (int j = 0; j < 8; ++j) *(LAS f32x4*)(rp + 16 * j) = a[j] * sc;
        }
        LDS_BARRIER();
        conv_load_part<4, 8, false>(pre, proj, nidx >> 5, nidx & 31, tid, h);
        const float gl = GB[64 + 63];
        {   const int t = tid >> 3, d0 = (tid & 7) * 16; const float eg = __expf(GB[64 + t]);
            const LAS float* qp = S + t * SP + d0; const LAS float* kp = S + (64 + t) * SP + d0;
            float q[16], kk[16];
#pragma unroll
            for (int j = 0; j < 4; ++j) { const f32x4 a = *(const LAS f32x4*)(qp + 4 * j), c = *(const LAS f32x4*)(kp + 4 * j); q[4 * j] = a.x; q[4 * j + 1] = a.y; q[4 * j + 2] = a.z; q[4 * j + 3] = a.w; kk[4 * j] = c.x; kk[4 * j + 1] = c.y; kk[4 * j + 2] = c.z; kk[4 * j + 3] = c.w; }
            u32x4 w0, w1;
            w0 = (u32x4){cvt_pk_bf16(q[0], q[1]), cvt_pk_bf16(q[2], q[3]), cvt_pk_bf16(q[4], q[5]), cvt_pk_bf16(q[6], q[7])}; w1 = (u32x4){cvt_pk_bf16(q[8], q[9]), cvt_pk_bf16(q[10], q[11]), cvt_pk_bf16(q[12], q[13]), cvt_pk_bf16(q[14], q[15])};
            *(LAS u32x4*)(F.lds + L_QB + t * 272 + d0 * 2) = w0; *(LAS u32x4*)(F.lds + L_QB + t * 272 + d0 * 2 + 16) = w1;
            w0 = (u32x4){cvt_pk_bf16(kk[0], kk[1]), cvt_pk_bf16(kk[2], kk[3]), cvt_pk_bf16(kk[4], kk[5]), cvt_pk_bf16(kk[6], kk[7])}; w1 = (u32x4){cvt_pk_bf16(kk[8], kk[9]), cvt_pk_bf16(kk[10], kk[11]), cvt_pk_bf16(kk[12], kk[13]), cvt_pk_bf16(kk[14], kk[15])};
            *(LAS u32x4*)(F.lds + L_KB + t * 272 + d0 * 2) = w0; *(LAS u32x4*)(F.lds + L_KB + t * 272 + d0 * 2 + 16) = w1;
            w0 = (u32x4){cvt_pk_bf16(q[0] * eg, q[1] * eg), cvt_pk_bf16(q[2] * eg, q[3] * eg), cvt_pk_bf16(q[4] * eg, q[5] * eg), cvt_pk_bf16(q[6] * eg, q[7] * eg)};
            w1 = (u32x4){cvt_pk_bf16(q[8] * eg, q[9] * eg), cvt_pk_bf16(q[10] * eg, q[11] * eg), cvt_pk_bf16(q[12] * eg, q[13] * eg), cvt_pk_bf16(q[14] * eg, q[15] * eg)};
            bf16_t* qd = (bf16_t*)(ws + WS_QD) + (row0 + t) * 1024 + h * 128 + d0; *(u32x4*)qd = w0; *(u32x4*)(qd + 8) = w1;
        }
        {   const int d = tid >> 2, tq = (tid & 3) * 16; float kd[16];
#pragma unroll
            for (int j = 0; j < 16; ++j) kd[j] = S[(64 + tq + j) * SP + d] * __expf(gl - GB[64 + tq + j]);
            bf16_t* o = (bf16_t*)(ws + WS_KDT) + ((size_t)unit * 128 + d) * 64 + tq;
            *(u32x4*)o = (u32x4){cvt_pk_bf16(kd[0], kd[1]), cvt_pk_bf16(kd[2], kd[3]), cvt_pk_bf16(kd[4], kd[5]), cvt_pk_bf16(kd[6], kd[7])};
            *(u32x4*)(o + 8) = (u32x4){cvt_pk_bf16(kd[8], kd[9]), cvt_pk_bf16(kd[10], kd[11]), cvt_pk_bf16(kd[12], kd[13]), cvt_pk_bf16(kd[14], kd[15])};
        }
        if (tid == 0) ((float*)(ws + WS_GL))[unit] = __expf(gl);
        LDS_BARRIER();
        conv_load_part<8, 11, true>(pre, proj, nidx >> 5, nidx & 31, tid, h);
        {   const int mat = wave >> 2, bi = wave & 3, g = lane >> 4, jl = lane & 15;
            LAS float* Lt = S;
            const LAS unsigned char* ab = F.lds + (mat ? L_QB : L_KB) + (16 * bi + jl) * 272 + 16 * g;
            bf16x8 af[4];
#pragma unroll
            for (int ks = 0; ks < 4; ++ks) af[ks] = *(const LAS bf16x8*)(ab + 64 * ks);
            float gi[4], bt[4];
#pragma unroll
            for (int r = 0; r < 4; ++r) { gi[r] = GB[64 + 16 * bi + 4 * g + r]; bt[r] = GB[16 * bi + 4 * g + r]; }
            for (int bj = 0; bj < 4; ++bj) {
                f32x4 acc = {0.f, 0.f, 0.f, 0.f};
                if (bj <= bi) {
                    const LAS unsigned char* bb = F.lds + L_KB + (16 * bj + jl) * 272 + 16 * g;
#pragma unroll
                    for (int ks = 0; ks < 4; ++ks) { const bf16x8 bf = *(const LAS bf16x8*)(bb + 64 * ks); acc = __builtin_amdgcn_mfma_f32_16x16x32_bf16(af[ks], bf, acc, 0, 0, 0); }
                }
                const int j = 16 * bj + jl; const float gj = GB[64 + j];
                if (mat == 0) { if (bj <= bi) { f32x4 lv;
#pragma unroll
                        for (int r = 0; r < 4; ++r) { const int i = 16 * bi + 4 * g + r; lv[r] = (i > j) ? bt[r] * acc[r] * __expf(gi[r] - gj) : 0.f; }
                        *(LAS f32x4*)(Lt + j * LP + 16 * bi + 4 * g) = lv;
                        if (bi >= 2 && bj < 2) {
#pragma unroll
                            for (int r = 0; r < 4; ++r) *(LAS bf16_t*)(F.lds + L_LB + (16 * (bi - 2) + 4 * g + r) * 80 + j * 2) = (bf16_t)f2bf(-lv[r]); } } }
                else {
#pragma unroll
                    for (int r = 0; r < 4; ++r) { const int i = 16 * bi + 4 * g + r; const float v = (i >= j) ? acc[r] * __expf(gi[r] - gj) : 0.f; ((bf16_t*)(ws + WS_QKM))[((size_t)unit * 64 + i) * 64 + j] = (bf16_t)f2bf(v); } }
            }
        }
        {   const int t = tid >> 3, d0 = (tid & 7) * 16; const float beta = GB[t], be = beta * __expf(GB[64 + t]);
            LAS float* kp = S + (64 + t) * SP + d0; LAS float* vp = S + (128 + t) * SP + d0;
#pragma unroll
            for (int j = 0; j < 4; ++j) { f32x4 a = *(LAS f32x4*)(kp + 4 * j); a = a * be; *(LAS f32x4*)(kp + 4 * j) = a; f32x4 c = *(LAS f32x4*)(vp + 4 * j); c = c * beta; *(LAS f32x4*)(vp + 4 * j) = c; }
        }
        LDS_BARRIER();
        const LAS float* Lt = S;
        if (wave == 0) {
            const int bi = lane >> 4, cc = lane & 15; float x[16];
#pragma unroll
            for (int i = 0; i < 16; ++i) x[i] = (i == cc) ? 1.f : 0.f;
#pragma unroll
            for (int j = 0; j < 15; ++j) { const float sj = x[j];
#pragma unroll
                for (int q4 = (j + 1) / 4; q4 < 4; ++q4) { const f32x4 l4 = *(const LAS f32x4*)(Lt + (16 * bi + j) * LP + 16 * bi + 4 * q4);
#pragma unroll
                    for (int jj = 0; jj < 4; ++jj) x[4 * q4 + jj] -= l4[jj] * sj; } }
#pragma unroll
            for (int i = 0; i < 16; ++i) *(LAS bf16_t*)(F.lds + L_ST + (16 * bi + i) * 32 + cc * 2) = (bf16_t)f2bf(x[i]);
        }
        LDS_BARRIER();
        {   const int g = lane >> 4, jl = lane & 15;
            bf16x8 At[4], Al[6];
#pragma unroll
            for (int bi = 0; bi < 4; ++bi) { const u32x2 t = *(const LAS u32x2*)(F.lds + L_ST + (16 * bi + jl) * 32 + 8 * g); At[bi] = __builtin_bit_cast(bf16x8, (u32x4){t.x, t.y, 0u, 0u}); }
#pragma unroll
            for (int bi = 1; bi < 4; ++bi)
#pragma unroll
                for (int bj = 0; bj < bi; ++bj) { const LAS float* lp = Lt + (16 * bj + 4 * g) * LP + 16 * bi + jl;
                    Al[bi * (bi - 1) / 2 + bj] = __builtin_bit_cast(bf16x8, (u32x4){cvt_pk_bf16(-lp[0], -lp[LP]), cvt_pk_bf16(-lp[2 * LP], -lp[3 * LP]), 0u, 0u}); }
#pragma unroll
            for (int q = 0; q < 2; ++q) { const int cc = 16 * (2 * wave + q) + jl;
                const LAS float* rp = S + (cc < 128 ? 128 * SP + cc : 64 * SP + (cc - 128)) + (4 * g) * SP;
                bf16_t* og = (bf16_t*)(ws + (cc < 128 ? WS_UU : WS_WW)) + (row0 + 4 * g) * 1024 + h * 128 + (cc & 127);
                f32x4 y[4]; bf16x8 sb[4];
#pragma unroll
                for (int bi = 0; bi < 4; ++bi) y[bi] = (f32x4){rp[(16 * bi) * SP], rp[(16 * bi + 1) * SP], rp[(16 * bi + 2) * SP], rp[(16 * bi + 3) * SP]};
#pragma unroll
                for (int bi = 0; bi < 4; ++bi) {
#pragma unroll
                    for (int bj = 0; bj < bi; ++bj) y[bi] = __builtin_amdgcn_mfma_f32_16x16x32_bf16(Al[bi * (bi - 1) / 2 + bj], sb[bj], y[bi], 0, 0, 0);
                    const bf16x8 yb = __builtin_bit_cast(bf16x8, (u32x4){cvt_pk_bf16(y[bi][0], y[bi][1]), cvt_pk_bf16(y[bi][2], y[bi][3]), 0u, 0u});
                    const f32x4 sv = __builtin_amdgcn_mfma_f32_16x16x32_bf16(At[bi], yb, (f32x4){0.f, 0.f, 0.f, 0.f}, 0, 0, 0);
                    const unsigned p0 = cvt_pk_bf16(sv[0], sv[1]), p1 = cvt_pk_bf16(sv[2], sv[3]);
                    sb[bi] = __builtin_bit_cast(bf16x8, (u32x4){p0, p1, 0u, 0u});
                    og[(size_t)(16 * bi) * 1024] = (bf16_t)p0; og[(size_t)(16 * bi + 1) * 1024] = (bf16_t)(p0 >> 16); og[(size_t)(16 * bi + 2) * 1024] = (bf16_t)p1; og[(size_t)(16 * bi + 3) * 1024] = (bf16_t)(p1 >> 16);
                }
            }
        }
        LDS_BARRIER();
    }
}
__device__ __forceinline__ void sample_item(Frame& F, int sb, int h) {
    const Params& P = *F.p; unsigned char* ws = P.ws; OPAQUE_WS(ws); int tid = F.tid; asm volatile("" : "+v"(tid));
    const int lane = tid & 63, wave = __builtin_amdgcn_readfirstlane(tid >> 6);
    LAS float* SQ = (LAS float*)F.lds;
    LAS float* GT = SQ + 3 * 4 * 128;
    LAS float* RED = GT + 16;
    const bf16_t* proj = (const bf16_t*)(ws + WS_PROJ) + (size_t)(MP + sb * DECS) * DN_NP;
    const int dg = tid >> 7, e = tid & 127;
    float St[32];
    const float* s0 = P.in[3] + (((size_t)sb * 8 + h) * 128 + 32 * dg) * 128 + e;
#pragma unroll
    for (int i = 0; i < 32; ++i) St[i] = __builtin_nontemporal_load(s0 + (size_t)i * 128);
    if (tid < 384) {
        const int part = tid >> 7, d = tid & 127, col = part * 1024 + h * 128 + d;
        float xs[7];
#pragma unroll
        for (int j = 0; j < 3; ++j) xs[j] = P.in[4][((size_t)sb * 3 + j) * DN_QKV + col];
#pragma unroll
        for (int t = 0; t < 4; ++t) xs[3 + t] = bf2f(proj[(size_t)t * DN_NP + col]);
        float cw[4];
#pragma unroll
        for (int j = 0; j < 4; ++j) cw[j] = P.in[15][j * DN_QKV + col];
#pragma unroll
        for (int t = 0; t < 4; ++t) { float a = 0.f;
#pragma unroll
            for (int j = 0; j < 4; ++j) a += cw[j] * xs[t + j];
            SQ[(part * 4 + t) * 128 + d] = silu(a); }
#pragma unroll
        for (int j = 0; j < 3; ++j) P.out[O_CS + ((size_t)sb * 3 + j) * DN_QKV + col] = xs[4 + j];
    }
    if (tid >= 384 && tid < 388) { const int t = tid - 384; const float braw = bf2f(proj[(size_t)t * DN_NP + 4096 + h]), araw = bf2f(proj[(size_t)t * DN_NP + 4104 + h]);
        const float xs = araw + P.in[17][h]; const float sp = xs > 20.f ? xs : log1pf(__expf(xs));
        GT[t] = -__expf(P.in[16][h]) * sp; GT[4 + t] = 1.f / (1.f + __expf(-braw)); }
    LDS_BARRIER();
    { LAS float* rp = SQ + wave * 128; const float a = rp[lane], c = rp[lane + 64];
      float sc = rsqrtf(wave_sum(a * a + c * c) + L2_EPS); if (wave < 4) sc *= 0.08838834764831845f;
      rp[lane] = a * sc; rp[lane + 64] = c * sc; }
    LDS_BARRIER();
    for (int t = 0; t < 4; ++t) {
        const float dec = __expf(GT[t]), beta = GT[4 + t];
        const LAS float* qp = SQ + t * 128 + 32 * dg; const LAS float* kp = SQ + (4 + t) * 128 + 32 * dg;
        float kv = 0.f;
#pragma unroll
        for (int i = 0; i < 32; ++i) { St[i] *= dec; kv += kp[i] * St[i]; }
        RED[dg * 128 + e] = kv;
        LDS_BARRIER();
        const float kvt = (RED[e] + RED[128 + e]) + (RED[256 + e] + RED[384 + e]);
        const float delta = (SQ[(8 + t) * 128 + e] - kvt) * beta;
        float ov = 0.f;
#pragma unroll
        for (int i = 0; i < 32; ++i) { St[i] += kp[i] * delta; ov += qp[i] * St[i]; }
        LDS_BARRIER();
        RED[dg * 128 + e] = ov;
        LDS_BARRIER();
        if (dg == 0) { const float o = (RED[e] + RED[128 + e]) + (RED[256 + e] + RED[384 + e]); ((bf16_t*)(ws + WS_DO))[(size_t)(MP + sb * DECS + t) * 1024 + h * 128 + e] = (bf16_t)f2bf(o); }
        LDS_BARRIER();
    }
    float* so = P.out + O_SS + (((size_t)sb * 8 + h) * 128 + 32 * dg) * 128 + e;
#pragma unroll
    for (int i = 0; i < 32; ++i) __builtin_nontemporal_store(St[i], so + (size_t)i * 128);
    asm volatile("s_waitcnt vmcnt(0)" ::: "memory"); __syncthreads();
    if (wave < 4) gated_norm_row(ws, P.in[18], (size_t)(MP + sb * DECS + wave), h, lane);
}

struct StepRegs { bf16x8 a1[4]; bf16x8 a3[2]; bf16x8 a4[2]; };
__device__ __forceinline__ void scan_load(StepRegs& R, const unsigned char* ws, int b, int h, int sl, int n, int w, int g, int jl) {
    const int unit = (b * 8 + h) * 32 + n; const size_t row0 = (size_t)b * SEQ + 64 * n; const int tb = w & 3;
    const bf16_t* A1 = (const bf16_t*)(ws + (w < 4 ? WS_WW : WS_QD)) + (row0 + 16 * tb + jl) * 1024 + h * 128 + 8 * g;
#pragma unroll
    for (int ks = 0; ks < 4; ++ks) R.a1[ks] = *(const bf16x8*)(A1 + 32 * ks);
    const bf16_t* A4 = (const bf16_t*)(ws + WS_KDT) + ((size_t)unit * 128 + 16 * w + jl) * 64 + 8 * g;
#pragma unroll
    for (int ks = 0; ks < 2; ++ks) R.a4[ks] = *(const bf16x8*)(A4 + 32 * ks);
    const bf16_t* X = w >= 4 ? (const bf16_t*)(ws + WS_QKM) + ((size_t)unit * 64 + 16 * tb + jl) * 64 + 8 * g
                             : (const bf16_t*)(ws + WS_UU) + (row0 + 16 * tb + jl) * 1024 + h * 128 + 32 * sl + 8 * g;
    R.a3[0] = *(const bf16x8*)X; R.a3[1] = *(const bf16x8*)(X + (w >= 4 ? 32 : 0));
}
__device__ __forceinline__ void scan_step(unsigned char* ws, LAS unsigned char* ST, LAS unsigned char* VT, const StepRegs& cur, f32x4 (&sacc)[2], int b, int h, int sl, int n, int w, int g, int jl) {
    const int tb = w & 3; const size_t row0 = (size_t)b * SEQ + 64 * n;
    f32x4 tacc[2] = {{0.f, 0.f, 0.f, 0.f}, {0.f, 0.f, 0.f, 0.f}};
#pragma unroll
    for (int cb = 0; cb < 2; ++cb)
#pragma unroll
        for (int ks = 0; ks < 4; ++ks) { const bf16x8 bf = *(const LAS bf16x8*)(ST + (16 * cb + jl) * 272 + (32 * ks + 8 * g) * 2); tacc[cb] = __builtin_amdgcn_mfma_f32_16x16x32_bf16(bf, cur.a1[ks], tacc[cb], 0, 0, 0); }
    if (w < 4) {
        float uf[8]; unpack8(__builtin_bit_cast(u32x4, cur.a3[0]), uf);
#pragma unroll
        for (int cb = 0; cb < 2; ++cb) {
            const unsigned p0 = cvt_pk_bf16(uf[4 * cb + 0] - tacc[cb][0], uf[4 * cb + 1] - tacc[cb][1]), p1 = cvt_pk_bf16(uf[4 * cb + 2] - tacc[cb][2], uf[4 * cb + 3] - tacc[cb][3]);
            LAS unsigned short* vp = (LAS unsigned short*)(VT + (16 * cb + 4 * g) * 144 + (16 * tb + jl) * 2);
            vp[0] = (unsigned short)p0; vp[72] = (unsigned short)(p0 >> 16); vp[144] = (unsigned short)p1; vp[216] = (unsigned short)(p1 >> 16); }
    }
    LDS_BARRIER();
    if (w >= 4) {
#pragma unroll
        for (int cb = 0; cb < 2; ++cb)
#pragma unroll
            for (int ks = 0; ks < 2; ++ks) { const bf16x8 bf = *(const LAS bf16x8*)(VT + (16 * cb + jl) * 144 + (32 * ks + 8 * g) * 2); tacc[cb] = __builtin_amdgcn_mfma_f32_16x16x32_bf16(bf, cur.a3[ks], tacc[cb], 0, 0, 0); }
        *(u32x4*)((bf16_t*)(ws + WS_DO) + (row0 + 16 * tb + jl) * 1024 + h * 128 + 32 * sl + 8 * g) =
            (u32x4){cvt_pk_bf16(tacc[0][0], tacc[0][1]), cvt_pk_bf16(tacc[0][2], tacc[0][3]), cvt_pk_bf16(tacc[1][0], tacc[1][1]), cvt_pk_bf16(tacc[1][2], tacc[1][3])};
    }
    const float gl = ((const LAS float*)(VT + 32 * 144))[n];
#pragma unroll
    for (int cb = 0; cb < 2; ++cb) { sacc[cb] = sacc[cb] * gl;
#pragma unroll
        for (int ks = 0; ks < 2; ++ks) { const bf16x8 bf = *(const LAS bf16x8*)(VT + (16 * cb + jl) * 144 + (32 * ks + 8 * g) * 2); sacc[cb] = __builtin_amdgcn_mfma_f32_16x16x32_bf16(cur.a4[ks], bf, sacc[cb], 0, 0, 0); }
        *(LAS u32x2*)(ST + (16 * cb + jl) * 272 + (16 * w + 4 * g) * 2) = (u32x2){cvt_pk_bf16(sacc[cb][0], sacc[cb][1]), cvt_pk_bf16(sacc[cb][2], sacc[cb][3])}; }
    LDS_BARRIER();
}
__device__ __forceinline__ void scan_item(Frame& F, int b, int h, int sl) {
    const Params& P = *F.p; unsigned char* ws = P.ws; OPAQUE_WS(ws); int tid = F.tid; asm volatile("" : "+v"(tid));
    const int lane = tid & 63, w = __builtin_amdgcn_readfirstlane(tid >> 6), g = lane >> 4, jl = lane & 15;
    LAS unsigned char* ST = F.lds;
    LAS unsigned char* VT = F.lds + 32 * 272;
    for (int i = tid; i < 32 * 272 / 4; i += NTHREADS) ((LAS unsigned*)ST)[i] = 0u;
    if (tid < 32) ((LAS float*)(VT + 32 * 144))[tid] = ((const float*)(ws + WS_GL))[(b * 8 + h) * 32 + tid];
    f32x4 sacc[2] = {{0.f, 0.f, 0.f, 0.f}, {0.f, 0.f, 0.f, 0.f}};
    StepRegs A, B, C;
    scan_load(A, ws, b, h, sl, 0, w, g, jl); scan_load(B, ws, b, h, sl, 1, w, g, jl);
    __syncthreads();
    for (int n = 0; n < 30; n += 3) {
        scan_load(C, ws, b, h, sl, n + 2, w, g, jl); __builtin_amdgcn_sched_barrier(0); scan_step(ws, ST, VT, A, sacc, b, h, sl, n, w, g, jl);
        scan_load(A, ws, b, h, sl, n + 3, w, g, jl); __builtin_amdgcn_sched_barrier(0); scan_step(ws, ST, VT, B, sacc, b, h, sl, n + 1, w, g, jl);
        scan_load(B, ws, b, h, sl, n + 4, w, g, jl); __builtin_amdgcn_sched_barrier(0); scan_step(ws, ST, VT, C, sacc, b, h, sl, n + 2, w, g, jl);
    }
    scan_step(ws, ST, VT, A, sacc, b, h, sl, 30, w, g, jl);
    scan_step(ws, ST, VT, B, sacc, b, h, sl, 31, w, g, jl);
    float* so = P.out + O_SP + (((size_t)b * 8 + h) * 128 + 16 * w + 4 * g) * 128 + 32 * sl + 8 * (jl >> 2) + (jl & 3);
#pragma unroll
    for (int cb = 0; cb < 2; ++cb)
#pragma unroll
        for (int r = 0; r < 4; ++r) __builtin_nontemporal_store(sacc[cb][r], so + (size_t)r * 128 + 4 * cb);
}
template <int NB>
__device__ __forceinline__ void gn_load_z(u32x4 (&zv)[NB], unsigned char* ws, size_t row0, int h, int lane) {
    const size_t rowb = row0 + (lane >> 4); const int c0 = (lane & 15) * 8;
#pragma unroll
    for (int i = 0; i < NB; ++i) zv[i] = __builtin_nontemporal_load((const u32x4*)((const bf16_t*)(ws + WS_PROJ) + (rowb + 32 * i) * DN_NP + 3072 + h * 128 + c0));
}
template <int NB>
__device__ __forceinline__ void gated_norm_batch(unsigned char* ws, const float* gout, size_t row0, int h, int lane, const u32x4 (&zv)[NB]) {
    const size_t rowb = row0 + (lane >> 4); const int c0 = (lane & 15) * 8;
    u32x4 ov[NB];
#pragma unroll
    for (int i = 0; i < NB; ++i) ov[i] = *(const u32x4*)((const bf16_t*)(ws + WS_DO) + (rowb + 32 * i) * 1024 + h * 128 + c0);
    const f32x4 g0 = *(const f32x4*)(gout + c0), g1 = *(const f32x4*)(gout + c0 + 4);
    const float g[8] = {g0.x, g0.y, g0.z, g0.w, g1.x, g1.y, g1.z, g1.w};
    __builtin_amdgcn_sched_barrier(0);
#pragma unroll
    for (int i = 0; i < NB; ++i) {
        float o[8], z[8]; unpack8(ov[i], o); unpack8(zv[i], z);
        float ss = 0.f;
#pragma unroll
        for (int k = 0; k < 8; ++k) ss += o[k] * o[k];
        ss += __shfl_xor(ss, 1); ss += __shfl_xor(ss, 2); ss += __shfl_xor(ss, 4); ss += __shfl_xor(ss, 8);
        const float rs = rsqrtf(ss * (1.f / 128.f) + RMS_EPS);
        float y[8];
#pragma unroll
        for (int k = 0; k < 8; ++k) y[k] = o[k] * rs * g[k] * silu(z[k]);
        *(u32x4*)((bf16_t*)(ws + WS_DOG) + (rowb + 32 * i) * 1024 + h * 128 + c0) = (u32x4){cvt_pk_bf16(y[0], y[1]), cvt_pk_bf16(y[2], y[3]), cvt_pk_bf16(y[4], y[5]), cvt_pk_bf16(y[6], y[7])};
    }
}
__device__ __forceinline__ void scan_tail(Frame& F, int b, int h, int sl) {
    unsigned char* ws = F.p->ws; unsigned* cnt = (unsigned*)(ws + WS_CTL) + CW_HAND + 64 * (16 + b * 8 + h);
    hand_signal(cnt);
    const int lane = F.lane; const size_t r0 = (size_t)b * SEQ + 512 * sl + 4 * F.wave;
    u32x4 z0[8], z1[8]; gn_load_z<8>(z0, ws, r0, h, lane); gn_load_z<8>(z1, ws, r0 + 256, h, lane);
    hand_wait(cnt, 4u);
    gated_norm_batch<8>(ws, F.p->in[18], r0, h, lane, z0); gated_norm_batch<8>(ws, F.p->in[18], r0 + 256, h, lane, z1);
}
}

__global__ void __launch_bounds__(NTHREADS, 2) fwd_kernel(Params prm) {
    extern __shared__ __attribute__((aligned(16))) unsigned char lds_raw[];
    Frame F; F.lds = (LAS unsigned char*)lds_raw; F.tid = threadIdx.x; F.lane = F.tid & 63; F.wave = __builtin_amdgcn_readfirstlane(F.tid >> 6);
    F.G = gridDim.x; F.c = blockIdx.x; F.p = &prm;
    unsigned char* ws = prm.ws;
    volatile LAS unsigned* MISC = (volatile LAS unsigned*)(F.lds + 131072 + 8192);
    if (F.tid < 16) MISC[F.tid] = 0u;
    __syncthreads();
    (void)xcd_barrier_post((unsigned*)(ws + WS_CTL) + 1024, MISC + 8);
#define GSYNC() do { XcdBarrier gb_; gb_.bar = (unsigned*)(ws + WS_CTL) + 1024; gb_.x = 0; gb_.st = MISC + 8; xcd_barrier(gb_); OPAQUE_WS(ws); } while (0)
    const float QSCALE = 0.07216878364870322f * 1.4426950408889634f;

    p0_prologue(F);
    GSYNC();
    {
        pg8::Gemm g{(const bf16_t*)(ws + WS_U), (const bf16_t*)(ws + WS_WT_IN0), 1024, 1024};
        pg8::PlainOrder S; S.init(MT / 256, NIN0P / 256, 16, F.G, F.c);
        pg8::EpiF32 E{(float*)(ws + WS_A0), NIN0P, nullptr};
        pg8::gemm_phase(F.lds, g, S, E);
    }
    {
        pg8::Gemm g1{(const bf16_t*)(ws + WS_WOT), (const bf16_t*)(ws + WS_BD_UV), 1024, 1024};
        pg8::PrepOrder S1{4, 8, F.G, F.c, 195, 0};
        pg8::EpiBf16 E1{(bf16_t*)(ws + WS_WT_UVO), 2048};
        pg8::gemm_phase(F.lds, g1, S1, E1);
        pg8::Gemm g2{(const bf16_t*)(ws + WS_BD_UK), (const bf16_t*)(ws + WS_UQN), 1024, 1024};
        pg8::PrepOrder S2{8, 2, F.G, F.c, 227, 1};
        pg8::EpiBf16 E2{(bf16_t*)(ws + WS_WT_Q), 512};
        pg8::gemm_phase(F.lds, g2, S2, E2);
    }
    GSYNC();
    m2_rows(F);
    GSYNC();
    {
        pg8::Gemm g{(const bf16_t*)(ws + WS_CQ), (const bf16_t*)(ws + WS_WT_Q), 384, 512};
        pg8::PlainOrder S; S.init(MT / 256, NQ / 256, 6, F.G, F.c);
        pg8::EpiQ E{(bf16_t*)(ws + WS_Q), (const f32x2*)(ws + WS_ROPE), QSCALE};
        pg8::gemm_phase(F.lds, g, S, E);
    }
    GSYNC();
    attn::phase(F);
    GSYNC();
    for (int sb = F.c; sb < DECB; sb += F.G) attn::sample_combine(F, sb);
    GSYNC();
    {
        pg8::Gemm g{(const bf16_t*)(ws + WS_OL), (const bf16_t*)(ws + WS_WT_UVO), 2048, 2048};
        pg8::SplitOrder S; S.init(MP / 256, 4, 32, F.G, F.c); S.pmx = MP / 256; S.nsplit = 8;
        pg8::EpiMix E{(bf16_t*)(ws + WS_MIX), DM, (float*)(ws + WS_SLAB)};
        pg8::gemm_phase(F.lds, g, S, E);
    }
    GSYNC();
    rowpass(F, true, false, F.p->in[6] + 1 * DM, F.p->in[6] + 2 * DM, 8);
    GSYNC();
#pragma unroll
    for (int l = 0; l < 2; ++l) {
        if (l == 1) {
            {
                pg8::Gemm g{(const bf16_t*)(ws + WS_U), (const bf16_t*)(ws + WS_WT_DIN), 1024, 1024};
                pg8::PlainOrder S; S.init(MT / 256, DN_NP / 256, 16, F.G, F.c);
                pg8::EpiBf16 E{(bf16_t*)(ws + WS_PROJ), DN_NP};
                pg8::gemm_phase(F.lds, g, S, E);
            }
            GSYNC();
            dn::chunk_phase(F);
            for (int L = F.c; L < DECB * 8; L += F.G) dn::sample_item(F, L >> 3, L & 7);
            GSYNC();
            for (int L = F.c; L < 256; L += F.G) { const int sl = (L >> 3) & 3, bh = (L & 7) + 8 * (L >> 5); dn::scan_item(F, bh >> 3, bh & 7, sl); }
            for (int L = F.c; L < 256; L += F.G) { const int sl = (L >> 3) & 3, bh = (L & 7) + 8 * (L >> 5); dn::scan_tail(F, bh >> 3, bh & 7, sl); }
            GSYNC();
            {
                pg8::Gemm g{(const bf16_t*)(ws + WS_DOG), (const bf16_t*)(ws + WS_WT_DO), 1024, 1024};
                pg8::SplitOrder S; S.init(MP / 256, 4, 16, F.G, F.c); S.pmx = MP / 256; S.nsplit = 4;
                pg8::EpiMix E{(bf16_t*)(ws + WS_MIX), DM, (float*)(ws + WS_SLAB)};
                pg8::gemm_phase(F.lds, g, S, E);
            }
            GSYNC();
            rowpass(F, false, false, F.p->in[6] + 5 * DM, F.p->in[6] + 6 * DM, 4);
            GSYNC();
        }
        {
            pg8::Gemm g{(const bf16_t*)(ws + WS_U), (const bf16_t*)(ws + WS_WT_F1) + (size_t)l * 5632 * 1024, 1024, 1024};
            pg8::PlainOrder S; S.init(MT / 256, 22, 16, F.G, F.c);
            pg8::EpiSwiglu E{(bf16_t*)(ws + WS_H), DFF};
            pg8::gemm_phase(F.lds, g, S, E);
        }
        GSYNC();
        {
            pg8::Gemm g{(const bf16_t*)(ws + WS_H), (const bf16_t*)(ws + WS_WT_F2) + (size_t)l * 1024 * DFF, DFF, DFF};
            pg8::SplitOrder S; S.init(MP / 256, 4, 44, F.G, F.c); S.pmx = MP / 256; S.nsplit = 11;
            pg8::EpiMix E{(bf16_t*)(ws + WS_MIX), DM, (float*)(ws + WS_SLAB)};
            pg8::gemm_phase(F.lds, g, S, E);
        }
        GSYNC();
        rowpass(F, false, l == 1, F.p->in[6] + (l * 4 + 3) * DM, l == 0 ? F.p->in[6] + 4 * DM : nullptr, 11);
        if (l == 0) GSYNC();
    }
}

extern "C" void kernel_launch(void* const* d_in, const int* in_sizes, int n_in, void* d_out, int out_size, void* d_ws, size_t ws_size, hipStream_t stream) {
    static int grid = 0;
    if (grid == 0) {
        int dev = 0, cus = 0, per_cu = 0;
        hipGetDevice(&dev);
        hipDeviceGetAttribute(&cus, hipDeviceAttributeMultiprocessorCount, dev);
        hipFuncSetAttribute((const void*)fwd_kernel, hipFuncAttributeMaxDynamicSharedMemorySize, LDS_BYTES);
        hipOccupancyMaxActiveBlocksPerMultiprocessor(&per_cu, (const void*)fwd_kernel, NTHREADS, LDS_BYTES);
        if (per_cu < 1) { fprintf(stderr, "kernel_launch: occupancy query reports %d blocks per CU\n", per_cu); per_cu = 1; }
        (void)hipGetLastError();
        grid = cus;
        if (n_in != 22 || (size_t)out_size != O_END || ws_size < WS_END) fprintf(stderr, "kernel_launch: unexpected sizes n_in %d out %d ws %zu\n", n_in, out_size, ws_size);
    }
    if (ws_size < WS_END || n_in != 22 || (size_t)out_size != O_END) return;
    hipMemsetAsync((char*)d_ws + WS_CTL, 0, CTL_BYTES, stream);
    Params p{};
    for (int i = 0; i < 22; ++i) p.in[i] = (const float*)d_in[i];
    p.page_table = (const int*)d_in[5]; p.out = (float*)d_out; p.ws = (unsigned char*)d_ws;
    void* args[] = {&p};
    hipError_t e = hipLaunchCooperativeKernel((const void*)fwd_kernel, dim3(grid), dim3(NTHREADS), args, LDS_BYTES, stream);
    if (e != hipSuccess) fprintf(stderr, "cooperative launch failed: %s (grid %d)\n", hipGetErrorString(e), grid);
}
```

```cpp
#include <hip/hip_runtime.h>
#include <hip/hip_cooperative_groups.h>
#include <cstdio>
#include <cstdint>
namespace cg = cooperative_groups;

#define LAS __attribute__((address_space(3)))
#define GAS __attribute__((address_space(1)))
typedef unsigned short bf16_t;
typedef short bf16x8 __attribute__((ext_vector_type(8)));
typedef short s16x4 __attribute__((ext_vector_type(4)));
typedef float f32x4 __attribute__((ext_vector_type(4)));
typedef float f32x2 __attribute__((ext_vector_type(2)));
typedef unsigned u32x4 __attribute__((ext_vector_type(4)));
typedef unsigned u32x2 __attribute__((ext_vector_type(2)));

constexpr int DM = 1024, BATCH = 8, SEQ = 2048, DECB = 32, DECS = 4, PAST = 16384, PAGE = 128;
constexpr int MP = BATCH * SEQ;
constexpr int MS = DECB * DECS;
constexpr int MV = MP + MS;
constexpr int MT = 16640;
constexpr int HEADS = 8, QK_NOPE = 128, QK_ROPE = 64, V_HEAD = 128, KV_LORA = 256, Q_LORA = 384, MLA_ROW = 320;
constexpr int NIN0 = Q_LORA + MLA_ROW;
constexpr int NIN0P = 768;
constexpr int NQ = HEADS * KV_LORA + HEADS * QK_ROPE;
constexpr int DN_HK = 1024, DN_QKV = 3072, DN_Z = 1024, DN_N = 4112, DN_NP = 4352, CONVW = 4, CHUNK = 64;
constexpr int DFF = 2816;
constexpr int NPAGES = PAST / PAGE;
constexpr float RMS_EPS = 1e-6f, L2_EPS = 1e-6f;
constexpr int NTHREADS = 512, NWAVES = 8;

constexpr size_t O_Y = 0;
constexpr size_t O_ROWS = (size_t)MV * DM;
constexpr size_t O_SP = O_ROWS + (size_t)MV * MLA_ROW;
constexpr size_t O_SS = O_SP + (size_t)BATCH * 8 * 128 * 128;
constexpr size_t O_CP = O_SS + (size_t)DECB * 8 * 128 * 128;
constexpr size_t O_CS = O_CP + (size_t)BATCH * 3 * DN_QKV;
constexpr size_t O_END = O_CS + (size_t)DECB * 3 * DN_QKV;

constexpr size_t MiB = 1u << 20;
constexpr size_t WS_CTL = 0;
constexpr size_t CTL_BYTES = 1 * MiB;
constexpr size_t WS_ROPE = 1 * MiB;
constexpr size_t WS_WT_IN0 = 2 * MiB;
constexpr size_t WS_WT_Q = 856 * MiB;
constexpr size_t WS_WT_UVO = 6 * MiB;
constexpr size_t WS_BD_UV = 10 * MiB;
constexpr size_t WS_WOT = 14 * MiB;
constexpr size_t WS_BD_UK = 16 * MiB;
constexpr size_t WS_UQN = 20 * MiB;
constexpr size_t WS_WT_F1 = 22 * MiB;
constexpr size_t WS_WT_F2 = 44 * MiB;
constexpr size_t WS_WT_DIN = 56 * MiB;
constexpr size_t WS_WT_DO = 65 * MiB;
constexpr size_t WS_U = 68 * MiB;
constexpr size_t WS_A0 = 102 * MiB;
constexpr size_t WS_CQ = 152 * MiB;
constexpr size_t WS_ROWSB = 166 * MiB;
constexpr size_t WS_Q = 178 * MiB;
constexpr size_t WS_OL = 260 * MiB;
constexpr size_t WS_MIX = 326 * MiB;
constexpr size_t WS_SLAB = 392 * MiB;
constexpr size_t WS_H = 400 * MiB;
constexpr size_t WS_PROJ = 490 * MiB;
constexpr size_t WS_PART = 632 * MiB;
constexpr size_t WS_ML = 641 * MiB;
constexpr size_t WS_DO = 642 * MiB;
constexpr size_t WS_DOG = 676 * MiB;
constexpr size_t WS_UU = 710 * MiB;
constexpr size_t WS_WW = 742 * MiB;
constexpr size_t WS_QD = 774 * MiB;
constexpr size_t WS_KDT = 806 * MiB;
constexpr size_t WS_QKM = 838 * MiB;
constexpr size_t WS_GL = 854 * MiB;
constexpr size_t WS_HB = 860 * MiB;
constexpr size_t WS_END = 894 * MiB;
constexpr int NSLAB_MAX = 16;

constexpr int CW_GEN = 64;
constexpr int CW_ATT = 8192;

__device__ __forceinline__ float bf2f(unsigned short b) { return __builtin_bit_cast(float, (unsigned)b << 16); }
typedef float f32x2_t __attribute__((ext_vector_type(2)));
typedef __bf16 bf16x2_t __attribute__((ext_vector_type(2)));
__device__ __forceinline__ unsigned cvt_pk_bf16(float lo, float hi) { f32x2_t v = {lo, hi}; bf16x2_t b = __builtin_convertvector(v, bf16x2_t); return __builtin_bit_cast(unsigned, b); }
__device__ __forceinline__ unsigned f2bf(float f) { return cvt_pk_bf16(f, 0.f) & 0xffffu; }
__device__ __forceinline__ unsigned pk2(float lo, float hi) { return cvt_pk_bf16(lo, hi); }
template <int CTRL> __device__ __forceinline__ float dpp_f(float x) { return __builtin_bit_cast(float, __builtin_amdgcn_update_dpp(0, __builtin_bit_cast(int, x), CTRL, 0xf, 0xf, true)); }
__device__ __forceinline__ float quad_sum(float x) { x += dpp_f<0xB1>(x); x += dpp_f<0x4E>(x); return x; }
__device__ __forceinline__ float row_sum16(float x) { x += dpp_f<0x128>(x); x += dpp_f<0x124>(x); x += dpp_f<0x122>(x); x += dpp_f<0x121>(x); return x; }
__device__ __forceinline__ float xsum16(float x) { float a = x, b = x; asm volatile("s_nop 1\n\tv_permlane16_swap_b32 %0, %1" : "+v"(a), "+v"(b)); return a + b; }
__device__ __forceinline__ float xsum32(float x) { float a = x, b = x; asm volatile("s_nop 1\n\tv_permlane32_swap_b32 %0, %1" : "+v"(a), "+v"(b)); return a + b; }
__device__ __forceinline__ float wave_sum(float v) {
    return xsum32(xsum16(row_sum16(v)));
}
#define LDS_WAIT() asm volatile("s_waitcnt lgkmcnt(0)" ::: "memory")
#define VM_WAIT() asm volatile("s_waitcnt vmcnt(0)" ::: "memory")

typedef __attribute__((address_space(1))) unsigned char g_u8_t;
#define OPAQUE_WS(ws) do { g_u8_t* w1_ = (g_u8_t*)(ws); asm volatile("" : "+s"(w1_)); ws = (unsigned char*)w1_; } while (0)
namespace pg8 {
constexpr int BM = 256, BK = 64, HALF = 128, HTB = HALF * BK * 2, STAGE_BYTES = 8 * HTB, NXCD = 8, WGM = 8;
__host__ __device__ __forceinline__ int lds_byte(int r, int c) { const int st = (r >> 4) * 2 + (c >> 5), rr = r & 15, cc = c & 31, ob = rr * 64 + cc * 2; return st * 1024 + (ob ^ (((ob >> 9) & 1) << 5)); }
__host__ __device__ __forceinline__ void stage_rc(int b, int& R, int& C) { const int st = b / 1024, sb = b % 1024, swz = sb ^ (((sb >> 9) & 1) << 5); R = (st >> 1) * 16 + swz / 64; C = (st & 1) * 32 + (swz % 64) / 2; }
__host__ __device__ __forceinline__ int perm32(int rho) { const int n = rho >> 4, i = rho & 15; return 8 * (i >> 2) + 4 * n + (i & 3); }

struct Unit { int pm, pn, kt0, nkt, z; };
struct Gemm { const bf16_t* A; const bf16_t* Bt; int lda, ldb; };

struct MainOrder {
    int nM, nN, nwg, G, c, nkt;
    __device__ __forceinline__ void init(int nM_, int nN_, int nkt_, int G_, int c_) { nM = nM_; nN = nN_; nwg = nM * nN; G = G_; c = c_; nkt = nkt_; asm volatile("" : "+s"(c)); }
    __device__ __forceinline__ void main_map(int L, int& pm, int& pn) const {
        int wgid = L; { const int q = nwg / NXCD, r = nwg % NXCD, xcd = wgid % NXCD, off = wgid / NXCD; wgid = (xcd < r ? xcd * (q + 1) : r * (q + 1) + (xcd - r) * q) + off; }
        const int nig = WGM * nN, gid = wgid / nig, fm = gid * WGM, gsz = (nM - fm) < WGM ? (nM - fm) : WGM;
        pm = fm + ((wgid % nig) % gsz); pn = (wgid % nig) / gsz;
    }
};
struct SplitOrder : MainOrder {
    int pmx, nsplit;
    __device__ __forceinline__ bool next(int i, Unit& u) const {
        const int L = i * G + c; const bool is_main = L < nwg; const int e = L - nwg; const bool ok = is_main || e < nsplit * nN;
        int pm = 0, pn = 0; main_map(is_main ? L : 0, pm, pn);
        const int per = nkt / nsplit, z = e / nN;
        Unit r; r.pm = is_main ? pm : pmx; r.pn = is_main ? pn : e % nN; r.kt0 = is_main ? 0 : z * per; r.nkt = is_main ? nkt : per; r.z = is_main ? -1 : z;
        u = r; return ok;
    }
};
struct PlainOrder : MainOrder {
    __device__ __forceinline__ bool next(int i, Unit& u) const {
        const int L = i * G + c; const bool ok = L < nwg; int pm = 0, pn = 0; main_map(ok ? L : 0, pm, pn);
        Unit r; r.pm = pm; r.pn = pn; r.kt0 = 0; r.nkt = nkt; r.z = -1; u = r; return ok;
    }
};
struct PrepOrder {
    int nM, nN, G, c, c0, by_m;
    __device__ __forceinline__ bool next(int i, Unit& u) const {
        const int i0 = c < c0 ? (c0 - c + G - 1) / G : 0; const int L = (i + i0) * G + c - c0; const bool ok = L < nM * nN;
        const int pm = ok ? L / nN : 0, pn = ok ? L % nN : 0; const int h = by_m ? pm : pn;
        int four = 4; asm volatile("" : "+s"(four));
        Unit r; r.pm = pm; r.pn = pn; r.kt0 = 4 * (h >> 1); r.nkt = four; r.z = -1; u = r; return ok;
    }
};

struct EpiF32 {
    static constexpr bool PERM = false;
    float* C; int ldc; float* slab;
    __device__ __forceinline__ void operator()(const f32x4 (&acc)[2][2][4][2], const Unit& u, int wr, int wc, int fr, int fq) const {
        const bool split = u.z >= 0;
        float* base = (split ? slab + (size_t)u.z * 128 * ldc : C + (size_t)u.pm * BM * ldc) + (size_t)(wr * 64 + fr) * ldc + u.pn * BM + wc * 32 + 4 * fq;
#pragma unroll
        for (int ai = 0; ai < 2; ++ai) {
            if (ai == 1 && split) break;
#pragma unroll
            for (int m = 0; m < 4; ++m) { float* rowp = base + (size_t)(ai * HALF + m * 16) * ldc;
#pragma unroll
                for (int bj = 0; bj < 2; ++bj)
#pragma unroll
                    for (int n = 0; n < 2; ++n) *(f32x4*)(rowp + bj * HALF + n * 16) = acc[ai][bj][m][n]; }
        }
    }
};
struct EpiMix {
    static constexpr bool PERM = true;
    bf16_t* C; int ldc; float* slab;
    __device__ __forceinline__ void operator()(const f32x4 (&acc)[2][2][4][2], const Unit& u, int wr, int wc, int fr, int fq) const {
        const int col0 = u.pn * BM + wc * 32 + 8 * fq;
        if (u.z < 0) {
            const int row0 = u.pm * BM + wr * 64 + fr;
#pragma unroll
            for (int ai = 0; ai < 2; ++ai)
#pragma unroll
                for (int m = 0; m < 4; ++m) { bf16_t* rowp = C + (size_t)(row0 + ai * HALF + m * 16) * ldc + col0;
#pragma unroll
                    for (int bj = 0; bj < 2; ++bj) { const f32x4 v0 = acc[ai][bj][m][0], v1 = acc[ai][bj][m][1];
                        u32x4 w; w.x = cvt_pk_bf16(v0[0], v0[1]); w.y = cvt_pk_bf16(v0[2], v0[3]); w.z = cvt_pk_bf16(v1[0], v1[1]); w.w = cvt_pk_bf16(v1[2], v1[3]);
                        *(u32x4*)(rowp + bj * HALF) = w; } }
        } else {
            float* base = slab + (size_t)u.z * 128 * ldc + (size_t)(wr * 64 + fr) * ldc + col0;
#pragma unroll
            for (int m = 0; m < 4; ++m)
#pragma unroll
                for (int bj = 0; bj < 2; ++bj) { float* p = base + (size_t)(m * 16) * ldc + bj * HALF; *(f32x4*)p = acc[0][bj][m][0]; *(f32x4*)(p + 4) = acc[0][bj][m][1]; }
        }
    }
};
struct EpiBf16 {
    static constexpr bool PERM = true;
    bf16_t* C; int ldc;
    __device__ __forceinline__ void operator()(const f32x4 (&acc)[2][2][4][2], const Unit& u, int wr, int wc, int fr, int fq) const {
        const int row0 = u.pm * BM + wr * 64 + fr, col0 = u.pn * BM + wc * 32 + 8 * fq;
#pragma unroll
        for (int ai = 0; ai < 2; ++ai)
#pragma unroll
            for (int m = 0; m < 4; ++m) { bf16_t* rowp = C + (size_t)(row0 + ai * HALF + m * 16) * ldc + col0;
#pragma unroll
                for (int bj = 0; bj < 2; ++bj) { const f32x4 v0 = acc[ai][bj][m][0], v1 = acc[ai][bj][m][1];
                    u32x4 w; w.x = cvt_pk_bf16(v0[0], v0[1]); w.y = cvt_pk_bf16(v0[2], v0[3]); w.z = cvt_pk_bf16(v1[0], v1[1]); w.w = cvt_pk_bf16(v1[2], v1[3]);
                    *(u32x4*)(rowp + bj * HALF) = w; } }
    }
};
struct EpiSwiglu {
    static constexpr bool PERM = true;
    bf16_t* C; int ldc;
    __device__ __forceinline__ void operator()(const f32x4 (&acc)[2][2][4][2], const Unit& u, int wr, int wc, int fr, int fq) const {
        const int row0 = u.pm * BM + wr * 64 + fr, col0 = u.pn * HALF + wc * 32 + 8 * fq;
#pragma unroll
        for (int ai = 0; ai < 2; ++ai)
#pragma unroll
            for (int m = 0; m < 4; ++m) { float o[8];
#pragma unroll
                for (int n = 0; n < 2; ++n)
#pragma unroll
                    for (int j = 0; j < 4; ++j) { const float g = acc[ai][0][m][n][j], up = acc[ai][1][m][n][j]; o[4 * n + j] = g * __builtin_amdgcn_rcpf(1.f + __expf(-g)) * up; }
                u32x4 w; w.x = cvt_pk_bf16(o[0], o[1]); w.y = cvt_pk_bf16(o[2], o[3]); w.z = cvt_pk_bf16(o[4], o[5]); w.w = cvt_pk_bf16(o[6], o[7]);
                *(u32x4*)(C + (size_t)(row0 + ai * HALF + m * 16) * ldc + col0) = w; }
    }
};
struct EpiQ {
    static constexpr bool PERM = true;
    bf16_t* C; const f32x2* rope; float scale;
    __device__ __forceinline__ void operator()(const f32x4 (&acc)[2][2][4][2], const Unit& u, int wr, int wc, int fr, int fq) const {
        const int row0 = u.pm * BM + wr * 64 + fr, col0 = u.pn * BM + wc * 32 + 8 * fq;
        const bool rp = u.pn >= 8;
#pragma unroll
        for (int ai = 0; ai < 2; ++ai)
#pragma unroll
            for (int m = 0; m < 4; ++m) { const int row = row0 + ai * HALF + m * 16;
                int pidx = row < MP ? (row & (SEQ - 1)) : (SEQ + ((row - MP) & 3)); if (row >= MV) pidx = 0;
                bf16_t* rowp = C + (size_t)row * NQ + col0;
#pragma unroll
                for (int bj = 0; bj < 2; ++bj) { f32x4 v0 = acc[ai][bj][m][0], v1 = acc[ai][bj][m][1];
                    if (rp) { const int i0 = ((col0 + bj * HALF) & 63) >> 1; const f32x2* t = rope + pidx * 32 + i0;
                        const f32x2 c0 = t[0], c1 = t[1], c2 = t[2], c3 = t[3];
                        const f32x4 r0 = {v0[0] * c0.x - v0[1] * c0.y, v0[1] * c0.x + v0[0] * c0.y, v0[2] * c1.x - v0[3] * c1.y, v0[3] * c1.x + v0[2] * c1.y};
                        const f32x4 r1 = {v1[0] * c2.x - v1[1] * c2.y, v1[1] * c2.x + v1[0] * c2.y, v1[2] * c3.x - v1[3] * c3.y, v1[3] * c3.x + v1[2] * c3.y};
                        v0 = r0; v1 = r1; }
                    v0 = v0 * scale; v1 = v1 * scale;
                    if (rp) {
                        const int cc = col0 + bj * HALF - 2048, hh = cc >> 6, i0 = (cc & 63) >> 1; bf16_t* qp = C + (size_t)row * NQ + 2048 + hh * 64 + i0;
                        u32x2 a, b; a.x = cvt_pk_bf16(v0[0], v0[2]); a.y = cvt_pk_bf16(v1[0], v1[2]); b.x = cvt_pk_bf16(v0[1], v0[3]); b.y = cvt_pk_bf16(v1[1], v1[3]);
                        *(u32x2*)qp = a; *(u32x2*)(qp + 32) = b;
                    } else {
                    u32x4 w; w.x = cvt_pk_bf16(v0[0], v0[1]); w.y = cvt_pk_bf16(v0[2], v0[3]); w.z = cvt_pk_bf16(v1[0], v1[1]); w.w = cvt_pk_bf16(v1[2], v1[3]);
                    *(u32x4*)(rowp + bj * HALF) = w; } } }
    }
};

template <class Epi, class Sched>
__device__ __forceinline__ void gemm_phase(LAS unsigned char* lds, const Gemm g, const Sched& S, const Epi& E) {
    int tid = threadIdx.x; asm volatile("" : "+v"(tid));
    const int wid = __builtin_amdgcn_readfirstlane(tid >> 6), lane = tid & 63, wr = wid >> 2, wc = wid & 3, fr = lane & 15, fq = lane >> 4;
    unsigned voffA[2], voffB[2];
#pragma unroll
    for (int i = 0; i < 2; ++i) { int R, C; stage_rc(tid * 16 + i * 8192, R, C); const int Rb = Epi::PERM ? ((R & ~31) + perm32(R & 31)) : R;
        voffA[i] = (unsigned)(R * g.lda + C) * 2u; voffB[i] = (unsigned)(Rb * g.ldb + C) * 2u; }
    const size_t kstep = (size_t)(BK * 2);
    const size_t hstepA = (size_t)HALF * g.lda * 2, hstepB = (size_t)HALF * g.ldb * 2;
    const size_t tstepA = 2 * hstepA, tstepB = 2 * hstepB;
    const unsigned ldsw = (unsigned)wid * 1024u;
    const int aoff = lds_byte(wr * 64 + fr, fq * 8), boff = lds_byte(wc * 32 + fr, fq * 8);
#define PG8_SA(b, h) (((b) * 2 + (h)) * HTB)
#define PG8_SB(b, h) ((4 + (b) * 2 + (h)) * HTB)
#define PG8_STAGE(bufoff, gbase, voff) do { _Pragma("unroll") for (int _i = 0; _i < 2; ++_i) \
        __builtin_amdgcn_global_load_lds((const unsigned*)((const char*)(gbase) + (voff)[_i]), (LAS unsigned*)(lds + (bufoff) + ldsw + _i * 8192), 16, 0, 0); } while (0)
#define PG8_LDA(dst, b, h) do { _Pragma("unroll") for (int m = 0; m < 4; ++m) _Pragma("unroll") for (int k = 0; k < 2; ++k) dst[m][k] = *(const LAS bf16x8*)(lds + PG8_SA(b, h) + aoff + m * 2048 + k * 1024); } while (0)
#define PG8_LDB(dst, b, h) do { _Pragma("unroll") for (int n = 0; n < 2; ++n) _Pragma("unroll") for (int k = 0; k < 2; ++k) dst[n][k] = *(const LAS bf16x8*)(lds + PG8_SB(b, h) + boff + n * 2048 + k * 1024); } while (0)
#define PG8_MMA(ai, bj, At, Bt) do { __builtin_amdgcn_s_setprio(1); _Pragma("unroll") for (int m = 0; m < 4; ++m) _Pragma("unroll") for (int n = 0; n < 2; ++n) _Pragma("unroll") for (int k = 0; k < 2; ++k) \
        acc[ai][bj][m][n] = __builtin_amdgcn_mfma_f32_16x16x32_bf16(Bt[n][k], At[m][k], acc[ai][bj][m][n], 0, 0, 0); __builtin_amdgcn_s_setprio(0); } while (0)
#define PG8_WAIT_V(n) asm volatile("s_waitcnt vmcnt(" #n ")" ::: "memory")
#define PG8_WAIT_L(n) asm volatile("s_waitcnt lgkmcnt(" #n ")" ::: "memory")
#define PG8_BAR __builtin_amdgcn_s_barrier()
#define PG8_SCHED __builtin_amdgcn_sched_barrier(0)
    Unit cur, nxt; int ui = 0;
    if (!S.next(0, cur)) return;
    f32x4 acc[2][2][4][2];
#pragma unroll
    for (int a = 0; a < 2; ++a)
#pragma unroll
        for (int b = 0; b < 2; ++b)
#pragma unroll
            for (int m = 0; m < 4; ++m)
#pragma unroll
                for (int n = 0; n < 2; ++n) acc[a][b][m][n] = (f32x4){0.f, 0.f, 0.f, 0.f};
    bf16x8 At[4][2], B0[2][2], B1[2][2];
    const char* cA = (const char*)g.A + (size_t)cur.pm * tstepA + (size_t)cur.kt0 * kstep; const char* cB = (const char*)g.Bt + (size_t)cur.pn * tstepB + (size_t)cur.kt0 * kstep;
    PG8_STAGE(PG8_SB(0, 0), cB, voffB); PG8_STAGE(PG8_SB(0, 1), cB + hstepB, voffB); PG8_STAGE(PG8_SA(0, 0), cA, voffA); PG8_STAGE(PG8_SA(0, 1), cA + hstepA, voffA);
    if (wr == 1) PG8_BAR;
    PG8_WAIT_V(2); PG8_BAR;
    PG8_STAGE(PG8_SB(1, 0), cB + kstep, voffB); PG8_STAGE(PG8_SA(1, 0), cA + kstep, voffA); PG8_STAGE(PG8_SB(1, 1), cB + hstepB + kstep, voffB);
    PG8_WAIT_V(6); PG8_BAR;
    for (;;) {
        const bool has_next = S.next(ui + 1, nxt);
        const char* nA = has_next ? (const char*)g.A + (size_t)nxt.pm * tstepA + (size_t)nxt.kt0 * kstep : cA;
        const char* nB = has_next ? (const char*)g.Bt + (size_t)nxt.pn * tstepB + (size_t)nxt.kt0 * kstep : cB;
        const int nt = cur.nkt;
        for (int t = 0; t < nt; t += 2) {
            const bool last = (t == nt - 2);
            const char* a1 = cA + (size_t)(t + 1) * kstep;
            const char* a2 = last ? nA : cA + (size_t)(t + 2) * kstep; const char* b2 = last ? nB : cB + (size_t)(t + 2) * kstep;
            const char* a3 = a2 + kstep; const char* b3 = b2 + kstep;
            PG8_LDB(B0, 0, 0); PG8_LDB(B1, 0, 1); PG8_SCHED; PG8_LDA(At, 0, 0); PG8_STAGE(PG8_SA(1, 1), a1 + hstepA, voffA);
            PG8_WAIT_V(8); PG8_WAIT_L(0); PG8_BAR; PG8_MMA(0, 0, At, B0); PG8_MMA(0, 1, At, B1); PG8_BAR; PG8_SCHED;
            PG8_LDA(At, 0, 1); PG8_STAGE(PG8_SB(0, 0), b2, voffB); PG8_STAGE(PG8_SB(0, 1), b2 + hstepB, voffB); PG8_STAGE(PG8_SA(0, 0), a2, voffA);
            PG8_WAIT_V(8); PG8_WAIT_L(0); PG8_BAR; PG8_MMA(1, 0, At, B0); PG8_MMA(1, 1, At, B1); PG8_BAR; PG8_SCHED;
            PG8_LDB(B0, 1, 0); PG8_LDB(B1, 1, 1); PG8_SCHED; PG8_LDA(At, 1, 0); PG8_STAGE(PG8_SA(0, 1), a2 + hstepA, voffA);
            PG8_WAIT_V(8); PG8_WAIT_L(0); PG8_BAR; PG8_MMA(0, 0, At, B0); PG8_MMA(0, 1, At, B1); PG8_BAR; PG8_SCHED;
            PG8_LDA(At, 1, 1); PG8_STAGE(PG8_SB(1, 0), b3, voffB); PG8_STAGE(PG8_SB(1, 1), b3 + hstepB, voffB); PG8_STAGE(PG8_SA(1, 0), a3, voffA);
            PG8_WAIT_V(8); PG8_WAIT_L(0); PG8_BAR; PG8_MMA(1, 0, At, B0); PG8_MMA(1, 1, At, B1); PG8_BAR; PG8_SCHED;
        }
        if (wr == 0) PG8_BAR;
        E(acc, cur, wr, wc, fr, fq);
        if (!has_next) break;
#pragma unroll
        for (int a = 0; a < 2; ++a)
#pragma unroll
            for (int b = 0; b < 2; ++b)
#pragma unroll
                for (int m = 0; m < 4; ++m)
#pragma unroll
                    for (int n = 0; n < 2; ++n) acc[a][b][m][n] = (f32x4){0.f, 0.f, 0.f, 0.f};
        cur = nxt; cA = nA; cB = nB; ++ui;
        if (wr == 1) PG8_BAR;
    }
    PG8_WAIT_V(0);
    PG8_BAR;
#undef PG8_SA
#undef PG8_SB
#undef PG8_STAGE
#undef PG8_LDA
#undef PG8_LDB
#undef PG8_MMA
#undef PG8_WAIT_V
#undef PG8_WAIT_L
#undef PG8_BAR
#undef PG8_SCHED
}
}


#define XB_TMO      128
#define XB_XCNT(j)  (256  + 64 * (j))
#define XB_XSUB(j)  (1280 + 64 * (j))
#define XB_XGEN(j)  (2304 + 64 * (j))
#define XB_TOP      3328
#define XB_TOPGEN   3392
#define XCD_BAR_WORDS 3456
#define XB_SPIN_CAP (1u << 22)
__device__ __forceinline__ unsigned xb_ld(unsigned* p)              { return __hip_atomic_load(p, __ATOMIC_RELAXED, __HIP_MEMORY_SCOPE_AGENT); }
__device__ __forceinline__ unsigned xb_add(unsigned* p, unsigned v) { return __hip_atomic_fetch_add(p, v, __ATOMIC_RELAXED, __HIP_MEMORY_SCOPE_AGENT); }
__device__ __forceinline__ unsigned xb_xcc_id() { return (unsigned)__builtin_amdgcn_s_getreg((3 << 11) | 20) & 0xFu; }
#define XB_SPIN(cond, bar) do { unsigned _sp = 0; while (cond) { __builtin_amdgcn_s_sleep(1); \
    if ((++_sp & 255u) == 0u) { if (xb_ld(&(bar)[XB_TMO])) break; if (_sp > XB_SPIN_CAP) { atomicAdd(&(bar)[XB_TMO], 1u); break; } } } } while (0)
struct XcdBarrier { unsigned* bar; unsigned x; volatile LAS unsigned* st; };
__device__ __forceinline__ XcdBarrier xcd_barrier_post(unsigned* bar, volatile LAS unsigned* st) {
    XcdBarrier b; b.bar = bar; b.x = xb_xcc_id(); b.st = st;
    if (threadIdx.x == 0) (void)xb_add(&bar[XB_XCNT(b.x)], 1u);
    return b;
}
__device__ __forceinline__ void xcd_barrier_complete(unsigned* bar, unsigned x, unsigned& nloc, unsigned& nx) {
    const unsigned G = gridDim.x * gridDim.y * gridDim.z;
    unsigned sum, cnt, mine, sp = 0u;
    for (;;) {
        sum = 0u; cnt = 0u; mine = 0u;
#pragma unroll
        for (unsigned j = 0; j < 16; ++j) { const unsigned c = xb_ld(&bar[XB_XCNT(j)]); sum += c; cnt += (c > 0u) ? 1u : 0u; mine = (j == x) ? c : mine; }
        if (sum == G) break;
        __builtin_amdgcn_s_sleep(1);
        if ((++sp & 255u) == 0u) { if (xb_ld(&bar[XB_TMO])) break; if (sp > XB_SPIN_CAP) { atomicAdd(&bar[XB_TMO], 1u); break; } }
    }
    nloc = mine > 0u ? mine : 1u; nx = cnt > 0u ? cnt : 1u;
}
__device__ __forceinline__ void xcd_barrier(const XcdBarrier& b0) {
    XcdBarrier b; b.bar = b0.bar; b.st = b0.st; b.x = (unsigned)__builtin_amdgcn_readfirstlane((int)xb_xcc_id());
    asm volatile("s_waitcnt vmcnt(0)" ::: "memory");
    __syncthreads();
    if (threadIdx.x == 0) {
        unsigned* bar = b.bar;
        __builtin_amdgcn_s_waitcnt(0);
        unsigned nloc = b.st[0], nx = b.st[1];
        if (nloc == 0u) { xcd_barrier_complete(bar, b.x, nloc, nx); b.st[0] = nloc; b.st[1] = nx; }
        const unsigned old = xb_add(&bar[XB_XSUB(b.x)], 1u);
        const unsigned gen = old / nloc;
        if (old + 1u == (gen + 1u) * nloc) {
            __builtin_amdgcn_fence(__ATOMIC_RELEASE, "agent");
            asm volatile("s_waitcnt vmcnt(0)" ::: "memory");
            const unsigned og = xb_add(&bar[XB_TOP], 1u);
            const unsigned tg = og / nx;
            if (og + 1u == (tg + 1u) * nx) xb_add(&bar[XB_TOPGEN], 1u);
            else XB_SPIN(xb_ld(&bar[XB_TOPGEN]) == tg, bar);
            __builtin_amdgcn_fence(__ATOMIC_ACQUIRE, "agent");
            xb_add(&bar[XB_XGEN(b.x)], 1u);
            asm volatile("s_waitcnt vmcnt(0)" ::: "memory");
        } else {
            XB_SPIN(xb_ld(&bar[XB_XGEN(b.x)]) == gen, bar);
            __builtin_amdgcn_fence(__ATOMIC_ACQUIRE, "agent");
            asm volatile("s_waitcnt vmcnt(0)" ::: "memory");
        }
    }
    __syncthreads();
}

constexpr int CW_HAND = 32768;
__device__ __forceinline__ void hand_signal(unsigned* cnt) {
    asm volatile("s_waitcnt vmcnt(0)" ::: "memory");
    __syncthreads();
    if (threadIdx.x == 0) { __builtin_amdgcn_fence(__ATOMIC_RELEASE, "agent"); asm volatile("s_waitcnt vmcnt(0)" ::: "memory");
        __hip_atomic_fetch_add(cnt, 1u, __ATOMIC_RELAXED, __HIP_MEMORY_SCOPE_AGENT); }
}
__device__ __forceinline__ void hand_wait(unsigned* cnt, unsigned need) {
    if (threadIdx.x == 0) { unsigned sp = 0;
        while (__hip_atomic_load(cnt, __ATOMIC_RELAXED, __HIP_MEMORY_SCOPE_AGENT) < need) { __builtin_amdgcn_s_sleep(2); if (++sp > (1u << 24)) break; }
        __builtin_amdgcn_fence(__ATOMIC_ACQUIRE, "agent"); asm volatile("s_waitcnt vmcnt(0)" ::: "memory"); }
    __syncthreads();
}

constexpr int LDS_BYTES = 147456;
struct Params {
    const float* in[22]; const int* page_table; float* out; unsigned char* ws; int pad0, pad1;
};
struct Frame {
    LAS unsigned char* lds;
    int tid, lane, wave, G, c;
    const Params* p;
};

__device__ __forceinline__ void transpose_item(const float* W, int ldw, int k0, int n_src0, int n_valid, bf16_t* WT, int ldd, int row_base, int row_stride, LAS float* scr, int lane) {
    const int n4 = (lane & 7) * 4;
    f32x4 v[8];
#pragma unroll
    for (int i = 0; i < 8; ++i) { const int kk = 8 * i + (lane >> 3); v[i] = (n_src0 + n4 < n_valid) ? __builtin_nontemporal_load((const f32x4*)(W + (size_t)(k0 + kk) * ldw + n_src0 + n4)) : (f32x4){0.f, 0.f, 0.f, 0.f}; }
#pragma unroll
    for (int i = 0; i < 8; ++i) { LAS float* d = scr + (8 * i + (lane >> 3)) * 33 + n4; d[0] = v[i].x; d[1] = v[i].y; d[2] = v[i].z; d[3] = v[i].w; }
    LDS_WAIT(); asm volatile("" ::: "memory");
    const int c = lane & 7;
#pragma unroll
    for (int j = 0; j < 4; ++j) { const int n = (lane >> 3) + 8 * j; const LAS float* s = scr + (8 * c) * 33 + n;
        u32x4 o; o.x = pk2(s[0 * 33], s[1 * 33]); o.y = pk2(s[2 * 33], s[3 * 33]); o.z = pk2(s[4 * 33], s[5 * 33]); o.w = pk2(s[6 * 33], s[7 * 33]);
        if (n_src0 + n < n_valid) *(u32x4*)(WT + (size_t)(row_base + n * row_stride) * ldd + k0 + 8 * c) = o; }
    LDS_WAIT(); asm volatile("" ::: "memory");
}
__device__ __forceinline__ void rms_row_to_bf16(const float* xrow, const float* w, bf16_t* orow, int lane) {
    const f32x4* xr = (const f32x4*)xrow + lane; const f32x4* wr = (const f32x4*)w + lane;
    f32x4 v[4]; float s = 0.f;
#pragma unroll
    for (int j = 0; j < 4; ++j) { v[j] = xr[64 * j]; s += (v[j].x * v[j].x + v[j].y * v[j].y) + (v[j].z * v[j].z + v[j].w * v[j].w); }
    const float rs = rsqrtf(wave_sum(s) * (1.f / DM) + RMS_EPS);
    u32x2* o8 = (u32x2*)orow + lane;
#pragma unroll
    for (int j = 0; j < 4; ++j) { const f32x4 g = wr[64 * j]; u32x2 o; o.x = pk2(v[j].x * rs * g.x, v[j].y * rs * g.y); o.y = pk2(v[j].z * rs * g.z, v[j].w * rs * g.w); o8[64 * j] = o; }
}

__device__ __forceinline__ void p0_prologue(Frame& F) {
    const Params& P = *F.p;
    unsigned char* ws = P.ws;
    LAS float* scr = (LAS float*)(F.lds + F.wave * 16384);
    const int gw = F.c * NWAVES + F.wave, NGW = F.G * NWAVES;
    const int gt = F.c * NTHREADS + F.tid, NGT = F.G * NTHREADS;
    constexpr int I_IN0 = 16 * 22, I_ROPE = 6 * 16, I_WO = 16 * 32, I_F1 = 16 * 176, I_F2 = 44 * 32, I_DIN = 16 * 129, I_DO = 16 * 32;
    constexpr int NITEMS = I_IN0 + I_ROPE + I_WO + 2 * I_F1 + 2 * I_F2 + I_DIN + I_DO;
    for (int it = gw; it < NITEMS; it += NGW) {
        int r = it;
        if (r < I_IN0) { const int kb = r / 22, nb = r % 22; transpose_item(P.in[7], NIN0, 64 * kb, 32 * nb, NIN0, (bf16_t*)(ws + WS_WT_IN0), 1024, 32 * nb, 1, scr, F.lane); continue; } r -= I_IN0;
        if (r < I_ROPE) { const int kb = r / 16, hs = r % 16, h = hs >> 1, s = hs & 1;
            transpose_item(P.in[10], 1536, 64 * kb, h * 192 + 128 + 32 * s, 1536, (bf16_t*)(ws + WS_WT_Q), 512, 2048 + h * 64 + s, 2, scr, F.lane); continue; } r -= I_ROPE;
        if (r < I_WO) { const int kb = r / 32, nb = r % 32; transpose_item(P.in[13], 1024, 64 * kb, 32 * nb, 1024, (bf16_t*)(ws + WS_WOT), 1024, 32 * nb, 1, scr, F.lane); continue; } r -= I_WO;
        if (r < 2 * I_F1) { const int l = r / I_F1, q = r % I_F1, kb = q / 176, nb = q % 176; const int n0 = 32 * nb; const int nn = n0 < DFF ? n0 : n0 - DFF;
            const int row = 256 * (nn / 128) + (n0 < DFF ? 0 : 128) + (nn % 128);
            transpose_item(P.in[20] + (size_t)l * 1024 * 5632, 5632, 64 * kb, n0, 5632, (bf16_t*)(ws + WS_WT_F1) + (size_t)l * 5632 * 1024, 1024, row, 1, scr, F.lane); continue; } r -= 2 * I_F1;
        if (r < 2 * I_F2) { const int l = r / I_F2, q = r % I_F2, kb = q / 32, nb = q % 32;
            transpose_item(P.in[21] + (size_t)l * DFF * 1024, 1024, 64 * kb, 32 * nb, 1024, (bf16_t*)(ws + WS_WT_F2) + (size_t)l * 1024 * DFF, DFF, 32 * nb, 1, scr, F.lane); continue; } r -= 2 * I_F2;
        if (r < I_DIN) { const int kb = r / 129, nb = r % 129; transpose_item(P.in[14], DN_N, 64 * kb, 32 * nb, DN_N, (bf16_t*)(ws + WS_WT_DIN), 1024, 32 * nb, 1, scr, F.lane); continue; } r -= I_DIN;
        { const int kb = r / 32, nb = r % 32; transpose_item(P.in[19], 1024, 64 * kb, 32 * nb, 1024, (bf16_t*)(ws + WS_WT_DO), 1024, 32 * nb, 1, scr, F.lane); }
    }
    {
        constexpr int N_BD = 2048 * 128, N_UQ = 512 * 128, N_PADIN = 64 * 128, N_PADD = (DN_NP - DN_N) * 128;
        for (int it = gt; it < 2 * N_BD + N_UQ + N_PADIN + N_PADD; it += NGT) {
            int r = it; u32x4 o = {0u, 0u, 0u, 0u}; bf16_t* dst;
            if (r < 2 * N_BD) { const int which = r / N_BD, q = r % N_BD, row = q >> 7, c8 = (q & 127) * 8, h = row >> 8, rr = row & 255;
                const float* src = (which ? P.in[11] : P.in[12]) + ((size_t)h * 256 + rr) * 128;
                if ((c8 >> 7) == h) { const f32x4 a = *(const f32x4*)(src + (c8 & 127)), b = *(const f32x4*)(src + (c8 & 127) + 4); o.x = pk2(a.x, a.y); o.y = pk2(a.z, a.w); o.z = pk2(b.x, b.y); o.w = pk2(b.z, b.w); }
                dst = (bf16_t*)(ws + (which ? WS_BD_UK : WS_BD_UV)) + (size_t)row * 1024 + c8;
            } else if ((r -= 2 * N_BD) < N_UQ) { const int row = r >> 7, c8 = (r & 127) * 8, h = c8 >> 7, n = c8 & 127;
                if (row < 384) { const float* src = P.in[10] + (size_t)row * 1536 + h * 192 + n; const f32x4 a = *(const f32x4*)src, b = *(const f32x4*)(src + 4); o.x = pk2(a.x, a.y); o.y = pk2(a.z, a.w); o.z = pk2(b.x, b.y); o.w = pk2(b.z, b.w); }
                dst = (bf16_t*)(ws + WS_UQN) + (size_t)row * 1024 + c8;
            } else if ((r -= N_UQ) < N_PADIN) { dst = (bf16_t*)(ws + WS_WT_IN0) + (size_t)(NIN0 + (r >> 7)) * 1024 + (r & 127) * 8;
            } else { r -= N_PADIN; dst = (bf16_t*)(ws + WS_WT_DIN) + (size_t)(DN_N + (r >> 7)) * 1024 + (r & 127) * 8; }
            *(u32x4*)dst = o;
        }
    }
    for (int it = gt; it < 2052 * 32; it += NGT) { const int pi = it >> 5, i = it & 31; const float pos = (float)(pi < SEQ ? pi : PAST + (pi - SEQ));
        const float freq = exp2f(-(float)i * (13.287712379549449f / 32.0f)); const float ang = pos * freq;
        ((f32x2*)(ws + WS_ROPE))[it] = (f32x2){cosf(ang), sinf(ang)}; }
    for (int m = gw; m < MT; m += NGW) {
        bf16_t* orow = (bf16_t*)(ws + WS_U) + (size_t)m * DM;
        if (m < MV) { const float* xrow = m < MP ? P.in[0] + (size_t)m * DM : P.in[1] + (size_t)(m - MP) * DM; rms_row_to_bf16(xrow, P.in[6], orow, F.lane); }
        else { u32x4 z = {0u, 0u, 0u, 0u}; ((u32x4*)orow)[F.lane] = z; ((u32x4*)orow)[F.lane + 64] = z; }
    }
}

__device__ __forceinline__ void m2_rows(Frame& F) {
    const Params& P = *F.p; unsigned char* ws = P.ws; OPAQUE_WS(ws);
    const int gw = F.c * NWAVES + F.wave, NGW = F.G * NWAVES, lane = F.lane;
    const float* gq = P.in[8]; const float* gkv = P.in[9];
    const f32x2* rope = (const f32x2*)(ws + WS_ROPE);
    for (int m = gw; m < MV; m += NGW) {
        const float* a = (const float*)(ws + WS_A0) + (size_t)m * NIN0P;
        float v[11];
#pragma unroll
        for (int j = 0; j < 11; ++j) v[j] = __builtin_nontemporal_load(a + lane + 64 * j);
        float sq = 0.f, sk = 0.f;
#pragma unroll
        for (int j = 0; j < 6; ++j) sq += v[j] * v[j];
#pragma unroll
        for (int j = 6; j < 10; ++j) sk += v[j] * v[j];
        const float rq = rsqrtf(wave_sum(sq) * (1.f / Q_LORA) + RMS_EPS), rk = rsqrtf(wave_sum(sk) * (1.f / KV_LORA) + RMS_EPS);
        bf16_t* cq = (bf16_t*)(ws + WS_CQ) + (size_t)m * Q_LORA;
#pragma unroll
        for (int j = 0; j < 6; ++j) cq[lane + 64 * j] = (bf16_t)f2bf(v[j] * rq * gq[lane + 64 * j]);
        float* orow = P.out + O_ROWS + (size_t)m * MLA_ROW; bf16_t* rb = (bf16_t*)(ws + WS_ROWSB) + (size_t)m * MLA_ROW;
#pragma unroll
        for (int j = 0; j < 4; ++j) { const float y = v[6 + j] * rk * gkv[lane + 64 * j]; __builtin_nontemporal_store(y, orow + lane + 64 * j); rb[lane + 64 * j] = (bf16_t)f2bf(y); }
        const int pidx = m < MP ? (m & (SEQ - 1)) : (SEQ + ((m - MP) & 3));
        const int i = lane & 31; const f32x2 cs = rope[pidx * 32 + i];
        const float other = __shfl_xor(v[10], 32);
        const float y = lane < 32 ? v[10] * cs.x - other * cs.y : v[10] * cs.x + other * cs.y;
        __builtin_nontemporal_store(y, orow + 256 + lane); rb[256 + lane] = (bf16_t)f2bf(y);
    }
}


#define LDS_BARRIER() do { asm volatile("s_waitcnt lgkmcnt(0)" ::: "memory"); __builtin_amdgcn_s_barrier(); asm volatile("" ::: "memory"); } while (0)
namespace attn {
typedef short v4i16_t __attribute__((ext_vector_type(4)));
constexpr int TILE_BYTES = 64 * 640;
__device__ __forceinline__ int koff(int row, int ch) { return 5120 * (row >> 3) + 512 * (ch >> 2) + 64 * (row & 7) + 16 * ((ch & 3) ^ ((row >> 2) & 3)); }

__device__ __forceinline__ float hmax16(float x) { float a = x, b = x; asm volatile("s_nop 1\n\tv_permlane16_swap_b32 %0, %1" : "+v"(a), "+v"(b)); return fmaxf(a, b); }
__device__ __forceinline__ float hmax32(float x) { float a = x, b = x; asm volatile("s_nop 1\n\tv_permlane32_swap_b32 %0, %1" : "+v"(a), "+v"(b)); return fmaxf(a, b); }
struct State { f32x4 o[16]; float m, l; };
struct Addr { int kb0, kb1, tb00, tb01, tb10, tb11; };
__device__ __forceinline__ Addr make_addr(int lane) {
    const int g = lane >> 4, rho = lane & 15, q4 = rho >> 2, p4 = lane & 3; Addr a;
    a.kb0 = 5120 * q4 + 64 * (rho & 3) + 16 * (g ^ (2 * (q4 & 1)));  a.kb1 = a.kb0 ^ 16;
    const int t0 = 5120 * g + 64 * q4 + 8 * (p4 & 1) + 32 * (g & 1) + 16 * (p4 >> 1);
    a.tb00 = t0; a.tb01 = t0 ^ 16; a.tb10 = t0 ^ 32; a.tb11 = t0 ^ 48;
    return a;
}
__device__ __forceinline__ void pv_load(bf16x8 (&vf)[8], const LAS unsigned char* buf, const Addr& A, int i) {
#pragma unroll
    for (int c = 0; c < 4; ++c) { const int cb = 4 * i + c;
        const LAS unsigned char* v0 = buf + ((cb & 1) ? A.tb10 : A.tb00) + 512 * (cb >> 1);
        const LAS unsigned char* v1 = buf + ((cb & 1) ? A.tb11 : A.tb01) + 512 * (cb >> 1) + 256;
#pragma unroll
        for (int ks = 0; ks < 2; ++ks) {
            const v4i16_t t0 = __builtin_amdgcn_ds_read_tr16_b64_v4i16((LAS v4i16_t*)(v0 + 20480 * ks));
            const v4i16_t t1 = __builtin_amdgcn_ds_read_tr16_b64_v4i16((LAS v4i16_t*)(v1 + 20480 * ks));
            vf[2 * c + ks] = __builtin_shufflevector(t0, t1, 0, 1, 2, 3, 4, 5, 6, 7); } }
}
__device__ __forceinline__ void pv_mma(State& st, const bf16x8 (&vf)[8], const bf16x8 (&pf)[2], int i) {
#pragma unroll
    for (int c = 0; c < 4; ++c)
#pragma unroll
        for (int ks = 0; ks < 2; ++ks) st.o[4 * i + c] = __builtin_amdgcn_mfma_f32_16x16x32_bf16(vf[2 * c + ks], pf[ks], st.o[4 * i + c], 0, 0, 0);
}
__device__ __forceinline__ void tile_scores(const LAS unsigned char* buf, const Addr& A, const bf16x8 (&qf)[10], State& st, int limit, bool need_mask, int lane, bf16x8 (&pf)[2], bf16x8 (&vf0)[8]) {
    const int g = lane >> 4;
    f32x4 sacc[4];
    __builtin_amdgcn_s_setprio(1);
    bf16x8 kf[2][5];
#pragma unroll
    for (int b = 0; b < 4; ++b) sacc[b] = (f32x4){0.f, 0.f, 0.f, 0.f};
#pragma unroll
    for (int j = 0; j < 5; ++j) kf[0][j] = *(const LAS bf16x8*)(buf + A.kb0 + 512 * j);
#pragma unroll
    for (int i = 0; i < 8; ++i) {
        if (i + 1 < 8) { const int b1 = (i + 1) >> 1; const LAS unsigned char* kp = buf + ((b1 & 1) ? A.kb1 : A.kb0) + 20480 * (b1 >> 1) + 256 * (b1 & 1) + 2560 * ((i + 1) & 1);
#pragma unroll
            for (int j = 0; j < 5; ++j) kf[(i + 1) & 1][j] = *(const LAS bf16x8*)(kp + 512 * j); }
        __builtin_amdgcn_sched_barrier(0);
#pragma unroll
        for (int j = 0; j < 5; ++j) sacc[i >> 1] = __builtin_amdgcn_mfma_f32_16x16x32_bf16(kf[i & 1][j], qf[5 * (i & 1) + j], sacc[i >> 1], 0, 0, 0);
        __builtin_amdgcn_sched_barrier(0);
    }
    __builtin_amdgcn_s_setprio(0);
    if (need_mask) {
#pragma unroll
        for (int b = 0; b < 4; ++b)
#pragma unroll
            for (int r = 0; r < 4; ++r) { const int key = 32 * (b >> 1) + 8 * g + 4 * (b & 1) + r; sacc[b][r] = key > limit ? -1e30f : sacc[b][r]; }
    }
    float mx = fmaxf(fmaxf(fmaxf(sacc[0][0], sacc[0][1]), fmaxf(sacc[0][2], sacc[0][3])), fmaxf(fmaxf(sacc[1][0], sacc[1][1]), fmaxf(sacc[1][2], sacc[1][3])));
    mx = fmaxf(mx, fmaxf(fmaxf(fmaxf(sacc[2][0], sacc[2][1]), fmaxf(sacc[2][2], sacc[2][3])), fmaxf(fmaxf(sacc[3][0], sacc[3][1]), fmaxf(sacc[3][2], sacc[3][3]))));
    mx = hmax16(mx); mx = hmax32(mx);
    __builtin_amdgcn_sched_barrier(0);
    pv_load(vf0, buf, A, 0);
    __builtin_amdgcn_sched_barrier(0);
    if (!__all(mx - st.m <= 6.0f)) {
        const float mnew = fmaxf(st.m, mx), alpha = __builtin_amdgcn_exp2f(st.m - mnew); st.m = mnew;
        st.l *= alpha;
#pragma unroll
        for (int cb = 0; cb < 16; ++cb) st.o[cb] = st.o[cb] * alpha;
    }
    float ps = 0.f;
#pragma unroll
    for (int b = 0; b < 4; ++b)
#pragma unroll
        for (int r = 0; r < 4; ++r) { const float p = __builtin_amdgcn_exp2f(sacc[b][r] - st.m); sacc[b][r] = p; ps += p; }
    st.l += ps;
#pragma unroll
    for (int ks = 0; ks < 2; ++ks) { u32x4 w; w.x = cvt_pk_bf16(sacc[2 * ks][0], sacc[2 * ks][1]); w.y = cvt_pk_bf16(sacc[2 * ks][2], sacc[2 * ks][3]);
        w.z = cvt_pk_bf16(sacc[2 * ks + 1][0], sacc[2 * ks + 1][1]); w.w = cvt_pk_bf16(sacc[2 * ks + 1][2], sacc[2 * ks + 1][3]); pf[ks] = __builtin_bit_cast(bf16x8, w); }
}
__device__ __forceinline__ void tile_pv(const LAS unsigned char* buf, const Addr& A, State& st, const bf16x8 (&pf)[2], bf16x8 (&vf0)[8]) {
    bf16x8 vf1[8];
    __builtin_amdgcn_s_setprio(1);
    pv_load(vf1, buf, A, 1); __builtin_amdgcn_sched_barrier(0); pv_mma(st, vf0, pf, 0); __builtin_amdgcn_sched_barrier(0);
    pv_load(vf0, buf, A, 2); __builtin_amdgcn_sched_barrier(0); pv_mma(st, vf1, pf, 1); __builtin_amdgcn_sched_barrier(0);
    pv_load(vf1, buf, A, 3); __builtin_amdgcn_sched_barrier(0); pv_mma(st, vf0, pf, 2); __builtin_amdgcn_sched_barrier(0);
    pv_mma(st, vf1, pf, 3);
    __builtin_amdgcn_s_setprio(0);
}
__device__ __forceinline__ void load_q(bf16x8 (&qf)[10], const bf16_t* Q, int row, int h, int g) {
    const bf16_t* qr = Q + (size_t)row * NQ;
#pragma unroll
    for (int s = 0; s < 8; ++s) qf[s] = __builtin_nontemporal_load((const bf16x8*)(qr + h * 256 + 32 * s + 8 * g));
#pragma unroll
    for (int s = 0; s < 2; ++s) qf[8 + s] = __builtin_nontemporal_load((const bf16x8*)(qr + 2048 + h * 64 + 32 * s + 8 * g));
}
__device__ __forceinline__ void state_init(State& st) {
#pragma unroll
    for (int cb = 0; cb < 16; ++cb) st.o[cb] = (f32x4){0.f, 0.f, 0.f, 0.f};
    st.m = -1e30f; st.l = 0.f;
}
__device__ __forceinline__ int stage_lds_off(int tid) { const int row = tid >> 3; return 5120 * (row >> 3) + 64 * (row & 7) + 512 * ((tid & 7) >> 2) + 16 * ((tid & 3) ^ ((row >> 2) & 3)); }
__device__ __forceinline__ void prompt_unit(Frame& F, int b, int qb) {
    unsigned char* ws = F.p->ws; OPAQUE_WS(ws); int tid = F.tid; asm volatile("" : "+v"(tid));
    const int lane = tid & 63, h = F.wave, g = lane >> 4, qi = lane & 15;
    const int p0 = 16 * qb, nt = (p0 + 15) / 64 + 1;
    const unsigned char* rows = (const unsigned char*)((const bf16_t*)(ws + WS_ROWSB) + (size_t)b * SEQ * MLA_ROW) + (tid >> 3) * 640 + (tid & 7) * 16;
    const int soff = stage_lds_off(tid);
    bf16x8 qf[10]; load_q(qf, (const bf16_t*)(ws + WS_Q), b * SEQ + p0 + qi, h, g);
    State st; state_init(st); const Addr AD = make_addr(lane);
    u32x4 pre[3];
#pragma unroll
    for (int j = 0; j < 5; ++j) *(LAS u32x4*)(F.lds + soff + 1024 * j) = *(const u32x4*)(rows + 128 * j);
    LDS_BARRIER();
    for (int kt = 0; kt < nt; ++kt) {
        const LAS unsigned char* buf = F.lds + (kt & 1) * TILE_BYTES; LAS unsigned char* nbuf = F.lds + ((kt + 1) & 1) * TILE_BYTES + soff;
        const bool more = kt + 1 < nt; const unsigned char* src = rows + (size_t)(more ? kt + 1 : kt) * (64 * 640);
        bf16x8 pf[2], vf0[8];
#pragma unroll
        for (int j = 0; j < 3; ++j) pre[j] = *(const u32x4*)(src + 128 * j);
        __builtin_amdgcn_sched_barrier(0);
        tile_scores(buf, AD, qf, st, p0 + qi - 64 * kt, 64 * kt + 63 > p0, lane, pf, vf0);
        if (more) {
#pragma unroll
            for (int j = 0; j < 3; ++j) *(LAS u32x4*)(nbuf + 1024 * j) = pre[j];
        }
#pragma unroll
        for (int j = 0; j < 2; ++j) pre[j] = *(const u32x4*)(src + 128 * (3 + j));
        __builtin_amdgcn_sched_barrier(0);
        tile_pv(buf, AD, st, pf, vf0);
        if (more) {
#pragma unroll
            for (int j = 0; j < 2; ++j) *(LAS u32x4*)(nbuf + 1024 * (3 + j)) = pre[j];
        }
        LDS_BARRIER();
    }
    float l = xsum32(xsum16(st.l));
    const float inv = 1.f / l;
    bf16_t* orow = (bf16_t*)(ws + WS_OL) + (size_t)(b * SEQ + p0 + qi) * 2048 + h * 256 + 4 * g;
#pragma unroll
    for (int cb = 0; cb < 16; ++cb) { u32x2 w; w.x = cvt_pk_bf16(st.o[cb][0] * inv, st.o[cb][1] * inv); w.y = cvt_pk_bf16(st.o[cb][2] * inv, st.o[cb][3] * inv); *(u32x2*)(orow + 16 * cb) = w; }
}
__device__ __forceinline__ void cache_load10(f32x4 (&pre)[10], const float* src) {
#pragma unroll
    for (int k = 0; k < 10; ++k) pre[k] = __builtin_nontemporal_load((const f32x4*)(src + 32 * k));
}
__device__ __forceinline__ void cache_store10(const f32x4 (&pre)[10], LAS unsigned char* dst) {
#pragma unroll
    for (int k = 0; k < 10; ++k) { u32x2 w; w.x = cvt_pk_bf16(pre[k][0], pre[k][1]); w.y = cvt_pk_bf16(pre[k][2], pre[k][3]); *(LAS u32x2*)(dst + 512 * k) = w; }
}
template <int J0, int J1>
__device__ __forceinline__ void load_cache_part(f32x4 (&pre)[10], const float* src) {
#pragma unroll
    for (int j = J0; j < J1; ++j) { pre[2 * (j - J0)] = *(const f32x4*)(src + 64 * j); pre[2 * (j - J0) + 1] = *(const f32x4*)(src + 64 * j + 4); }
}
template <int J0, int J1>
__device__ __forceinline__ void store_cache_part(const f32x4 (&pre)[10], LAS unsigned char* dst) {
#pragma unroll
    for (int j = J0; j < J1; ++j) { const int k = 2 * (j - J0); u32x4 w; w.x = cvt_pk_bf16(pre[k][0], pre[k][1]); w.y = cvt_pk_bf16(pre[k][2], pre[k][3]);
        w.z = cvt_pk_bf16(pre[k + 1][0], pre[k + 1][1]); w.w = cvt_pk_bf16(pre[k + 1][2], pre[k + 1][3]); *(LAS u32x4*)(dst + 1024 * j) = w; }
}
__device__ __forceinline__ const float* cache_tile_src(const float* cache, int pgv, int kt) {
    const int page = __builtin_amdgcn_readlane(pgv, kt >> 1);
    return cache + ((size_t)page * PAGE + (kt & 1) * 64) * MLA_ROW;
}
__device__ __forceinline__ void samp_tile(const LAS unsigned char* buf, const Addr& A, const bf16x8 (&qf)[10], State& st, int kb, int limit, bool need_mask, int lane) {
    const int g = lane >> 4;
    f32x4 sacc = {0.f, 0.f, 0.f, 0.f};
    const LAS unsigned char* kp = buf + ((kb & 1) ? A.kb1 : A.kb0) + 20480 * (kb >> 1) + 256 * (kb & 1);
#pragma unroll
    for (int s = 0; s < 10; ++s) { const bf16x8 kf = *(const LAS bf16x8*)(kp + 512 * s); sacc = __builtin_amdgcn_mfma_f32_16x16x32_bf16(kf, qf[s], sacc, 0, 0, 0); }
    if (need_mask) {
#pragma unroll
        for (int r = 0; r < 4; ++r) { const int key = 32 * (kb >> 1) + 8 * g + 4 * (kb & 1) + r; sacc[r] = key > limit ? -1e30f : sacc[r]; }
    }
    float mx = fmaxf(fmaxf(sacc[0], sacc[1]), fmaxf(sacc[2], sacc[3]));
    mx = hmax16(mx); mx = hmax32(mx);
    if (!__all(mx - st.m <= 6.0f)) {
        const float mnew = fmaxf(st.m, mx), alpha = __builtin_amdgcn_exp2f(st.m - mnew); st.m = mnew; st.l *= alpha;
#pragma unroll
        for (int cb = 0; cb < 16; ++cb) st.o[cb] = st.o[cb] * alpha;
    }
    float p[4];
#pragma unroll
    for (int r = 0; r < 4; ++r) p[r] = __builtin_amdgcn_exp2f(sacc[r] - st.m);
    st.l += (p[0] + p[1]) + (p[2] + p[3]);
    const unsigned w0 = cvt_pk_bf16(p[0], p[1]), w1 = cvt_pk_bf16(p[2], p[3]);
    const u32x4 pw = (kb & 1) ? (u32x4){0u, 0u, w0, w1} : (u32x4){w0, w1, 0u, 0u};
    const bf16x8 pf = __builtin_bit_cast(bf16x8, pw);
#pragma unroll
    for (int cb = 0; cb < 16; ++cb) {
        const LAS unsigned char* vp = buf + ((cb & 1) ? ((kb & 1) ? A.tb11 : A.tb10) : ((kb & 1) ? A.tb01 : A.tb00)) + 512 * (cb >> 1) + 256 * (kb & 1) + 20480 * (kb >> 1);
        const v4i16_t t0 = __builtin_amdgcn_ds_read_tr16_b64_v4i16((LAS v4i16_t*)vp);
        const bf16x8 vf = __builtin_shufflevector(t0, t0, 0, 1, 2, 3, 4, 5, 6, 7);
        st.o[cb] = __builtin_amdgcn_mfma_f32_16x16x32_bf16(vf, pf, st.o[cb], 0, 0, 0);
    }
}
__device__ __forceinline__ void sample_unit(Frame& F, int sb, int split) {
    unsigned char* ws = F.p->ws; OPAQUE_WS(ws); int tid = F.tid; asm volatile("" : "+v"(tid));
    const int lane = tid & 63, w = F.wave, g = lane >> 4, qi = lane & 15;
    const float* cache = F.p->in[2]; const int* pt = F.p->page_table;
    const int hg = w & 1, kb = w >> 1, head = 4 * hg + (qi >> 2), tq = qi & 3;
    bf16x8 qf[10]; load_q(qf, (const bf16_t*)(ws + WS_Q), MP + sb * DECS + tq, head, g);
    State st; state_init(st); const Addr AD = make_addr(lane);
    f32x4 pre[10];
    const int soff = stage_lds_off(tid);
    const int crow = tid >> 3, cq = tid & 7, goff = crow * MLA_ROW + 4 * cq, coff = 5120 * (crow >> 3) + 64 * (crow & 7) + 16 * ((cq >> 1) ^ ((crow >> 2) & 3)) + 8 * (cq & 1);
    const int pgv = pt[sb * NPAGES + 16 * split + (lane & 15)];
    { const float* src = cache_tile_src(cache, pgv, 0) + goff;
      cache_load10(pre, src); cache_store10(pre, F.lds + coff);
      cache_load10(pre, cache_tile_src(cache, pgv, 1) + goff); }
    __builtin_amdgcn_sched_barrier(0);
    LDS_BARRIER();
    constexpr int NT = 32;
    for (int kt = 0; kt < NT; ++kt) {
        const LAS unsigned char* buf = F.lds + (kt & 1) * TILE_BYTES; LAS unsigned char* nbuf = F.lds + ((kt + 1) & 1) * TILE_BYTES + coff;
        samp_tile(buf, AD, qf, st, kb, 63, false, lane);
        __builtin_amdgcn_sched_barrier(0);
        if (kt + 1 < NT) cache_store10(pre, nbuf);
        if (kt + 2 < NT) cache_load10(pre, cache_tile_src(cache, pgv, kt + 2) + goff);
        __builtin_amdgcn_sched_barrier(0);
        LDS_BARRIER();
    }
    if (split == 7) {
        const bf16_t* rows = (const bf16_t*)(ws + WS_ROWSB) + (size_t)(MP + sb * DECS) * MLA_ROW;
        unsigned zr = 0u; asm volatile("" : "+v"(zr));
#pragma unroll
        for (int j = 0; j < 5; ++j) { const int row = tid >> 3; u32x4 wv = {zr, zr, zr, zr}; if (row < 4) wv = *(const u32x4*)(rows + (size_t)row * MLA_ROW + ((tid & 7) + 8 * j) * 8); *(LAS u32x4*)(F.lds + soff + 1024 * j) = wv; }
        __syncthreads();
        if (kb == 0) samp_tile(F.lds, AD, qf, st, 0, tq, true, lane);
        __syncthreads();
    }
    float l = xsum32(xsum16(st.l));
    LAS float* OB = (LAS float*)F.lds; LAS float* MLB = (LAS float*)(F.lds + 131072);
#pragma unroll
    for (int cb = 0; cb < 16; ++cb) *(LAS f32x4*)(OB + (w * 16 + qi) * 256 + 16 * cb + 4 * g) = st.o[cb];
    if (g == 0) { MLB[(w * 16 + qi) * 2] = st.m; MLB[(w * 16 + qi) * 2 + 1] = l; }
    __syncthreads();
    {   const int hg2 = tid >> 8, q = (tid >> 4) & 15, c0 = (tid & 15) * 16;
        float ms[4], ls[4], mt = -1e30f;
#pragma unroll
        for (int k = 0; k < 4; ++k) { const int ww = 2 * k + hg2; ms[k] = MLB[(ww * 16 + q) * 2]; ls[k] = MLB[(ww * 16 + q) * 2 + 1]; mt = fmaxf(mt, ms[k]); }
        float L = 0.f; f32x4 acc[4];
#pragma unroll
        for (int j = 0; j < 4; ++j) acc[j] = (f32x4){0.f, 0.f, 0.f, 0.f};
#pragma unroll
        for (int k = 0; k < 4; ++k) { const int ww = 2 * k + hg2; const float wt = __builtin_amdgcn_exp2f(ms[k] - mt); L += wt * ls[k];
#pragma unroll
            for (int j = 0; j < 4; ++j) { const f32x4 v = *(const LAS f32x4*)(OB + (ww * 16 + q) * 256 + c0 + 4 * j); acc[j] = acc[j] + v * wt; } }
        const int hd = 4 * hg2 + (q >> 2), t = q & 3;
        float* po = (float*)(ws + WS_PART) + ((((size_t)sb * 8 + split) * 8 + hd) * 4 + t) * 256 + c0;
#pragma unroll
        for (int j = 0; j < 4; ++j) *(f32x4*)(po + 4 * j) = acc[j];
        if (c0 == 0) { float* ml = (float*)(ws + WS_ML) + ((((size_t)sb * 8 + split) * 8 + hd) * 4 + t) * 2; ml[0] = mt; ml[1] = L; }
    }
    __syncthreads();
}
__device__ __forceinline__ void sample_combine(Frame& F, int sb) {
    unsigned char* ws = F.p->ws; const int tid = F.tid;
    {
        const int row = tid >> 4, c0 = (tid & 15) * 16, hh = row >> 2, t = row & 3;
        float ms[8], ls[8], mt = -1e30f;
#pragma unroll
        for (int s = 0; s < 8; ++s) { const float* ml = (const float*)(ws + WS_ML) + ((((size_t)sb * 8 + s) * 8 + hh) * 4 + t) * 2;
            ms[s] = ml[0]; ls[s] = ml[1]; mt = fmaxf(mt, ms[s]); }
        float L = 0.f; f32x4 acc[4];
#pragma unroll
        for (int j = 0; j < 4; ++j) acc[j] = (f32x4){0.f, 0.f, 0.f, 0.f};
#pragma unroll
        for (int s = 0; s < 8; ++s) { const float w = __builtin_amdgcn_exp2f(ms[s] - mt); L += w * ls[s];
            const float* po = (const float*)(ws + WS_PART) + ((((size_t)sb * 8 + s) * 8 + hh) * 4 + t) * 256 + c0;
#pragma unroll
            for (int j = 0; j < 4; ++j) { const f32x4 v = *(const f32x4*)(po + 4 * j); acc[j] = acc[j] + v * w; } }
        const float inv = 1.f / L;
        bf16_t* orow = (bf16_t*)(ws + WS_OL) + (size_t)(MP + sb * DECS + t) * 2048 + hh * 256 + c0;
#pragma unroll
        for (int j = 0; j < 2; ++j) { u32x4 w; w.x = cvt_pk_bf16(acc[2 * j][0] * inv, acc[2 * j][1] * inv); w.y = cvt_pk_bf16(acc[2 * j][2] * inv, acc[2 * j][3] * inv);
            w.z = cvt_pk_bf16(acc[2 * j + 1][0] * inv, acc[2 * j + 1][1] * inv); w.w = cvt_pk_bf16(acc[2 * j + 1][2] * inv, acc[2 * j + 1][3] * inv); *(u32x4*)(orow + 8 * j) = w; }
    }
}
__device__ __forceinline__ void phase(Frame& F) {
    const int slot = (F.c >> 3) % 3; int done = 0;
    if (slot == 0) { for (int S = F.c; S < DECB * 8; S += F.G) sample_unit(F, S >> 3, S & 7); done = 1; }
    int np = 0;
    for (int L = F.c; L < 512; L += F.G) {
        const int b = L % 8, j = L / 8;
        prompt_unit(F, b, j); prompt_unit(F, b, 127 - j); ++np;
        if (!done && slot == 1 && np == 1) { for (int S = F.c; S < DECB * 8; S += F.G) sample_unit(F, S >> 3, S & 7); done = 1; }
    }
    if (!done) for (int S = F.c; S < DECB * 8; S += F.G) sample_unit(F, S >> 3, S & 7);
}
}


__device__ __forceinline__ void unpack8(const u32x4 v, float (&o)[8]) {
#pragma unroll
    for (int c = 0; c < 4; ++c) { o[2 * c] = __builtin_bit_cast(float, v[c] << 16); o[2 * c + 1] = __builtin_bit_cast(float, v[c] & 0xffff0000u); }
}
template <int R>
__device__ __forceinline__ void rowpass_rows(const Params& P, const int (&mrow)[R], bool first, bool last, const float* wa, const float* wb, int nslab, int lane) {
    unsigned char* ws = P.ws;
    float v[R][2][8], hv[R][2][8];
#pragma unroll
    for (int r = 0; r < R; ++r) { const int m = mrow[r];
        if (m < MP) { const u32x4* mr = (const u32x4*)((const bf16_t*)(ws + WS_MIX) + (size_t)m * DM) + lane; unpack8(__builtin_nontemporal_load(mr), v[r][0]); unpack8(__builtin_nontemporal_load(mr + 64), v[r][1]); }
        else {
#pragma unroll
            for (int j = 0; j < 2; ++j)
#pragma unroll
                for (int i = 0; i < 8; ++i) v[r][j][i] = 0.f;
            for (int z = 0; z < nslab; ++z) { const f32x4* mr = (const f32x4*)((const float*)(ws + WS_SLAB) + ((size_t)z * 128 + (m - MP)) * DM) + 2 * lane;
#pragma unroll
                for (int j = 0; j < 2; ++j) { const f32x4 a = mr[128 * j], b = mr[128 * j + 1]; v[r][j][0] += a.x; v[r][j][1] += a.y; v[r][j][2] += a.z; v[r][j][3] += a.w; v[r][j][4] += b.x; v[r][j][5] += b.y; v[r][j][6] += b.z; v[r][j][7] += b.w; } } }
        if (first) { const f32x4* hr = (const f32x4*)(m < MP ? P.in[0] + (size_t)m * DM : P.in[1] + (size_t)(m - MP) * DM) + 2 * lane;
#pragma unroll
            for (int j = 0; j < 2; ++j) { const f32x4 a = __builtin_nontemporal_load(hr + 128 * j), b = __builtin_nontemporal_load(hr + 128 * j + 1); hv[r][j][0] = a.x; hv[r][j][1] = a.y; hv[r][j][2] = a.z; hv[r][j][3] = a.w; hv[r][j][4] = b.x; hv[r][j][5] = b.y; hv[r][j][6] = b.z; hv[r][j][7] = b.w; }
        } else { const u32x4* hr = (const u32x4*)((const bf16_t*)(ws + WS_HB) + (size_t)m * DM) + lane; unpack8(__builtin_nontemporal_load(hr), hv[r][0]); unpack8(__builtin_nontemporal_load(hr + 64), hv[r][1]); } }
    float s[R];
#pragma unroll
    for (int r = 0; r < R; ++r) { s[r] = 0.f;
#pragma unroll
        for (int j = 0; j < 2; ++j)
#pragma unroll
            for (int i = 0; i < 8; ++i) s[r] += v[r][j][i] * v[r][j][i]; }
#pragma unroll
    for (int r = 0; r < R; ++r) s[r] = xsum32(xsum16(row_sum16(s[r])));
    float s2[R];
#pragma unroll
    for (int r = 0; r < R; ++r) { const float rs = rsqrtf(s[r] * (1.f / DM) + RMS_EPS); s2[r] = 0.f;
#pragma unroll
        for (int j = 0; j < 2; ++j) { const f32x4 g0 = ((const f32x4*)wa)[2 * lane + 128 * j], g1 = ((const f32x4*)wa)[2 * lane + 128 * j + 1];
            const float g[8] = {g0.x, g0.y, g0.z, g0.w, g1.x, g1.y, g1.z, g1.w};
#pragma unroll
            for (int i = 0; i < 8; ++i) { v[r][j][i] = hv[r][j][i] + v[r][j][i] * rs * g[i]; s2[r] += v[r][j][i] * v[r][j][i]; } }
        const int m = mrow[r];
        if (last) { f32x4* yr = (f32x4*)(P.out + O_Y + (size_t)m * DM) + 2 * lane;
#pragma unroll
            for (int j = 0; j < 2; ++j) { __builtin_nontemporal_store((f32x4){v[r][j][0], v[r][j][1], v[r][j][2], v[r][j][3]}, yr + 128 * j); __builtin_nontemporal_store((f32x4){v[r][j][4], v[r][j][5], v[r][j][6], v[r][j][7]}, yr + 128 * j + 1); }
        } else { u32x4* hb = (u32x4*)((bf16_t*)(ws + WS_HB) + (size_t)m * DM) + lane;
#pragma unroll
            for (int j = 0; j < 2; ++j) hb[64 * j] = (u32x4){cvt_pk_bf16(v[r][j][0], v[r][j][1]), cvt_pk_bf16(v[r][j][2], v[r][j][3]), cvt_pk_bf16(v[r][j][4], v[r][j][5]), cvt_pk_bf16(v[r][j][6], v[r][j][7])}; } }
    if (wb) {
#pragma unroll
        for (int r = 0; r < R; ++r) s2[r] = xsum32(xsum16(row_sum16(s2[r])));
#pragma unroll
        for (int r = 0; r < R; ++r) { const float r2 = rsqrtf(s2[r] * (1.f / DM) + RMS_EPS);
            u32x4* ur = (u32x4*)((bf16_t*)(ws + WS_U) + (size_t)mrow[r] * DM) + lane;
#pragma unroll
            for (int j = 0; j < 2; ++j) { const f32x4 g0 = ((const f32x4*)wb)[2 * lane + 128 * j], g1 = ((const f32x4*)wb)[2 * lane + 128 * j + 1];
                ur[64 * j] = (u32x4){cvt_pk_bf16(v[r][j][0] * r2 * g0.x, v[r][j][1] * r2 * g0.y), cvt_pk_bf16(v[r][j][2] * r2 * g0.z, v[r][j][3] * r2 * g0.w), cvt_pk_bf16(v[r][j][4] * r2 * g1.x, v[r][j][5] * r2 * g1.y), cvt_pk_bf16(v[r][j][6] * r2 * g1.z, v[r][j][7] * r2 * g1.w)}; } } }
}
__device__ __forceinline__ void rowpass(Frame& F, bool first, bool last, const float* wa, const float* wb, int nslab) {
    const Params& P = *F.p; int lane = F.lane; asm volatile("" : "+v"(lane));
    const int gw = F.c * NWAVES + F.wave, NGW = F.G * NWAVES;
    for (int p = gw; p < MP / 4; p += NGW) { const int mr[4] = {4 * p, 4 * p + 1, 4 * p + 2, 4 * p + 3}; rowpass_rows<4>(P, mr, first, last, wa, wb, nslab, lane); }
    for (int m = MP + gw; m < MV; m += NGW) { const int mr[1] = {m}; rowpass_rows<1>(P, mr, first, last, wa, wb, nslab, lane); }
}


namespace dn {
constexpr int SP = 132;
constexpr int L_S = 0;
constexpr int L_KB = 3 * 64 * SP * 4;
constexpr int L_QB = L_KB + 64 * 272;
constexpr int L_G = L_QB + 64 * 272;
constexpr int LP = 68;
constexpr int L_LB = L_G + 512;
constexpr int L_ST = L_KB;
static_assert(L_LB + 32 * 80 <= 131072 + 8192 && 256 * 80 <= 2 * 64 * 272, "dn LDS map");
__device__ __forceinline__ float silu(float x) { return x * __builtin_amdgcn_rcpf(1.f + __expf(-x)); }
__device__ __forceinline__ void gated_norm_row(unsigned char* ws, const float* gout, size_t row, int h, int lane) {
    const unsigned ov = *(const unsigned*)((const bf16_t*)(ws + WS_DO) + row * 1024 + h * 128 + 2 * lane);
    const unsigned zv = *(const unsigned*)((const bf16_t*)(ws + WS_PROJ) + row * DN_NP + 3072 + h * 128 + 2 * lane);
    const float o0 = __builtin_bit_cast(float, ov << 16), o1 = __builtin_bit_cast(float, ov & 0xffff0000u);
    const float z0 = __builtin_bit_cast(float, zv << 16), z1 = __builtin_bit_cast(float, zv & 0xffff0000u);
    const float rs = rsqrtf(wave_sum(o0 * o0 + o1 * o1) * (1.f / 128.f) + RMS_EPS);
    const f32x2 g = *(const f32x2*)(gout + 2 * lane);
    *(unsigned*)((bf16_t*)(ws + WS_DOG) + row * 1024 + h * 128 + 2 * lane) = cvt_pk_bf16(o0 * rs * g.x * silu(z0), o1 * rs * g.y * silu(z1));
}

struct ConvPre { u32x4 x[11]; bf16_t gb, ga; };
template <int I0, int I1, bool GATES>
__device__ __forceinline__ void conv_load_part(ConvPre& R, const bf16_t* proj, int b, int n, int tid, int h) {
    const int cgp = tid % 48, tg = tid / 48, part = cgp >> 4, d0 = (cgp & 15) * 8, col = part * 1024 + h * 128 + d0;
#pragma unroll
    for (int i = I0; i < I1; ++i) { int tok = n * CHUNK + 8 * tg - 3 + i; u32x4 v = {0u, 0u, 0u, 0u};
        int cl = col; if (tid >= 384) { tok = n * CHUNK; cl = h * 128; }
        if (tok >= 0) v = __builtin_nontemporal_load((const u32x4*)(proj + ((size_t)b * SEQ + tok) * DN_NP + cl));
        R.x[i] = v; }
    if (GATES) { const bf16_t* pr = proj + ((size_t)b * SEQ + n * CHUNK + (tid & 63)) * DN_NP + 4096 + h; R.gb = pr[0]; R.ga = pr[8]; }
}
__device__ __forceinline__ void conv_load(ConvPre& R, const bf16_t* proj, int b, int n, int tid, int h) { conv_load_part<0, 11, true>(R, proj, b, n, tid, h); }
__device__ __forceinline__ void chunk_phase(Frame& F) {
    const Params& P = *F.p; unsigned char* ws = P.ws; OPAQUE_WS(ws); int tid = F.tid; asm volatile("" : "+v"(tid));
    const int lane = tid & 63, wave = __builtin_amdgcn_readfirstlane(tid >> 6);
    LAS float* S = (LAS float*)(F.lds + L_S); LAS float* GB = (LAS float*)(F.lds + L_G);
    const bf16_t* proj = (const bf16_t*)(ws + WS_PROJ);
    const int h = F.c & 7; const int nun = (256 - (F.c >> 3) + (F.G >> 3) - 1) / (F.G >> 3);
    if ((F.G & 7) != 0 || nun <= 0) return;
    constexpr int L_CW = 131072 + 8192 + 256;
    LAS float* CW = (LAS float*)(F.lds + L_CW);
    for (int i = tid; i < 4 * 384; i += NTHREADS) { const int j = i / 384, cc = i % 384; CW[i] = P.in[15][j * DN_QKV + (cc >> 7) * 1024 + h * 128 + (cc & 127)]; }
    __syncthreads();
    ConvPre pre;
    { const int idx = F.c >> 3; conv_load(pre, proj, idx >> 5, idx & 31, tid, h); }
    const int tid0 = tid;
    for (int k = 0; k < nun; ++k) {
        int tid = tid0; asm volatile("" : "+v"(tid));
        const int lane = tid & 63;
        const int cgp = tid % 48, tg = tid / 48, part = cgp >> 4, d0c = (cgp & 15) * 8, col = part * 1024 + h * 128 + d0c;
        const int idx = (F.c >> 3) + k * (F.G >> 3), b = idx >> 5, n = idx & 31;
        const int t0 = n * CHUNK; const size_t row0 = (size_t)b * SEQ + t0; const int unit = (b * 8 + h) * 32 + n;
        if (tid < 384) {
#pragma unroll
            for (int c2 = 0; c2 < 4; ++c2) {
                float x0[11], x1[11], w0[4], w1[4];
#pragma unroll
                for (int i = 0; i < 11; ++i) { x0[i] = __builtin_bit_cast(float, pre.x[i][c2] << 16); x1[i] = __builtin_bit_cast(float, pre.x[i][c2] & 0xffff0000u); }
#pragma unroll
                for (int j = 0; j < 4; ++j) { const f32x2 wv = *(const LAS f32x2*)(CW + j * 384 + part * 128 + d0c + 2 * c2); w0[j] = wv.x; w1[j] = wv.y; }
#pragma unroll
                for (int tt = 0; tt < 8; ++tt) { float a0 = 0.f, a1 = 0.f;
#pragma unroll
                    for (int j = 0; j < 4; ++j) { a0 += w0[j] * x0[tt + j]; a1 += w1[j] * x1[tt + j]; }
                    *(LAS f32x2*)(S + (part * 64 + 8 * tg + tt) * SP + d0c + 2 * c2) = (f32x2){silu(a0), silu(a1)}; }
                if (n == 31 && tg == 7) {
#pragma unroll
                    for (int r = 0; r < 3; ++r) *(f32x2*)(P.out + O_CP + ((size_t)b * 3 + r) * DN_QKV + col + 2 * c2) = (f32x2){x0[8 + r], x1[8 + r]}; }
            }
        }
        if (wave == 7) {
            const float braw = bf2f(pre.gb), araw = bf2f(pre.ga);
            const float beta = 1.f / (1.f + __expf(-braw));
            const float xs = araw + P.in[17][h]; const float sp = xs > 20.f ? xs : log1pf(__expf(xs));
            float g = -__expf(P.in[16][h]) * sp;
#pragma unroll
            for (int o = 1; o < 64; o <<= 1) { const float t = __shfl_up(g, o); if (lane >= o) g += t; }
            GB[lane] = beta; GB[64 + lane] = g;
        }
        LDS_BARRIER();
        const int nidx = k + 1 < nun ? idx + (F.G >> 3) : idx;
        conv_load_part<0, 4, false>(pre, proj, nidx >> 5, nidx & 31, tid, h);
        {   const int r = tid >> 2, qd = tid & 3; LAS float* rp = S + r * SP + 4 * qd;
            f32x4 a[8]; float ss = 0.f;
#pragma unroll
            for (int j = 0; j < 8; ++j) { a[j] = *(const LAS f32x4*)(rp + 16 * j); ss += (a[j].x * a[j].x + a[j].y * a[j].y) + (a[j].z * a[j].z + a[j].w * a[j].w); }
            ss = quad_sum(ss);
            float sc = rsqrtf(ss + L2_EPS); if (r < 64) sc *= 0.08838834764831845f;
#pragma unroll
            for (int j = 0; j < 8; ++j) *(LAS f32x4*)(rp + 16 * j) = a[j] * sc;
        }
        LDS_BARRIER();
        conv_load_part<4, 8, false>(pre, proj, nidx >> 5, nidx & 31, tid, h);
        const float gl = GB[64 + 63];
        {   const int t = tid >> 3, d0 = (tid & 7) * 16; const float eg = __expf(GB[64 + t]);
            const LAS float* qp = S + t * SP + d0; const LAS float* kp = S + (64 + t) * SP + d0;
            float q[16], kk[16];
#pragma unroll
            for (int j = 0; j < 4; ++j) { const f32x4 a = *(const LAS f32x4*)(qp + 4 * j), c = *(const LAS f32x4*)(kp + 4 * j); q[4 * j] = a.x; q[4 * j + 1] = a.y; q[4 * j + 2] = a.z; q[4 * j + 3] = a.w; kk[4 * j] = c.x; kk[4 * j + 1] = c.y; kk[4 * j + 2] = c.z; kk[4 * j + 3] = c.w; }
            u32x4 w0, w1;
            w0 = (u32x4){cvt_pk_bf16(q[0], q[1]), cvt_pk_bf16(q[2], q[3]), cvt_pk_bf16(q[4], q[5]), cvt_pk_bf16(q[6], q[7])}; w1 = (u32x4){cvt_pk_bf16(q[8], q[9]), cvt_pk_bf16(q[10], q[11]), cvt_pk_bf16(q[12], q[13]), cvt_pk_bf16(q[14], q[15])};
            *(LAS u32x4*)(F.lds + L_QB + t * 272 + d0 * 2) = w0; *(LAS u32x4*)(F.lds + L_QB + t * 272 + d0 * 2 + 16) = w1;
            w0 = (u32x4){cvt_pk_bf16(kk[0], kk[1]), cvt_pk_bf16(kk[2], kk[3]), cvt_pk_bf16(kk[4], kk[5]), cvt_pk_bf16(kk[6], kk[7])}; w1 = (u32x4){cvt_pk_bf16(kk[8], kk[9]), cvt_pk_bf16(kk[10], kk[11]), cvt_pk_bf16(kk[12], kk[13]), cvt_pk_bf16(kk[14], kk[15])};
            *(LAS u32x4*)(F.lds + L_KB + t * 272 + d0 * 2) = w0; *(LAS u32x4*)(F.lds + L_KB + t * 272 + d0 * 2 + 16) = w1;
            w0 = (u32x4){cvt_pk_bf16(q[0] * eg, q[1] * eg), cvt_pk_bf16(q[2] * eg, q[3] * eg), cvt_pk_bf16(q[4] * eg, q[5] * eg), cvt_pk_bf16(q[6] * eg, q[7] * eg)};
            w1 = (u32x4){cvt_pk_bf16(q[8] * eg, q[9] * eg), cvt_pk_bf16(q[10] * eg, q[11] * eg), cvt_pk_bf16(q[12] * eg, q[13] * eg), cvt_pk_bf16(q[14] * eg, q[15] * eg)};
            bf16_t* qd = (bf16_t*)(ws + WS_QD) + (row0 + t) * 1024 + h * 128 + d0; *(u32x4*)qd = w0; *(u32x4*)(qd + 8) = w1;
        }
        {   const int d = tid >> 2, tq = (tid & 3) * 16; float kd[16];
#pragma unroll
            for (int j = 0; j < 16; ++j) kd[j] = S[(64 + tq + j) * SP + d] * __expf(gl - GB[64 + tq + j]);
            bf16_t* o = (bf16_t*)(ws + WS_KDT) + ((size_t)unit * 128 + d) * 64 + tq;
            *(u32x4*)o = (u32x4){cvt_pk_bf16(kd[0], kd[1]), cvt_pk_bf16(kd[2], kd[3]), cvt_pk_bf16(kd[4], kd[5]), cvt_pk_bf16(kd[6], kd[7])};
            *(u32x4*)(o + 8) = (u32x4){cvt_pk_bf16(kd[8], kd[9]), cvt_pk_bf16(kd[10], kd[11]), cvt_pk_bf16(kd[12], kd[13]), cvt_pk_bf16(kd[14], kd[15])};
        }
        if (tid == 0) ((float*)(ws + WS_GL))[unit] = __expf(gl);
        LDS_BARRIER();
        conv_load_part<8, 11, true>(pre, proj, nidx >> 5, nidx & 31, tid, h);
        {   const int mat = wave >> 2, bi = wave & 3, g = lane >> 4, jl = lane & 15;
            LAS float* Lt = S;
            const LAS unsigned char* ab = F.lds + (mat ? L_QB : L_KB) + (16 * bi + jl) * 272 + 16 * g;
            bf16x8 af[4];
#pragma unroll
            for (int ks = 0; ks < 4; ++ks) af[ks] = *(const LAS bf16x8*)(ab + 64 * ks);
            float gi[4], bt[4];
#pragma unroll
            for (int r = 0; r < 4; ++r) { gi[r] = GB[64 + 16 * bi + 4 * g + r]; bt[r] = GB[16 * bi + 4 * g + r]; }
            for (int bj = 0; bj < 4; ++bj) {
                f32x4 acc = {0.f, 0.f, 0.f, 0.f};
                if (bj <= bi) {
                    const LAS unsigned char* bb = F.lds + L_KB + (16 * bj + jl) * 272 + 16 * g;
#pragma unroll
                    for (int ks = 0; ks < 4; ++ks) { const bf16x8 bf = *(const LAS bf16x8*)(bb + 64 * ks); acc = __builtin_amdgcn_mfma_f32_16x16x32_bf16(af[ks], bf, acc, 0, 0, 0); }
                }
                const int j = 16 * bj + jl; const float gj = GB[64 + j];
                if (mat == 0) { if (bj <= bi) { f32x4 lv;
#pragma unroll
                        for (int r = 0; r < 4; ++r) { const int i = 16 * bi + 4 * g + r; lv[r] = (i > j) ? bt[r] * acc[r] * __expf(gi[r] - gj) : 0.f; }
                        *(LAS f32x4*)(Lt + j * LP + 16 * bi + 4 * g) = lv;
                        if (bi >= 2 && bj < 2) {
#pragma unroll
                            for (int r = 0; r < 4; ++r) *(LAS bf16_t*)(F.lds + L_LB + (16 * (bi - 2) + 4 * g + r) * 80 + j * 2) = (bf16_t)f2bf(-lv[r]); } } }
                else {
#pragma unroll
                    for (int r = 0; r < 4; ++r) { const int i = 16 * bi + 4 * g + r; const float v = (i >= j) ? acc[r] * __expf(gi[r] - gj) : 0.f; ((bf16_t*)(ws + WS_QKM))[((size_t)unit * 64 + i) * 64 + j] = (bf16_t)f2bf(v); } }
            }
        }
        {   const int t = tid >> 3, d0 = (tid & 7) * 16; const float beta = GB[t], be = beta * __expf(GB[64 + t]);
            LAS float* kp = S + (64 + t) * SP + d0; LAS float* vp = S + (128 + t) * SP + d0;
#pragma unroll
            for (int j = 0; j < 4; ++j) { f32x4 a = *(LAS f32x4*)(kp + 4 * j); a = a * be; *(LAS f32x4*)(kp + 4 * j) = a; f32x4 c = *(LAS f32x4*)(vp + 4 * j); c = c * beta; *(LAS f32x4*)(vp + 4 * j) = c; }
        }
        LDS_BARRIER();
        const LAS float* Lt = S;
        if (wave == 0) {
            const int bi = lane >> 4, cc = lane & 15; float x[16];
#pragma unroll
            for (int i = 0; i < 16; ++i) x[i] = (i == cc) ? 1.f : 0.f;
#pragma unroll
            for (int j = 0; j < 15; ++j) { const float sj = x[j];
#pragma unroll
                for (int q4 = (j + 1) / 4; q4 < 4; ++q4) { const f32x4 l4 = *(const LAS f32x4*)(Lt + (16 * bi + j) * LP + 16 * bi + 4 * q4);
#pragma unroll
                    for (int jj = 0; jj < 4; ++jj) x[4 * q4 + jj] -= l4[jj] * sj; } }
#pragma unroll
            for (int i = 0; i < 16; ++i) *(LAS bf16_t*)(F.lds + L_ST + (16 * bi + i) * 32 + cc * 2) = (bf16_t)f2bf(x[i]);
        }
        LDS_BARRIER();
        {   const int g = lane >> 4, jl = lane & 15;
            bf16x8 At[4], Al[6];
#pragma unroll
            for (int bi = 0; bi < 4; ++bi) { const u32x2 t = *(const LAS u32x2*)(F.lds + L_ST + (16 * bi + jl) * 32 + 8 * g); At[bi] = __builtin_bit_cast(bf16x8, (u32x4){t.x, t.y, 0u, 0u}); }
#pragma unroll
            for (int bi = 1; bi < 4; ++bi)
#pragma unroll
                for (int bj = 0; bj < bi; ++bj) { const LAS float* lp = Lt + (16 * bj + 4 * g) * LP + 16 * bi + jl;
                    Al[bi * (bi - 1) / 2 + bj] = __builtin_bit_cast(bf16x8, (u32x4){cvt_pk_bf16(-lp[0], -lp[LP]), cvt_pk_bf16(-lp[2 * LP], -lp[3 * LP]), 0u, 0u}); }
#pragma unroll
            for (int q = 0; q < 2; ++q) { const int cc = 16 * (2 * wave + q) + jl;
                const LAS float* rp = S + (cc < 128 ? 128 * SP + cc : 64 * SP + (cc - 128)) + (4 * g) * SP;
                bf16_t* og = (bf16_t*)(ws + (cc < 128 ? WS_UU : WS_WW)) + (row0 + 4 * g) * 1024 + h * 128 + (cc & 127);
                f32x4 y[4]; bf16x8 sb[4];
#pragma unroll
                for (int bi = 0; bi < 4; ++bi) y[bi] = (f32x4){rp[(16 * bi) * SP], rp[(16 * bi + 1) * SP], rp[(16 * bi + 2) * SP], rp[(16 * bi + 3) * SP]};
#pragma unroll
                for (int bi = 0; bi < 4; ++bi) {
#pragma unroll
                    for (int bj = 0; bj < bi; ++bj) y[bi] = __builtin_amdgcn_mfma_f32_16x16x32_bf16(Al[bi * (bi - 1) / 2 + bj], sb[bj], y[bi], 0, 0, 0);
                    const bf16x8 yb = __builtin_bit_cast(bf16x8, (u32x4){cvt_pk_bf16(y[bi][0], y[bi][1]), cvt_pk_bf16(y[bi][2], y[bi][3]), 0u, 0u});
                    const f32x4 sv = __builtin_amdgcn_mfma_f32_16x16x32_bf16(At[bi], yb, (f32x4){0.f, 0.f, 0.f, 0.f}, 0, 0, 0);
                    const unsigned p0 = cvt_pk_bf16(sv[0], sv[1]), p1 = cvt_pk_bf16(sv[2], sv[3]);
                    sb[bi] = __builtin_bit_cast(bf16x8, (u32x4){p0, p1, 0u, 0u});
                    og[(size_t)(16 * bi) * 1024] = (bf16_t)p0; og[(size_t)(16 * bi + 1) * 1024] = (bf16_t)(p0 >> 16); og[(size_t)(16 * bi + 2) * 1024] = (bf16_t)p1; og[(size_t)(16 * bi + 3) * 1024] = (bf16_t)(p1 >> 16);
                }
            }
        }
        LDS_BARRIER();
    }
}
__device__ __forceinline__ void sample_item(Frame& F, int sb, int h) {
    const Params& P = *F.p; unsigned char* ws = P.ws; OPAQUE_WS(ws); int tid = F.tid; asm volatile("" : "+v"(tid));
    const int lane = tid & 63, wave = __builtin_amdgcn_readfirstlane(tid >> 6);
    LAS float* SQ = (LAS float*)F.lds;
    LAS float* GT = SQ + 3 * 4 * 128;
    LAS float* RED = GT + 16;
    const bf16_t* proj = (const bf16_t*)(ws + WS_PROJ) + (size_t)(MP + sb * DECS) * DN_NP;
    const int dg = tid >> 7, e = tid & 127;
    float St[32];
    const float* s0 = P.in[3] + (((size_t)sb * 8 + h) * 128 + 32 * dg) * 128 + e;
#pragma unroll
    for (int i = 0; i < 32; ++i) St[i] = __builtin_nontemporal_load(s0 + (size_t)i * 128);
    if (tid < 384) {
        const int part = tid >> 7, d = tid & 127, col = part * 1024 + h * 128 + d;
        float xs[7];
#pragma unroll
        for (int j = 0; j < 3; ++j) xs[j] = P.in[4][((size_t)sb * 3 + j) * DN_QKV + col];
#pragma unroll
        for (int t = 0; t < 4; ++t) xs[3 + t] = bf2f(proj[(size_t)t * DN_NP + col]);
        float cw[4];
#pragma unroll
        for (int j = 0; j < 4; ++j) cw[j] = P.in[15][j * DN_QKV + col];
#pragma unroll
        for (int t = 0; t < 4; ++t) { float a = 0.f;
#pragma unroll
            for (int j = 0; j < 4; ++j) a += cw[j] * xs[t + j];
            SQ[(part * 4 + t) * 128 + d] = silu(a); }
#pragma unroll
        for (int j = 0; j < 3; ++j) P.out[O_CS + ((size_t)sb * 3 + j) * DN_QKV + col] = xs[4 + j];
    }
    if (tid >= 384 && tid < 388) { const int t = tid - 384; const float braw = bf2f(proj[(size_t)t * DN_NP + 4096 + h]), araw = bf2f(proj[(size_t)t * DN_NP + 4104 + h]);
        const float xs = araw + P.in[17][h]; const float sp = xs > 20.f ? xs : log1pf(__expf(xs));
        GT[t] = -__expf(P.in[16][h]) * sp; GT[4 + t] = 1.f / (1.f + __expf(-braw)); }
    LDS_BARRIER();
    { LAS float* rp = SQ + wave * 128; const float a = rp[lane], c = rp[lane + 64];
      float sc = rsqrtf(wave_sum(a * a + c * c) + L2_EPS); if (wave < 4) sc *= 0.08838834764831845f;
      rp[lane] = a * sc; rp[lane + 64] = c * sc; }
    LDS_BARRIER();
    for (int t = 0; t < 4; ++t) {
        const float dec = __expf(GT[t]), beta = GT[4 + t];
        const LAS float* qp = SQ + t * 128 + 32 * dg; const LAS float* kp = SQ + (4 + t) * 128 + 32 * dg;
        float kv = 0.f;
#pragma unroll
        for (int i = 0; i < 32; ++i) { St[i] *= dec; kv += kp[i] * St[i]; }
        RED[dg * 128 + e] = kv;
        LDS_BARRIER();
        const float kvt = (RED[e] + RED[128 + e]) + (RED[256 + e] + RED[384 + e]);
        const float delta = (SQ[(8 + t) * 128 + e] - kvt) * beta;
        float ov = 0.f;
#pragma unroll
        for (int i = 0; i < 32; ++i) { St[i] += kp[i] * delta; ov += qp[i] * St[i]; }
        LDS_BARRIER();
        RED[dg * 128 + e] = ov;
        LDS_BARRIER();
        if (dg == 0) { const float o = (RED[e] + RED[128 + e]) + (RED[256 + e] + RED[384 + e]); ((bf16_t*)(ws + WS_DO))[(size_t)(MP + sb * DECS + t) * 1024 + h * 128 + e] = (bf16_t)f2bf(o); }
        LDS_BARRIER();
    }
    float* so = P.out + O_SS + (((size_t)sb * 8 + h) * 128 + 32 * dg) * 128 + e;
#pragma unroll
    for (int i = 0; i < 32; ++i) __builtin_nontemporal_store(St[i], so + (size_t)i * 128);
    asm volatile("s_waitcnt vmcnt(0)" ::: "memory"); __syncthreads();
    if (wave < 4) gated_norm_row(ws, P.in[18], (size_t)(MP + sb * DECS + wave), h, lane);
}

struct StepRegs { bf16x8 a1[4]; bf16x8 a3[2]; bf16x8 a4[2]; };
__device__ __forceinline__ void scan_load(StepRegs& R, const unsigned char* ws, int b, int h, int sl, int n, int w, int g, int jl) {
    const int unit = (b * 8 + h) * 32 + n; const size_t row0 = (size_t)b * SEQ + 64 * n; const int tb = w & 3;
    const bf16_t* A1 = (const bf16_t*)(ws + (w < 4 ? WS_WW : WS_QD)) + (row0 + 16 * tb + jl) * 1024 + h * 128 + 8 * g;
#pragma unroll
    for (int ks = 0; ks < 4; ++ks) R.a1[ks] = *(const bf16x8*)(A1 + 32 * ks);
    const bf16_t* A4 = (const bf16_t*)(ws + WS_KDT) + ((size_t)unit * 128 + 16 * w + jl) * 64 + 8 * g;
#pragma unroll
    for (int ks = 0; ks < 2; ++ks) R.a4[ks] = *(const bf16x8*)(A4 + 32 * ks);
    const bf16_t* X = w >= 4 ? (const bf16_t*)(ws + WS_QKM) + ((size_t)unit * 64 + 16 * tb + jl) * 64 + 8 * g
                             : (const bf16_t*)(ws + WS_UU) + (row0 + 16 * tb + jl) * 1024 + h * 128 + 32 * sl + 8 * g;
    R.a3[0] = *(const bf16x8*)X; R.a3[1] = *(const bf16x8*)(X + (w >= 4 ? 32 : 0));
}
__device__ __forceinline__ void scan_step(unsigned char* ws, LAS unsigned char* ST, LAS unsigned char* VT, const StepRegs& cur, f32x4 (&sacc)[2], int b, int h, int sl, int n, int w, int g, int jl) {
    const int tb = w & 3; const size_t row0 = (size_t)b * SEQ + 64 * n;
    f32x4 tacc[2] = {{0.f, 0.f, 0.f, 0.f}, {0.f, 0.f, 0.f, 0.f}};
#pragma unroll
    for (int cb = 0; cb < 2; ++cb)
#pragma unroll
        for (int ks = 0; ks < 4; ++ks) { const bf16x8 bf = *(const LAS bf16x8*)(ST + (16 * cb + jl) * 272 + (32 * ks + 8 * g) * 2); tacc[cb] = __builtin_amdgcn_mfma_f32_16x16x32_bf16(bf, cur.a1[ks], tacc[cb], 0, 0, 0); }
    if (w < 4) {
        float uf[8]; unpack8(__builtin_bit_cast(u32x4, cur.a3[0]), uf);
#pragma unroll
        for (int cb = 0; cb < 2; ++cb) {
            const unsigned p0 = cvt_pk_bf16(uf[4 * cb + 0] - tacc[cb][0], uf[4 * cb + 1] - tacc[cb][1]), p1 = cvt_pk_bf16(uf[4 * cb + 2] - tacc[cb][2], uf[4 * cb + 3] - tacc[cb][3]);
            LAS unsigned short* vp = (LAS unsigned short*)(VT + (16 * cb + 4 * g) * 144 + (16 * tb + jl) * 2);
            vp[0] = (unsigned short)p0; vp[72] = (unsigned short)(p0 >> 16); vp[144] = (unsigned short)p1; vp[216] = (unsigned short)(p1 >> 16); }
    }
    LDS_BARRIER();
    if (w >= 4) {
#pragma unroll
        for (int cb = 0; cb < 2; ++cb)
#pragma unroll
            for (int ks = 0; ks < 2; ++ks) { const bf16x8 bf = *(const LAS bf16x8*)(VT + (16 * cb + jl) * 144 + (32 * ks + 8 * g) * 2); tacc[cb] = __builtin_amdgcn_mfma_f32_16x16x32_bf16(bf, cur.a3[ks], tacc[cb], 0, 0, 0); }
        *(u32x4*)((bf16_t*)(ws + WS_DO) + (row0 + 16 * tb + jl) * 1024 + h * 128 + 32 * sl + 8 * g) =
            (u32x4){cvt_pk_bf16(tacc[0][0], tacc[0][1]), cvt_pk_bf16(tacc[0][2], tacc[0][3]), cvt_pk_bf16(tacc[1][0], tacc[1][1]), cvt_pk_bf16(tacc[1][2], tacc[1][3])};
    }
    const float gl = ((const LAS float*)(VT + 32 * 144))[n];
#pragma unroll
    for (int cb = 0; cb < 2; ++cb) { sacc[cb] = sacc[cb] * gl;
#pragma unroll
        for (int ks = 0; ks < 2; ++ks) { const bf16x8 bf = *(const LAS bf16x8*)(VT + (16 * cb + jl) * 144 + (32 * ks + 8 * g) * 2); sacc[cb] = __builtin_amdgcn_mfma_f32_16x16x32_bf16(cur.a4[ks], bf, sacc[cb], 0, 0, 0); }
        *(LAS u32x2*)(ST + (16 * cb + jl) * 272 + (16 * w + 4 * g) * 2) = (u32x2){cvt_pk_bf16(sacc[cb][0], sacc[cb][1]), cvt_pk_bf16(sacc[cb][2], sacc[cb][3])}; }
    LDS_BARRIER();
}
__device__ __forceinline__ void scan_item(Frame& F, int b, int h, int sl) {
    const Params& P = *F.p; unsigned char* ws = P.ws; OPAQUE_WS(ws); int tid = F.tid; asm volatile("" : "+v"(tid));
    const int lane = tid & 63, w = __builtin_amdgcn_readfirstlane(tid >> 6), g = lane >> 4, jl = lane & 15;
    LAS unsigned char* ST = F.lds;
    LAS unsigned char* VT = F.lds + 32 * 272;
    for (int i = tid; i < 32 * 272 / 4; i += NTHREADS) ((LAS unsigned*)ST)[i] = 0u;
    if (tid < 32) ((LAS float*)(VT + 32 * 144))[tid] = ((const float*)(ws + WS_GL))[(b * 8 + h) * 32 + tid];
    f32x4 sacc[2] = {{0.f, 0.f, 0.f, 0.f}, {0.f, 0.f, 0.f, 0.f}};
    StepRegs A, B, C;
    scan_load(A, ws, b, h, sl, 0, w, g, jl); scan_load(B, ws, b, h, sl, 1, w, g, jl);
    __syncthreads();
    for (int n = 0; n < 30; n += 3) {
        scan_load(C, ws, b, h, sl, n + 2, w, g, jl); __builtin_amdgcn_sched_barrier(0); scan_step(ws, ST, VT, A, sacc, b, h, sl, n, w, g, jl);
        scan_load(A, ws, b, h, sl, n + 3, w, g, jl); __builtin_amdgcn_sched_barrier(0); scan_step(ws, ST, VT, B, sacc, b, h, sl, n + 1, w, g, jl);
        scan_load(B, ws, b, h, sl, n + 4, w, g, jl); __builtin_amdgcn_sched_barrier(0); scan_step(ws, ST, VT, C, sacc, b, h, sl, n + 2, w, g, jl);
    }
    scan_step(ws, ST, VT, A, sacc, b, h, sl, 30, w, g, jl);
    scan_step(ws, ST, VT, B, sacc, b, h, sl, 31, w, g, jl);
    float* so = P.out + O_SP + (((size_t)b * 8 + h) * 128 + 16 * w + 4 * g) * 128 + 32 * sl + 8 * (jl >> 2) + (jl & 3);
#pragma unroll
    for (int cb = 0; cb < 2; ++cb)
#pragma unroll
        for (int r = 0; r < 4; ++r) __builtin_nontemporal_store(sacc[cb][r], so + (size_t)r * 128 + 4 * cb);
}
template <int NB>
__device__ __forceinline__ void gn_load_z(u32x4 (&zv)[NB], unsigned char* ws, size_t row0, int h, int lane) {
    const size_t rowb = row0 + (lane >> 4); const int c0 = (lane & 15) * 8;
#pragma unroll
    for (int i = 0; i < NB; ++i) zv[i] = __builtin_nontemporal_load((const u32x4*)((const bf16_t*)(ws + WS_PROJ) + (rowb + 32 * i) * DN_NP + 3072 + h * 128 + c0));
}
template <int NB>
__device__ __forceinline__ void gated_norm_batch(unsigned char* ws, const float* gout, size_t row0, int h, int lane, const u32x4 (&zv)[NB]) {
    const size_t rowb = row0 + (lane >> 4); const int c0 = (lane & 15) * 8;
    u32x4 ov[NB];
#pragma unroll
    for (int i = 0; i < NB; ++i) ov[i] = *(const u32x4*)((const bf16_t*)(ws + WS_DO) + (rowb + 32 * i) * 1024 + h * 128 + c0);
    const f32x4 g0 = *(const f32x4*)(gout + c0), g1 = *(const f32x4*)(gout + c0 + 4);
    const float g[8] = {g0.x, g0.y, g0.z, g0.w, g1.x, g1.y, g1.z, g1.w};
    __builtin_amdgcn_sched_barrier(0);
#pragma unroll
    for (int i = 0; i < NB; ++i) {
        float o[8], z[8]; unpack8(ov[i], o); unpack8(zv[i], z);
        float ss = 0.f;
#pragma unroll
        for (int k = 0; k < 8; ++k) ss += o[k] * o[k];
        ss = row_sum16(ss);
        const float rs = rsqrtf(ss * (1.f / 128.f) + RMS_EPS);
        float y[8];
#pragma unroll
        for (int k = 0; k < 8; ++k) y[k] = o[k] * rs * g[k] * silu(z[k]);
        *(u32x4*)((bf16_t*)(ws + WS_DOG) + (rowb + 32 * i) * 1024 + h * 128 + c0) = (u32x4){cvt_pk_bf16(y[0], y[1]), cvt_pk_bf16(y[2], y[3]), cvt_pk_bf16(y[4], y[5]), cvt_pk_bf16(y[6], y[7])};
    }
}
__device__ __forceinline__ void scan_tail(Frame& F, int b, int h, int sl) {
    unsigned char* ws = F.p->ws; unsigned* cnt = (unsigned*)(ws + WS_CTL) + CW_HAND + 64 * (16 + b * 8 + h);
    hand_signal(cnt);
    const int lane = F.lane; const size_t r0 = (size_t)b * SEQ + 512 * sl + 4 * F.wave;
    u32x4 z0[8], z1[8]; gn_load_z<8>(z0, ws, r0, h, lane); gn_load_z<8>(z1, ws, r0 + 256, h, lane);
    hand_wait(cnt, 4u);
    gated_norm_batch<8>(ws, F.p->in[18], r0, h, lane, z0); gated_norm_batch<8>(ws, F.p->in[18], r0 + 256, h, lane, z1);
}
}

__global__ void __launch_bounds__(NTHREADS, 2) fwd_kernel(Params prm) {
    extern __shared__ __attribute__((aligned(16))) unsigned char lds_raw[];
    Frame F; F.lds = (LAS unsigned char*)lds_raw; F.tid = threadIdx.x; F.lane = F.tid & 63; F.wave = __builtin_amdgcn_readfirstlane(F.tid >> 6);
    F.G = gridDim.x; F.c = blockIdx.x; F.p = &prm;
    unsigned char* ws = prm.ws;
    volatile LAS unsigned* MISC = (volatile LAS unsigned*)(F.lds + 131072 + 8192);
    if (F.tid < 16) MISC[F.tid] = 0u;
    __syncthreads();
    (void)xcd_barrier_post((unsigned*)(ws + WS_CTL) + 1024, MISC + 8);
#define GSYNC() do { XcdBarrier gb_; gb_.bar = (unsigned*)(ws + WS_CTL) + 1024; gb_.x = 0; gb_.st = MISC + 8; xcd_barrier(gb_); OPAQUE_WS(ws); } while (0)
    const float QSCALE = 0.07216878364870322f * 1.4426950408889634f;

    p0_prologue(F);
    GSYNC();
    {
        pg8::Gemm g{(const bf16_t*)(ws + WS_U), (const bf16_t*)(ws + WS_WT_IN0), 1024, 1024};
        pg8::PlainOrder S; S.init(MT / 256, NIN0P / 256, 16, F.G, F.c);
        pg8::EpiF32 E{(float*)(ws + WS_A0), NIN0P, nullptr};
        pg8::gemm_phase(F.lds, g, S, E);
    }
    {
        pg8::Gemm g1{(const bf16_t*)(ws + WS_WOT), (const bf16_t*)(ws + WS_BD_UV), 1024, 1024};
        pg8::PrepOrder S1{4, 8, F.G, F.c, 195, 0};
        pg8::EpiBf16 E1{(bf16_t*)(ws + WS_WT_UVO), 2048};
        pg8::gemm_phase(F.lds, g1, S1, E1);
        pg8::Gemm g2{(const bf16_t*)(ws + WS_BD_UK), (const bf16_t*)(ws + WS_UQN), 1024, 1024};
        pg8::PrepOrder S2{8, 2, F.G, F.c, 227, 1};
        pg8::EpiBf16 E2{(bf16_t*)(ws + WS_WT_Q), 512};
        pg8::gemm_phase(F.lds, g2, S2, E2);
    }
    GSYNC();
    m2_rows(F);
    GSYNC();
    {
        pg8::Gemm g{(const bf16_t*)(ws + WS_CQ), (const bf16_t*)(ws + WS_WT_Q), 384, 512};
        pg8::PlainOrder S; S.init(MT / 256, NQ / 256, 6, F.G, F.c);
        pg8::EpiQ E{(bf16_t*)(ws + WS_Q), (const f32x2*)(ws + WS_ROPE), QSCALE};
        pg8::gemm_phase(F.lds, g, S, E);
    }
    GSYNC();
    attn::phase(F);
    GSYNC();
    for (int sb = F.c; sb < DECB; sb += F.G) attn::sample_combine(F, sb);
    GSYNC();
    {
        pg8::Gemm g{(const bf16_t*)(ws + WS_OL), (const bf16_t*)(ws + WS_WT_UVO), 2048, 2048};
        pg8::SplitOrder S; S.init(MP / 256, 4, 32, F.G, F.c); S.pmx = MP / 256; S.nsplit = 8;
        pg8::EpiMix E{(bf16_t*)(ws + WS_MIX), DM, (float*)(ws + WS_SLAB)};
        pg8::gemm_phase(F.lds, g, S, E);
    }
    GSYNC();
    rowpass(F, true, false, F.p->in[6] + 1 * DM, F.p->in[6] + 2 * DM, 8);
    GSYNC();
#pragma unroll
    for (int l = 0; l < 2; ++l) {
        if (l == 1) {
            {
                pg8::Gemm g{(const bf16_t*)(ws + WS_U), (const bf16_t*)(ws + WS_WT_DIN), 1024, 1024};
                pg8::PlainOrder S; S.init(MT / 256, DN_NP / 256, 16, F.G, F.c);
                pg8::EpiBf16 E{(bf16_t*)(ws + WS_PROJ), DN_NP};
                pg8::gemm_phase(F.lds, g, S, E);
            }
            GSYNC();
            dn::chunk_phase(F);
            for (int L = F.c; L < DECB * 8; L += F.G) dn::sample_item(F, L >> 3, L & 7);
            GSYNC();
            for (int L = F.c; L < 256; L += F.G) { const int sl = (L >> 3) & 3, bh = (L & 7) + 8 * (L >> 5); dn::scan_item(F, bh >> 3, bh & 7, sl); }
            for (int L = F.c; L < 256; L += F.G) { const int sl = (L >> 3) & 3, bh = (L & 7) + 8 * (L >> 5); dn::scan_tail(F, bh >> 3, bh & 7, sl); }
            GSYNC();
            {
                pg8::Gemm g{(const bf16_t*)(ws + WS_DOG), (const bf16_t*)(ws + WS_WT_DO), 1024, 1024};
                pg8::SplitOrder S; S.init(MP / 256, 4, 16, F.G, F.c); S.pmx = MP / 256; S.nsplit = 4;
                pg8::EpiMix E{(bf16_t*)(ws + WS_MIX), DM, (float*)(ws + WS_SLAB)};
                pg8::gemm_phase(F.lds, g, S, E);
            }
            GSYNC();
            rowpass(F, false, false, F.p->in[6] + 5 * DM, F.p->in[6] + 6 * DM, 4);
            GSYNC();
        }
        {
            pg8::Gemm g{(const bf16_t*)(ws + WS_U), (const bf16_t*)(ws + WS_WT_F1) + (size_t)l * 5632 * 1024, 1024, 1024};
            pg8::PlainOrder S; S.init(MT / 256, 22, 16, F.G, F.c);
            pg8::EpiSwiglu E{(bf16_t*)(ws + WS_H), DFF};
            pg8::gemm_phase(F.lds, g, S, E);
        }
        GSYNC();
        {
            pg8::Gemm g{(const bf16_t*)(ws + WS_H), (const bf16_t*)(ws + WS_WT_F2) + (size_t)l * 1024 * DFF, DFF, DFF};
            pg8::SplitOrder S; S.init(MP / 256, 4, 44, F.G, F.c); S.pmx = MP / 256; S.nsplit = 11;
            pg8::EpiMix E{(bf16_t*)(ws + WS_MIX), DM, (float*)(ws + WS_SLAB)};
            pg8::gemm_phase(F.lds, g, S, E);
        }
        GSYNC();
        rowpass(F, false, l == 1, F.p->in[6] + (l * 4 + 3) * DM, l == 0 ? F.p->in[6] + 4 * DM : nullptr, 11);
        if (l == 0) GSYNC();
    }
}

extern "C" void kernel_launch(void* const* d_in, const int* in_sizes, int n_in, void* d_out, int out_size, void* d_ws, size_t ws_size, hipStream_t stream) {
    static int grid = 0;
    if (grid == 0) {
        int dev = 0, cus = 0, per_cu = 0;
        hipGetDevice(&dev);
        hipDeviceGetAttribute(&cus, hipDeviceAttributeMultiprocessorCount, dev);
        hipFuncSetAttribute((const void*)fwd_kernel, hipFuncAttributeMaxDynamicSharedMemorySize, LDS_BYTES);
        hipOccupancyMaxActiveBlocksPerMultiprocessor(&per_cu, (const void*)fwd_kernel, NTHREADS, LDS_BYTES);
        if (per_cu < 1) { fprintf(stderr, "kernel_launch: occupancy query reports %d blocks per CU\n", per_cu); per_cu = 1; }
        (void)hipGetLastError();
        grid = cus;
        if (n_in != 22 || (size_t)out_size != O_END || ws_size < WS_END) fprintf(stderr, "kernel_launch: unexpected sizes n_in %d out %d ws %zu\n", n_in, out_size, ws_size);
    }
    if (ws_size < WS_END || n_in != 22 || (size_t)out_size != O_END) return;
    hipMemsetAsync((char*)d_ws + WS_CTL, 0, CTL_BYTES, stream);
    Params p{};
    for (int i = 0; i < 22; ++i) p.in[i] = (const float*)d_in[i];
    p.page_table = (const int*)d_in[5]; p.out = (float*)d_out; p.ws = (unsigned char*)d_ws;
    void* args[] = {&p};
    hipError_t e = hipLaunchCooperativeKernel((const void*)fwd_kernel, dim3(grid), dim3(NTHREADS), args, LDS_BYTES, stream);
    if (e != hipSuccess) fprintf(stderr, "cooperative launch failed: %s (grid %d)\n", hipGetErrorString(e), grid);
}
```
